# Optimizing an MI355X kernel written in HIP

```python
import math
import jax
import jax.numpy as jnp
from jax import lax
import numpy as np


D_MODEL = 1024
BATCH = 8
SEQ = 2048
DEPTH = 2

PLE_DIM = 256
D_FF = 2816
EPS = 1e-6
Q_BLOCK = 128

A_HEADS = 8
A_HEAD_DIM = 64
MOBA_BLOCK = 256
MOBA_TOPK = 3
MOBA_Q_CHUNK = 16

B_HEADS = 8
MLA_Q_RANK = 256
MLA_KV_RANK = 128
MLA_NOPE = 64
MLA_ROPE = 32
MLA_V = 64
ROPE_THETA = 10000.0

T5_BUCKETS = 32
T5_MAX_DIST = 128

C_HEADS = 16
C_HEAD_DIM = 64

A_WIDTH = A_HEADS * A_HEAD_DIM
B_WIDTH = B_HEADS * MLA_V
AB_IN = 3 * A_WIDTH + MLA_Q_RANK + MLA_KV_RANK + MLA_ROPE
AB_OUT = A_WIDTH + B_WIDTH
C_WIDTH = C_HEADS * C_HEAD_DIM
C_IN = 3 * C_WIDTH + C_HEADS
N_EVEN = (DEPTH + 1) // 2
N_ODD = DEPTH // 2

kernel_name = 'hybrid_moba_mla_fox_macaron'

F32 = jnp.float32


def rmsnorm(x, g):
    xf = x.astype(F32)
    y = xf * lax.rsqrt(jnp.mean(xf * xf, axis=-1, keepdims=True) + EPS)
    return (y * g.astype(F32)).astype(x.dtype)


def swiglu(h, w_in, w_out):
    a, u = jnp.split(h @ w_in, 2, axis=-1)
    return (jax.nn.silu(a) * u) @ w_out


def split_heads(t, n_heads):
    b, s, _ = t.shape
    return t.reshape(b, s, n_heads, -1).transpose(0, 2, 1, 3)


def merge_heads(t):
    b, h, s, d = t.shape
    return t.transpose(0, 2, 1, 3).reshape(b, s, h * d)


def rope(x, pos):
    half = x.shape[-1] // 2
    inv = ROPE_THETA ** (-jnp.arange(half, dtype=F32) / half)
    ang = pos[:, None] * inv[None, :]
    cos, sin = jnp.cos(ang), jnp.sin(ang)
    xf = x.astype(F32)
    x1, x2 = xf[..., :half], xf[..., half:]
    return jnp.concatenate([x1 * cos - x2 * sin, x1 * sin + x2 * cos], axis=-1).astype(x.dtype)


def t5_bucket(dist):
    dist = jnp.maximum(dist, 0)
    max_exact = T5_BUCKETS // 2
    d = jnp.maximum(dist.astype(F32), 1.0)
    large = max_exact + (jnp.log(d / max_exact) / math.log(T5_MAX_DIST / max_exact)
                         * (T5_BUCKETS - max_exact)).astype(jnp.int32)
    large = jnp.minimum(large, T5_BUCKETS - 1)
    return jnp.where(dist < max_exact, dist, large)


def causal_block_attention(q, k, v, scale, log_decay_cum=None):
    b, h, s, dq = q.shape
    dv = v.shape[-1]
    nq = s // Q_BLOCK
    qb = q.reshape(b, h, nq, Q_BLOCK, dq).transpose(2, 0, 1, 3, 4)
    key_pos = jnp.arange(s)

    def block_fn(xs):
        i, q_i = xs[0], xs[1]
        logits = jnp.einsum('bhqd,bhkd->bhqk', q_i, k).astype(F32) * scale
        if log_decay_cum is not None:
            c_i = xs[2]
            logits = logits + (c_i[..., :, None] - log_decay_cum[..., None, :])
        q_pos = i * Q_BLOCK + jnp.arange(Q_BLOCK)
        mask = key_pos[None, :] <= q_pos[:, None]
        probs = jax.nn.softmax(jnp.where(mask, logits, -jnp.inf), axis=-1)
        return jnp.einsum('bhqk,bhkd->bhqd', probs.astype(v.dtype), v)

    xs = (jnp.arange(nq), qb)
    if log_decay_cum is not None:
        xs = xs + (log_decay_cum.reshape(b, h, nq, Q_BLOCK).transpose(2, 0, 1, 3),)
    out = lax.map(block_fn, xs)
    return out.transpose(1, 2, 0, 3, 4).reshape(b, h, s, dv)


def moba_attention(q, k, v, t5_table):
    b, h, s, dh = q.shape
    nb = -(-s // MOBA_BLOCK)
    pad = nb * MOBA_BLOCK - s
    k_blk = jnp.pad(k, ((0, 0), (0, 0), (0, pad), (0, 0))).reshape(b, h, nb, MOBA_BLOCK, dh)
    v_blk = jnp.pad(v, ((0, 0), (0, 0), (0, pad), (0, 0))).reshape(b, h, nb, MOBA_BLOCK, dh)
    pos = jnp.arange(s)
    own = (pos // MOBA_BLOCK).astype(jnp.int32)
    n_sel = min(MOBA_TOPK, nb - 1)
    own_idx = jnp.broadcast_to(own[:, None], (b, h, s, 1))
    if n_sel > 0:
        k_mean = k_blk.astype(F32).mean(axis=3)
        gate = jnp.einsum('bhsd,bhnd->bhsn', q.astype(F32), k_mean)
        past = jnp.arange(nb)[None, :] < own[:, None]
        gate = jnp.where(past, gate, -jnp.inf)
        _, top_idx = lax.top_k(gate, n_sel)
        sel_idx = jnp.concatenate([top_idx.astype(jnp.int32), own_idx], axis=-1)
        sel_valid = jnp.concatenate([jnp.arange(n_sel)[None, :] < own[:, None],
                                     jnp.ones((s, 1), dtype=bool)], axis=-1)
    else:
        sel_idx = own_idx
        sel_valid = jnp.ones((s, 1), dtype=bool)
    n_slots = n_sel + 1
    nqc = s // MOBA_Q_CHUNK
    qc = q.reshape(b, h, nqc, MOBA_Q_CHUNK, dh).transpose(2, 0, 1, 3, 4)
    idxc = sel_idx.reshape(b, h, nqc, MOBA_Q_CHUNK, n_slots).transpose(2, 0, 1, 3, 4)
    validc = sel_valid.reshape(nqc, MOBA_Q_CHUNK, n_slots)
    table_h = t5_table.T.astype(F32)
    bi = jnp.arange(b)[:, None, None, None]
    hi4 = jnp.arange(h)[None, :, None, None]
    hi5 = jnp.arange(h)[None, :, None, None, None]
    scale = dh ** -0.5

    def chunk_fn(xs):
        ci, q_i, idx_i, valid_i = xs
        k_g = k_blk[bi, hi4, idx_i]
        v_g = v_blk[bi, hi4, idx_i]
        logits = jnp.einsum('bhqd,bhqnkd->bhqnk', q_i, k_g).astype(F32) * scale
        q_pos = ci * MOBA_Q_CHUNK + jnp.arange(MOBA_Q_CHUNK)
        k_pos = idx_i[..., None] * MOBA_BLOCK + jnp.arange(MOBA_BLOCK)
        dist = q_pos[None, None, :, None, None] - k_pos
        bias = table_h[hi5, t5_bucket(dist)]
        mask = (dist >= 0) & valid_i[None, None, :, :, None]
        logits = jnp.where(mask, logits + bias, -jnp.inf)
        probs = jax.nn.softmax(logits.reshape(b, h, MOBA_Q_CHUNK, n_slots * MOBA_BLOCK), axis=-1)
        probs = probs.reshape(b, h, MOBA_Q_CHUNK, n_slots, MOBA_BLOCK)
        return jnp.einsum('bhqnk,bhqnkd->bhqd', probs.astype(v.dtype), v_g)

    out = lax.map(chunk_fn, (jnp.arange(nqc), qc, idxc, validc))
    return out.transpose(1, 2, 0, 3, 4).reshape(b, h, s, dh)


def mla_attention(cq, ckv, kr, q_norm, w_uq, kv_norm, w_ukv):
    b, s, _ = cq.shape
    pos = jnp.arange(s, dtype=F32)
    q = split_heads(rmsnorm(cq, q_norm) @ w_uq, B_HEADS)
    kv = split_heads(rmsnorm(ckv, kv_norm) @ w_ukv, B_HEADS)
    q_full = jnp.concatenate([q[..., :MLA_NOPE], rope(q[..., MLA_NOPE:], pos)], axis=-1)
    k_rope = jnp.broadcast_to(rope(kr, pos)[:, None], (b, B_HEADS, s, MLA_ROPE))
    k_full = jnp.concatenate([kv[..., :MLA_NOPE], k_rope], axis=-1)
    v = kv[..., MLA_NOPE:]
    return causal_block_attention(q_full, k_full, v, (MLA_NOPE + MLA_ROPE) ** -0.5)


def moba_mla_mixer(h, w_in, t5_table, q_norm, w_uq, kv_norm, w_ukv, w_out):
    u = h @ w_in
    cuts = np.cumsum([A_WIDTH, A_WIDTH, A_WIDTH, MLA_Q_RANK, MLA_KV_RANK]).tolist()
    qa, ka, va, cq, ckv, kr = jnp.split(u, cuts, axis=-1)
    oa = moba_attention(split_heads(qa, A_HEADS), split_heads(ka, A_HEADS),
                        split_heads(va, A_HEADS), t5_table)
    ob = mla_attention(cq, ckv, kr, q_norm, w_uq, kv_norm, w_ukv)
    return jnp.concatenate([merge_heads(oa), merge_heads(ob)], axis=-1) @ w_out


def fox_mixer(h, w_in, b_f, w_out):
    u = h @ w_in
    q, k, v, f = jnp.split(u, [C_WIDTH, 2 * C_WIDTH, 3 * C_WIDTH], axis=-1)
    log_f = jax.nn.log_sigmoid((f + b_f).astype(F32))
    cum = jnp.cumsum(log_f, axis=1).transpose(0, 2, 1)
    o = causal_block_attention(split_heads(q, C_HEADS), split_heads(k, C_HEADS),
                               split_heads(v, C_HEADS), C_HEAD_DIM ** -0.5, cum)
    return merge_heads(o) @ w_out


def setup_inputs(seed: int = 0) -> dict:
    key = jax.random.key(seed)
    ks = iter(jax.random.split(key, 32))

    def w(shape, fan_in):
        return jax.random.normal(next(ks), shape, F32) * fan_in ** -0.5

    def gain(shape):
        return 1.0 + 0.02 * jax.random.normal(next(ks), shape, F32)

    return {
        'x': jax.random.normal(next(ks), (BATCH, SEQ, D_MODEL), F32),
        'p': jax.random.normal(next(ks), (DEPTH, BATCH, SEQ, PLE_DIM), F32),
        't5_bias': 0.5 * jax.random.normal(next(ks), (T5_BUCKETS, A_HEADS), F32),
        'ff1_norm': gain((DEPTH, D_MODEL)),
        'ff1_w_in': w((DEPTH, D_MODEL, 2 * D_FF), D_MODEL),
        'ff1_w_out': w((DEPTH, D_FF, D_MODEL), D_FF),
        'mix_norm': gain((DEPTH, D_MODEL)),
        'ff2_norm': gain((DEPTH, D_MODEL)),
        'ff2_w_in': w((DEPTH, D_MODEL, 2 * D_FF), D_MODEL),
        'ff2_w_out': w((DEPTH, D_FF, D_MODEL), D_FF),
        'ple_norm': gain((DEPTH, D_MODEL)),
        'ple_w_gate': w((DEPTH, D_MODEL, D_MODEL), D_MODEL),
        'ple_w_proj': w((DEPTH, PLE_DIM, D_MODEL), PLE_DIM),
        'ab_w_in': w((N_EVEN, D_MODEL, AB_IN), D_MODEL),
        'mla_q_norm': gain((N_EVEN, MLA_Q_RANK)),
        'mla_w_uq': w((N_EVEN, MLA_Q_RANK, B_HEADS * (MLA_NOPE + MLA_ROPE)), MLA_Q_RANK),
        'mla_kv_norm': gain((N_EVEN, MLA_KV_RANK)),
        'mla_w_ukv': w((N_EVEN, MLA_KV_RANK, B_HEADS * (MLA_NOPE + MLA_V)), MLA_KV_RANK),
        'ab_w_out': w((N_EVEN, AB_OUT, D_MODEL), AB_OUT),
        'fox_w_in': w((N_ODD, D_MODEL, C_IN), D_MODEL),
        'fox_b_f': 3.0 + 0.5 * jax.random.normal(next(ks), (N_ODD, C_HEADS), F32),
        'fox_w_out': w((N_ODD, C_WIDTH, D_MODEL), C_WIDTH),
        'final_norm': gain((D_MODEL,)),
    }


def reference(x, p, t5_bias, ff1_norm, ff1_w_in, ff1_w_out, mix_norm, ff2_norm, ff2_w_in,
              ff2_w_out, ple_norm, ple_w_gate, ple_w_proj, ab_w_in, mla_q_norm, mla_w_uq,
              mla_kv_norm, mla_w_ukv, ab_w_out, fox_w_in, fox_b_f, fox_w_out, final_norm):
    for i in range(DEPTH):
        x = x + 0.5 * swiglu(rmsnorm(x, ff1_norm[i]), ff1_w_in[i], ff1_w_out[i])
        h = rmsnorm(x, mix_norm[i])
        j = i // 2
        if i % 2 == 0:
            x = x + moba_mla_mixer(h, ab_w_in[j], t5_bias, mla_q_norm[j], mla_w_uq[j],
                                   mla_kv_norm[j], mla_w_ukv[j], ab_w_out[j])
        else:
            x = x + fox_mixer(h, fox_w_in[j], fox_b_f[j], fox_w_out[j])
        x = x + 0.5 * swiglu(rmsnorm(x, ff2_norm[i]), ff2_w_in[i], ff2_w_out[i])
        g = jax.nn.sigmoid(rmsnorm(x, ple_norm[i]) @ ple_w_gate[i])
        x = x + g * (p[i] @ ple_w_proj[i])
    return rmsnorm(x, final_norm)
```

```cpp
#include <hip/hip_runtime.h>
#include <hip/hip_bf16.h>
#include <cstdio>
#include <cstdint>
#include <cmath>

#ifndef MK_ONE_LAUNCH
#define MK_ONE_LAUNCH 0
#endif

constexpr int BATCH = 8, SEQ = 2048, DM = 1024, M = BATCH * SEQ, DFF = 2816, PLED = 256;
constexpr float EPS = 1e-6f;

namespace pg8 {
#define PG8_LAS __attribute__((address_space(3)))
typedef unsigned short bf16_t;
typedef short bf16x8 __attribute__((ext_vector_type(8)));
typedef float f32x4 __attribute__((ext_vector_type(4)));
typedef unsigned u32x4 __attribute__((ext_vector_type(4)));
typedef unsigned u32x2 __attribute__((ext_vector_type(2)));
constexpr int BM = 256, BK = 64, HALF = 128, HTB = HALF * BK * 2, STAGE_BYTES = 8 * HTB, NXCD = 8, WGM = 8;

__host__ __device__ __forceinline__ int lds_byte(int r, int c) { const int st = (r >> 4) * 2 + (c >> 5), rr = r & 15, cc = c & 31, ob = rr * 64 + cc * 2; return st * 1024 + (ob ^ (((ob >> 9) & 1) << 5)); }
__host__ __device__ __forceinline__ void stage_rc(int b, int& R, int& C) { const int st = b / 1024, sb = b % 1024, swz = sb ^ (((sb >> 9) & 1) << 5); R = (st >> 1) * 16 + swz / 64; C = (st & 1) * 32 + (swz % 64) / 2; }
__host__ __device__ __forceinline__ int perm32(int rho) { const int n = rho >> 4, i = rho & 15; return 8 * (i >> 2) + 4 * n + (i & 3); }

struct Unit { int pm, pn; };
struct Gemm { const bf16_t* A; const bf16_t* A2; const bf16_t* Bt; int M, N, K, lda, ldb, pn_split; };

struct StaticOrder {
    int nM, nN, nwg, G, c;
    __host__ __device__ void init(int M_, int N_, int G_, int c_) { nM = M_ / BM; nN = N_ / BM; nwg = nM * nN; G = G_; c = c_; }
    __host__ __device__ bool next(int i, Unit& u) const {
        const long L = (long)i * G + c; if (L >= nwg) return false;
        int wgid = (int)L; { const int q = nwg / NXCD, r = nwg % NXCD, xcd = wgid % NXCD, off = wgid / NXCD; wgid = (xcd < r ? xcd * (q + 1) : r * (q + 1) + (xcd - r) * q) + off; }
        const int nig = WGM * nN, gid = wgid / nig, fm = gid * WGM, gsz = (nM - fm) < WGM ? (nM - fm) : WGM;
        u.pm = fm + ((wgid % nig) % gsz); u.pn = (wgid % nig) / gsz; return true;
    }
    __device__ __forceinline__ void a_ready(const Unit&) const {}
    __device__ __forceinline__ void done(const Unit&) const {}
};

__device__ __forceinline__ unsigned cvt_pk_bf16(float lo, float hi) { unsigned r; asm volatile("v_cvt_pk_bf16_f32 %0, %1, %2" : "=v"(r) : "v"(lo), "v"(hi)); return r; }

template <class Epi, class Sched, bool ALIGN_EPI = false, bool SP2 = false>
__device__ __forceinline__ void gemm_phase(PG8_LAS unsigned char* lds, const Gemm g, const Sched& S, const Epi& E, const int tid) {
    const int wid = __builtin_amdgcn_readfirstlane(tid >> 6), lane = tid & 63, wr = wid >> 2, wc = wid & 3, fr = lane & 15, fq = lane >> 4;
    const int K = g.K, nt = K / BK;
    unsigned voffA[2], voffB[2];
#pragma unroll
    for (int i = 0; i < 2; ++i) { int R, C; stage_rc(tid * 16 + i * 8192, R, C); const int Rb = Epi::PERM ? ((R & ~31) + perm32(R & 31)) : R;
        voffA[i] = (unsigned)(R * g.lda + C) * 2u; voffB[i] = (unsigned)(Rb * g.ldb + C) * 2u; }
    const size_t kstep = (size_t)(BK * 2);
    const size_t hstepA = (size_t)HALF * g.lda * 2, hstepB = (size_t)HALF * g.ldb * 2;
    const size_t tstepA = 2 * hstepA, tstepB = 2 * hstepB;
    const unsigned ldsw = (unsigned)wid * 1024u;
    const int aoff = lds_byte(wr * 64 + fr, fq * 8), boff = lds_byte(wc * 32 + fr, fq * 8);
#define PG8_SA(b, h) (((b) * 2 + (h)) * HTB)
#define PG8_SB(b, h) ((4 + (b) * 2 + (h)) * HTB)
#define PG8_STAGE(bufoff, gbase, voff) do { _Pragma("unroll") for (int _i = 0; _i < 2; ++_i) \
        __builtin_amdgcn_global_load_lds((const unsigned*)((const char*)(gbase) + (voff)[_i]), (PG8_LAS unsigned*)(lds + (bufoff) + ldsw + _i * 8192), 16, 0, 0); } while (0)
#define PG8_LDA(dst, b, h) do { _Pragma("unroll") for (int m = 0; m < 4; ++m) _Pragma("unroll") for (int k = 0; k < 2; ++k) dst[m][k] = *(const PG8_LAS bf16x8*)(lds + PG8_SA(b, h) + aoff + m * 2048 + k * 1024); } while (0)
#define PG8_LDB(dst, b, h) do { _Pragma("unroll") for (int n = 0; n < 2; ++n) _Pragma("unroll") for (int k = 0; k < 2; ++k) dst[n][k] = *(const PG8_LAS bf16x8*)(lds + PG8_SB(b, h) + boff + n * 2048 + k * 1024); } while (0)
#define PG8_MMA(ai, bj, At, Bt) do { __builtin_amdgcn_s_setprio(1); _Pragma("unroll") for (int m = 0; m < 4; ++m) _Pragma("unroll") for (int n = 0; n < 2; ++n) _Pragma("unroll") for (int k = 0; k < 2; ++k) \
        acc[ai][bj][m][n] = __builtin_amdgcn_mfma_f32_16x16x32_bf16(Bt[n][k], At[m][k], acc[ai][bj][m][n], 0, 0, 0); __builtin_amdgcn_s_setprio(0); } while (0)
#define PG8_WAIT_V(n) asm volatile("s_waitcnt vmcnt(" #n ")" ::: "memory")
#define PG8_WAIT_L(n) asm volatile("s_waitcnt lgkmcnt(" #n ")" ::: "memory")
#define PG8_BAR __builtin_amdgcn_s_barrier()
#define PG8_SCHED __builtin_amdgcn_sched_barrier(0)
#define PG8_ABASE(u) ((const char*)(((u).pn >= g.pn_split) ? g.A2 : g.A) + (size_t)(u).pm * tstepA)
    Unit cur, nxt; int ui = 0;
    if (!S.next(0, cur)) return;
    f32x4 acc[2][2][4][2];
#pragma unroll
    for (int a = 0; a < 2; ++a)
#pragma unroll
        for (int b = 0; b < 2; ++b)
#pragma unroll
            for (int m = 0; m < 4; ++m)
#pragma unroll
                for (int n = 0; n < 2; ++n) acc[a][b][m][n] = (f32x4){0.f, 0.f, 0.f, 0.f};
    bf16x8 At[4][2], B0[2][2], B1[2][2];
    const char* cA = PG8_ABASE(cur); const char* cB = (const char*)g.Bt + (size_t)cur.pn * tstepB;
    S.a_ready(cur);
    if constexpr (SP2) {
        PG8_STAGE(PG8_SB(0, 0), cB, voffB); PG8_STAGE(PG8_SB(0, 1), cB + hstepB, voffB); PG8_STAGE(PG8_SA(0, 0), cA, voffA); PG8_STAGE(PG8_SA(0, 1), cA + hstepA, voffA);
        if (wr == 1) PG8_BAR;
        PG8_WAIT_V(2); PG8_BAR;
        PG8_STAGE(PG8_SB(1, 0), cB + kstep, voffB); PG8_STAGE(PG8_SA(1, 0), cA + kstep, voffA); PG8_STAGE(PG8_SB(1, 1), cB + hstepB + kstep, voffB);
        PG8_WAIT_V(6); PG8_BAR;
    } else {
        PG8_STAGE(PG8_SB(0, 0), cB, voffB); PG8_STAGE(PG8_SA(0, 0), cA, voffA); PG8_STAGE(PG8_SB(0, 1), cB + hstepB, voffB); PG8_STAGE(PG8_SA(0, 1), cA + hstepA, voffA);
        if (wr == 1) PG8_BAR;
        PG8_WAIT_V(4); PG8_BAR;
        PG8_STAGE(PG8_SB(1, 0), cB + kstep, voffB); PG8_STAGE(PG8_SA(1, 0), cA + kstep, voffA); PG8_STAGE(PG8_SB(1, 1), cB + hstepB + kstep, voffB);
        PG8_WAIT_V(6); PG8_BAR;
    }
    for (;;) {
        const bool has_next = S.next(ui + 1, nxt);
        const char* nA = has_next ? PG8_ABASE(nxt) : cA; const char* nB = has_next ? (const char*)g.Bt + (size_t)nxt.pn * tstepB : cB;
        for (int t = 0; t < nt; t += 2) {
            const bool last = (t == nt - 2);
            const char* a1 = cA + (size_t)(t + 1) * kstep;
            const char* a2 = last ? nA : cA + (size_t)(t + 2) * kstep; const char* b2 = last ? nB : cB + (size_t)(t + 2) * kstep;
            const char* a3 = a2 + kstep; const char* b3 = b2 + kstep;
            if (last && has_next) S.a_ready(nxt);
            if constexpr (SP2) {
            PG8_LDB(B0, 0, 0); PG8_LDB(B1, 0, 1); PG8_SCHED; PG8_LDA(At, 0, 0); PG8_STAGE(PG8_SA(1, 1), a1 + hstepA, voffA);
            PG8_WAIT_V(8); PG8_WAIT_L(0); PG8_BAR; PG8_MMA(0, 0, At, B0); PG8_MMA(0, 1, At, B1); PG8_BAR; PG8_SCHED;
            PG8_LDA(At, 0, 1); PG8_STAGE(PG8_SB(0, 0), b2, voffB); PG8_STAGE(PG8_SB(0, 1), b2 + hstepB, voffB); PG8_STAGE(PG8_SA(0, 0), a2, voffA);
            PG8_WAIT_V(8); PG8_WAIT_L(0); PG8_BAR; PG8_MMA(1, 0, At, B0); PG8_MMA(1, 1, At, B1); PG8_BAR; PG8_SCHED;
            PG8_LDB(B0, 1, 0); PG8_LDB(B1, 1, 1); PG8_SCHED; PG8_LDA(At, 1, 0); PG8_STAGE(PG8_SA(0, 1), a2 + hstepA, voffA);
            PG8_WAIT_V(8); PG8_WAIT_L(0); PG8_BAR; PG8_MMA(0, 0, At, B0); PG8_MMA(0, 1, At, B1); PG8_BAR; PG8_SCHED;
            PG8_LDA(At, 1, 1); PG8_STAGE(PG8_SB(1, 0), b3, voffB); PG8_STAGE(PG8_SB(1, 1), b3 + hstepB, voffB); PG8_STAGE(PG8_SA(1, 0), a3, voffA);
            PG8_WAIT_V(8); PG8_WAIT_L(0); PG8_BAR; PG8_MMA(1, 0, At, B0); PG8_MMA(1, 1, At, B1); PG8_BAR; PG8_SCHED;
            } else {
            PG8_LDB(B0, 0, 0); PG8_SCHED; PG8_LDA(At, 0, 0); PG8_STAGE(PG8_SA(1, 1), a1 + hstepA, voffA);
            PG8_WAIT_L(8); PG8_BAR; PG8_WAIT_L(0); PG8_MMA(0, 0, At, B0); PG8_BAR; PG8_SCHED;
            PG8_LDB(B1, 0, 1); PG8_STAGE(PG8_SB(0, 0), b2, voffB);
            PG8_BAR; PG8_WAIT_L(0); PG8_MMA(0, 1, At, B1); PG8_BAR;
            PG8_LDA(At, 0, 1); PG8_STAGE(PG8_SA(0, 0), a2, voffA);
            PG8_BAR; PG8_WAIT_L(0); PG8_MMA(1, 0, At, B0); PG8_BAR; PG8_SCHED;
            PG8_STAGE(PG8_SB(0, 1), b2 + hstepB, voffB);
            PG8_WAIT_V(6); PG8_BAR; PG8_MMA(1, 1, At, B1); PG8_BAR;
            PG8_LDB(B0, 1, 0); PG8_SCHED; PG8_LDA(At, 1, 0); PG8_STAGE(PG8_SA(0, 1), a2 + hstepA, voffA);
            PG8_WAIT_L(8); PG8_BAR; PG8_WAIT_L(0); PG8_MMA(0, 0, At, B0); PG8_BAR; PG8_SCHED;
            PG8_LDB(B1, 1, 1); PG8_STAGE(PG8_SB(1, 0), b3, voffB);
            PG8_BAR; PG8_WAIT_L(0); PG8_MMA(0, 1, At, B1); PG8_BAR;
            PG8_LDA(At, 1, 1); PG8_STAGE(PG8_SA(1, 0), a3, voffA);
            PG8_BAR; PG8_WAIT_L(0); PG8_MMA(1, 0, At, B0); PG8_BAR; PG8_SCHED;
            PG8_STAGE(PG8_SB(1, 1), b3 + hstepB, voffB);
            PG8_WAIT_V(6); PG8_BAR; PG8_MMA(1, 1, At, B1); PG8_BAR;
            }
        }
        if constexpr (ALIGN_EPI) { if (wr == 0) PG8_BAR; }
        E(acc, cur, wr, wc, fr, fq);
        if (!has_next) break;
#pragma unroll
        for (int a = 0; a < 2; ++a)
#pragma unroll
            for (int b = 0; b < 2; ++b)
#pragma unroll
                for (int m = 0; m < 4; ++m)
#pragma unroll
                    for (int n = 0; n < 2; ++n) acc[a][b][m][n] = (f32x4){0.f, 0.f, 0.f, 0.f};
        cur = nxt; cA = nA; cB = nB; ++ui;
        if constexpr (ALIGN_EPI) { if (wr == 1) PG8_BAR; }
    }
    PG8_WAIT_V(0);
    if constexpr (!ALIGN_EPI) { if (wr == 0) PG8_BAR; }
    PG8_BAR;
#undef PG8_SA
#undef PG8_SB
#undef PG8_STAGE
#undef PG8_LDA
#undef PG8_LDB
#undef PG8_MMA
#undef PG8_WAIT_V
#undef PG8_WAIT_L
#undef PG8_BAR
#undef PG8_SCHED
#undef PG8_ABASE
}
}

using pg8::bf16_t; using pg8::f32x4; using pg8::u32x4; using pg8::u32x2; using pg8::Unit; using pg8::cvt_pk_bf16;

#define GAS __attribute__((address_space(1)))
#define LAS __attribute__((address_space(3)))
typedef GAS unsigned gu32;
#define RLX_AGENT __ATOMIC_RELAXED, __HIP_MEMORY_SCOPE_AGENT

constexpr size_t MiB = 1u << 20;
constexpr size_t WS_CTL = 0, CTL_ZERO_BYTES = 1 * MiB;
constexpr size_t WS_SSQ = 1 * MiB;
constexpr size_t WS_LF = 2 * MiB;
constexpr size_t WS_CUM = 3 * MiB;
constexpr size_t WS_ROPE = 4 * MiB;
constexpr size_t WS_BIASD = WS_ROPE + 256 * 1024;
constexpr size_t WS_KMP = WS_BIASD + 64 * 1024;
constexpr size_t WS_SSQCQ = WS_KMP + 256 * 1024;
constexpr size_t WS_SSQCKV = WS_SSQCQ + 256 * 1024;
constexpr size_t WS_KR = WS_SSQCKV + 256 * 1024;
constexpr size_t WS_W = 7 * MiB;
constexpr size_t SZ_WFI = (size_t)2 * DFF * DM * 2, SZ_WFO = (size_t)DM * DFF * 2;
constexpr size_t WS_WFI = WS_W;
constexpr size_t WS_WFO = WS_WFI + 4 * SZ_WFI;
constexpr size_t WS_WABI = WS_WFO + 4 * SZ_WFO;
constexpr size_t WS_WUP = WS_WABI + (size_t)2048 * 1024 * 2;
constexpr size_t WS_WABO = WS_WUP + (size_t)1792 * 256 * 2;
constexpr size_t WS_WFXI = WS_WABO + (size_t)1024 * 1024 * 2;
constexpr size_t WS_WFXO = WS_WFXI + (size_t)3072 * 1024 * 2;
constexpr size_t WS_WG = WS_WFXO + (size_t)1024 * 1024 * 2;
constexpr size_t WS_WP = WS_WG + (size_t)2 * 1024 * 1024 * 2;
constexpr size_t WS_WEND = WS_WP + (size_t)2 * 1024 * 256 * 2;
constexpr size_t WS_XB = 96 * MiB;
constexpr size_t WS_R = 128 * MiB;
constexpr size_t WS_PB = 248 * MiB;
constexpr size_t WS_END = 256 * MiB;
static_assert(WS_WEND <= WS_XB, "weights fit");
constexpr size_t R_H = 0;
constexpr size_t R_ZZ = 0;
constexpr size_t R_QMLA = 64 * MiB;
constexpr size_t R_KVMLA = 88 * MiB;
constexpr size_t R_QKV = 0;
constexpr size_t R_PP = 0;

constexpr int CW_BAR = 4096;

constexpr int RING_BYTES = 131072;
constexpr int LDSCTL_OFF = RING_BYTES, MISC_OFF = LDSCTL_OFF + 320;
constexpr int LDS_BYTES = 147456;

#define XB_TMO      128
#define XB_XCNT(j)  (256  + 64 * (j))
#define XB_XSUB(j)  (1280 + 64 * (j))
#define XB_XGEN(j)  (2304 + 64 * (j))
#define XB_TOP      3328
#define XB_TOPGEN   3392
#define XCD_BAR_WORDS 3456
#define XB_SPIN_CAP (1u << 22)
__device__ __forceinline__ unsigned xb_ld(unsigned* p)              { return __hip_atomic_load(p, __ATOMIC_RELAXED, __HIP_MEMORY_SCOPE_AGENT); }
__device__ __forceinline__ unsigned xb_add(unsigned* p, unsigned v) { return __hip_atomic_fetch_add(p, v, __ATOMIC_RELAXED, __HIP_MEMORY_SCOPE_AGENT); }
__device__ __forceinline__ unsigned xb_xcc_id() { return (unsigned)__builtin_amdgcn_s_getreg((3 << 11) | 20) & 0xFu; }
#define XB_SPIN(cond, bar) do { unsigned _sp = 0; while (cond) { __builtin_amdgcn_s_sleep(1); \
    if ((++_sp & 255u) == 0u) { if (xb_ld(&(bar)[XB_TMO])) break; if (_sp > XB_SPIN_CAP) { atomicAdd(&(bar)[XB_TMO], 1u); break; } } } } while (0)
struct XcdBarrier { unsigned* bar; unsigned x; volatile LAS unsigned* st; };
__device__ __forceinline__ XcdBarrier xcd_barrier_post(unsigned* bar, volatile LAS unsigned* st) {
    XcdBarrier b; b.bar = bar; b.x = xb_xcc_id(); b.st = st;
    if (threadIdx.x == 0) (void)xb_add(&bar[XB_XCNT(b.x)], 1u);
    return b;
}
__device__ __forceinline__ void xcd_barrier_complete(unsigned* bar, unsigned x, unsigned& nloc, unsigned& nx) {
    const unsigned G = gridDim.x * gridDim.y * gridDim.z;
    unsigned sum, cnt, mine, sp = 0u;
    for (;;) {
        sum = 0u; cnt = 0u; mine = 0u;
#pragma unroll
        for (unsigned j = 0; j < 16; ++j) { const unsigned c = xb_ld(&bar[XB_XCNT(j)]); sum += c; cnt += (c > 0u) ? 1u : 0u; mine = (j == x) ? c : mine; }
        if (sum == G) break;
        __builtin_amdgcn_s_sleep(1);
        if ((++sp & 255u) == 0u) { if (xb_ld(&bar[XB_TMO])) break; if (sp > XB_SPIN_CAP) { atomicAdd(&bar[XB_TMO], 1u); break; } }
    }
    nloc = mine > 0u ? mine : 1u; nx = cnt > 0u ? cnt : 1u;
}
__device__ __forceinline__ void xcd_barrier(const XcdBarrier& b) {
    asm volatile("s_waitcnt vmcnt(0)" ::: "memory");
    __syncthreads();
    if (threadIdx.x == 0) {
        unsigned* bar = b.bar;
        __builtin_amdgcn_s_waitcnt(0);
        unsigned nloc = b.st[0], nx = b.st[1];
        if (nloc == 0u) { xcd_barrier_complete(bar, b.x, nloc, nx); b.st[0] = nloc; b.st[1] = nx; }
        const unsigned old = xb_add(&bar[XB_XSUB(b.x)], 1u);
        const unsigned gen = old / nloc;
        if (old + 1u == (gen + 1u) * nloc) {
            __builtin_amdgcn_fence(__ATOMIC_RELEASE, "agent");
            asm volatile("s_waitcnt vmcnt(0)" ::: "memory");
            const unsigned og = xb_add(&bar[XB_TOP], 1u);
            const unsigned tg = og / nx;
            if (og + 1u == (tg + 1u) * nx) xb_add(&bar[XB_TOPGEN], 1u);
            else XB_SPIN(xb_ld(&bar[XB_TOPGEN]) == tg, bar);
            __builtin_amdgcn_fence(__ATOMIC_ACQUIRE, "agent");
            xb_add(&bar[XB_XGEN(b.x)], 1u);
            asm volatile("s_waitcnt vmcnt(0)" ::: "memory");
        } else {
            XB_SPIN(xb_ld(&bar[XB_XGEN(b.x)]) == gen, bar);
            __builtin_amdgcn_fence(__ATOMIC_ACQUIRE, "agent");
            asm volatile("s_waitcnt vmcnt(0)" ::: "memory");
        }
    }
    __syncthreads();
}

__device__ __forceinline__ unsigned f2bf(float f) { unsigned u = __builtin_bit_cast(unsigned, f); return (u + 0x7fffu + ((u >> 16) & 1u)) >> 16; }
__device__ __forceinline__ unsigned pk2(float lo, float hi) { return f2bf(lo) | (f2bf(hi) << 16); }
__device__ __forceinline__ float bf2f(unsigned short b) { return __builtin_bit_cast(float, (unsigned)b << 16); }
__device__ __forceinline__ float wave_sum(float v) {
#pragma unroll
    for (int o = 1; o < 64; o <<= 1) v += __shfl_xor(v, o);
    return v;
}
__device__ __forceinline__ float sum4(f32x4 a) { return (a.x + a.y) + (a.z + a.w); }
__device__ __forceinline__ float rstd_from16(const float* ssq, int row) {
    const f32x4* p = (const f32x4*)(ssq + (size_t)row * 16);
    const float s = (sum4(p[0]) + sum4(p[1])) + (sum4(p[2]) + sum4(p[3]));
    return rsqrtf(s * (1.f / 1024.f) + EPS);
}
__device__ __forceinline__ float rstd_from4(const float* ssq, int row, float invn) {
    const f32x4 a = *(const f32x4*)(ssq + (size_t)row * 4);
    return rsqrtf(sum4(a) * invn + EPS);
}
__device__ __forceinline__ float sigmoidf_(float a) { return __builtin_amdgcn_rcpf(1.f + __expf(-a)); }

struct EpiSwiglu {
    static constexpr bool PERM = true;
    bf16_t* H; const float* ssq;
    __device__ __forceinline__ void operator()(const f32x4 (&acc)[2][2][4][2], const Unit& u, int wr, int wc, int fr, int fq) const {
        const int row0 = u.pm * 256 + wr * 64 + fr, col0 = u.pn * 128 + wc * 32 + 8 * fq;
#pragma unroll
        for (int ai = 0; ai < 2; ++ai)
#pragma unroll
            for (int m = 0; m < 4; ++m) {
                const int row = row0 + ai * 128 + m * 16; const float rs = rstd_from16(ssq, row);
                float h[8];
#pragma unroll
                for (int n = 0; n < 2; ++n)
#pragma unroll
                    for (int j = 0; j < 4; ++j) { const float a = acc[ai][0][m][n][j] * rs, uu = acc[ai][1][m][n][j] * rs; h[n * 4 + j] = a * sigmoidf_(a) * uu; }
                u32x4 w; w.x = cvt_pk_bf16(h[0], h[1]); w.y = cvt_pk_bf16(h[2], h[3]); w.z = cvt_pk_bf16(h[4], h[5]); w.w = cvt_pk_bf16(h[6], h[7]);
                *(u32x4*)(H + (size_t)row * DFF + col0) = w;
            }
    }
};

struct EpiRes {
    static constexpr bool PERM = false;
    float* x; bf16_t* xb; float* ssq_out; const float* ssq_in; const bf16_t* pp; float alpha; int mode;
    __device__ __forceinline__ void operator()(const f32x4 (&acc)[2][2][4][2], const Unit& u, int wr, int wc, int fr, int fq) const {
        const int row0 = u.pm * 256 + wr * 64 + fr, col0 = u.pn * 256 + wc * 32 + 4 * fq;
#pragma unroll
        for (int ai = 0; ai < 2; ++ai)
#pragma unroll
            for (int m = 0; m < 4; ++m) {
                const int row = row0 + ai * 128 + m * 16; float q = 0.f;
                float rs = 1.f; if (mode == 1) rs = rstd_from16(ssq_in, row);
#pragma unroll
                for (int bj = 0; bj < 2; ++bj)
#pragma unroll
                    for (int n = 0; n < 2; ++n) {
                        const size_t off = (size_t)row * DM + col0 + bj * 128 + n * 16;
                        const f32x4 xo = *(const f32x4*)(x + off); f32x4 xn;
                        if (mode == 1) { const u32x2 pw = *(const u32x2*)(pp + off);
                            const float p0 = __builtin_bit_cast(float, pw.x << 16), p1 = __builtin_bit_cast(float, pw.x & 0xffff0000u), p2 = __builtin_bit_cast(float, pw.y << 16), p3 = __builtin_bit_cast(float, pw.y & 0xffff0000u);
                            const f32x4 a = acc[ai][bj][m][n] * rs;
                            xn.x = xo.x + sigmoidf_(a.x) * p0; xn.y = xo.y + sigmoidf_(a.y) * p1; xn.z = xo.z + sigmoidf_(a.z) * p2; xn.w = xo.w + sigmoidf_(a.w) * p3;
                        } else xn = xo + acc[ai][bj][m][n] * alpha;
                        *(f32x4*)(x + off) = xn;
                        u32x2 w; w.x = cvt_pk_bf16(xn.x, xn.y); w.y = cvt_pk_bf16(xn.z, xn.w); *(u32x2*)(xb + off) = w;
                        q += (xn.x * xn.x + xn.y * xn.y) + (xn.z * xn.z + xn.w * xn.w);
                    }
                q += __shfl_xor(q, 16); q += __shfl_xor(q, 32);
                if (fq == 0) ssq_out[(size_t)row * 16 + u.pn * 4 + wc] = q;
            }
    }
};

struct EpiStoreT {
    static constexpr bool PERM = true;
    bf16_t* O; int ldo; const float* ssq;
    __device__ __forceinline__ void operator()(const f32x4 (&acc)[2][2][4][2], const Unit& u, int wr, int wc, int fr, int fq) const {
        const int row0 = u.pm * 256 + wr * 64 + fr, col0 = u.pn * 256 + wc * 32 + 8 * fq;
#pragma unroll
        for (int ai = 0; ai < 2; ++ai)
#pragma unroll
            for (int m = 0; m < 4; ++m) {
                const int row = row0 + ai * 128 + m * 16; const float rs = rstd_from16(ssq, row);
#pragma unroll
                for (int bj = 0; bj < 2; ++bj) { const f32x4 v0 = acc[ai][bj][m][0] * rs, v1 = acc[ai][bj][m][1] * rs;
                    u32x4 w; w.x = cvt_pk_bf16(v0.x, v0.y); w.y = cvt_pk_bf16(v0.z, v0.w); w.z = cvt_pk_bf16(v1.x, v1.y); w.w = cvt_pk_bf16(v1.z, v1.w);
                    *(u32x4*)(O + (size_t)row * ldo + col0 + bj * 128) = w; }
            }
    }
};

struct EpiStoreF {
    static constexpr bool PERM = false;
    int mode; bf16_t* O; bf16_t* O2; const float* ssq; float* ssq_cq; float* ssq_ckv; bf16_t* kr; float* kmp; const float* rope;
    __device__ __forceinline__ void operator()(const f32x4 (&acc)[2][2][4][2], const Unit& u, int wr, int wc, int fr, int fq) const {
        const int row0 = u.pm * 256 + wr * 64 + fr;
        float colsum[2][2][4];
#pragma unroll
        for (int bj = 0; bj < 2; ++bj)
#pragma unroll
            for (int n = 0; n < 2; ++n)
#pragma unroll
                for (int j = 0; j < 4; ++j) colsum[bj][n][j] = 0.f;
#pragma unroll
        for (int ai = 0; ai < 2; ++ai)
#pragma unroll
            for (int m = 0; m < 4; ++m) {
                const int row = row0 + ai * 128 + m * 16;
                float rs = 1.f;
                if (mode == 0) rs = rstd_from16(ssq, row);
                else if (mode == 1) rs = (u.pn < 3) ? rstd_from4(ssq_cq, row, 1.f / 256.f) : rstd_from4(ssq_ckv, row, 1.f / 128.f);
                f32x4 v[2][2];
#pragma unroll
                for (int bj = 0; bj < 2; ++bj)
#pragma unroll
                    for (int n = 0; n < 2; ++n) v[bj][n] = acc[ai][bj][m][n] * rs;
                bf16_t* orow; int ocol;
                if (mode == 0) { orow = O + (size_t)row * 2048; ocol = u.pn * 256 + wc * 32 + 4 * fq; }
                else if (mode == 1) { if (u.pn < 3) { orow = O + (size_t)row * 768; ocol = u.pn * 256 + wc * 32 + 4 * fq; } else { orow = O2 + (size_t)row * 1024; ocol = (u.pn - 3) * 256 + wc * 32 + 4 * fq; } }
                else { orow = O + (size_t)row * 1024; ocol = u.pn * 256 + wc * 32 + 4 * fq; }
                if (mode == 0) {
                    if (u.pn == 2) { float q = 0.f;
#pragma unroll
                        for (int bj = 0; bj < 2; ++bj)
#pragma unroll
                            for (int n = 0; n < 2; ++n) q += (v[bj][n].x * v[bj][n].x + v[bj][n].y * v[bj][n].y) + (v[bj][n].z * v[bj][n].z + v[bj][n].w * v[bj][n].w);
                        q += __shfl_xor(q, 16); q += __shfl_xor(q, 32); if (fq == 0) ssq_cq[(size_t)row * 4 + wc] = q; }
                    if (u.pn == 3) { float q = 0.f;
#pragma unroll
                        for (int n = 0; n < 2; ++n) q += (v[0][n].x * v[0][n].x + v[0][n].y * v[0][n].y) + (v[0][n].z * v[0][n].z + v[0][n].w * v[0][n].w);
                        q += __shfl_xor(q, 16); q += __shfl_xor(q, 32); if (fq == 0) ssq_ckv[(size_t)row * 4 + wc] = q;
                        if (wc == 0) {
                            const int pos = row & (SEQ - 1);
                            const f32x4 cs = *(const f32x4*)(rope + (size_t)pos * 16 + 4 * fq), sn = *(const f32x4*)(rope + (size_t)SEQ * 16 + (size_t)pos * 16 + 4 * fq);
                            const f32x4 x1 = v[1][0], x2 = v[1][1];
                            const f32x4 y1 = x1 * cs - x2 * sn, y2 = x1 * sn + x2 * cs;
                            u32x2 w1, w2; w1.x = cvt_pk_bf16(y1.x, y1.y); w1.y = cvt_pk_bf16(y1.z, y1.w); w2.x = cvt_pk_bf16(y2.x, y2.y); w2.y = cvt_pk_bf16(y2.z, y2.w);
                            *(u32x2*)(kr + (size_t)row * 32 + 4 * fq) = w1; *(u32x2*)(kr + (size_t)row * 32 + 16 + 4 * fq) = w2;
                        } }
                    if (u.pn == 4 || u.pn == 5) {
#pragma unroll
                        for (int bj = 0; bj < 2; ++bj)
#pragma unroll
                            for (int n = 0; n < 2; ++n) { colsum[bj][n][0] += v[bj][n].x; colsum[bj][n][1] += v[bj][n].y; colsum[bj][n][2] += v[bj][n].z; colsum[bj][n][3] += v[bj][n].w; }
                    }
                }
                if (mode == 1 && u.pn < 3) {
#pragma unroll
                    for (int bj = 0; bj < 2; ++bj) {
                        const int g32 = u.pn * 8 + bj * 4 + wc;
                        if (g32 % 3 == 2) {
                            const int pos = row & (SEQ - 1);
                            const f32x4 cs = *(const f32x4*)(rope + (size_t)pos * 16 + 4 * fq), sn = *(const f32x4*)(rope + (size_t)SEQ * 16 + (size_t)pos * 16 + 4 * fq);
                            const f32x4 x1 = v[bj][0], x2 = v[bj][1];
                            v[bj][0] = x1 * cs - x2 * sn; v[bj][1] = x1 * sn + x2 * cs;
                        }
                    }
                }
#pragma unroll
                for (int bj = 0; bj < 2; ++bj)
#pragma unroll
                    for (int n = 0; n < 2; ++n) { u32x2 w; w.x = cvt_pk_bf16(v[bj][n].x, v[bj][n].y); w.y = cvt_pk_bf16(v[bj][n].z, v[bj][n].w);
                        *(u32x2*)(orow + ocol + bj * 128 + n * 16) = w; }
            }
        if (mode == 0 && (u.pn == 4 || u.pn == 5)) {
#pragma unroll
            for (int bj = 0; bj < 2; ++bj)
#pragma unroll
                for (int n = 0; n < 2; ++n)
#pragma unroll
                    for (int j = 0; j < 4; ++j) { float s = colsum[bj][n][j];
                        s += __shfl_xor(s, 1); s += __shfl_xor(s, 2); s += __shfl_xor(s, 4); s += __shfl_xor(s, 8);
                        if (fr == 0) kmp[((size_t)u.pm * 2 + wr) * 512 + (u.pn - 4) * 256 + bj * 128 + wc * 32 + n * 16 + 4 * fq + j] = s; }
        }
    }
};

struct Args {
    const float* in[23]; float* out; unsigned char* ws; int ph_lo, ph_hi;
};
struct Frame {
    LAS unsigned char* lds; unsigned char* ldsg; volatile LAS unsigned* MISC; gu32* ctl;
    int tid, lane, wave, vcu, G;
    unsigned char* ws; float* x;
};

__device__ __forceinline__ void conv_item(const float* W, int ldw, int sc0, const float* gain, bf16_t* WT, int ldt, int n0, int k0, LAS float* scr, int lane) {
#pragma unroll 8
    for (int i = 0; i < 32; ++i) { const int kk = 2 * i + (lane >> 5);
        float v = 0.f; if (sc0 >= 0) { v = W[(size_t)(k0 + kk) * ldw + sc0 + (lane & 31)]; if (gain) v *= gain[k0 + kk]; }
        scr[kk * 33 + (lane & 31)] = v; }
    asm volatile("s_waitcnt lgkmcnt(0)" ::: "memory");
    const int c = lane & 7;
#pragma unroll
    for (int j = 0; j < 4; ++j) { const int n = (lane >> 3) + 8 * j; const LAS float* s = scr + (8 * c) * 33 + n;
        u32x4 o; o.x = pk2(s[0 * 33], s[1 * 33]); o.y = pk2(s[2 * 33], s[3 * 33]); o.z = pk2(s[4 * 33], s[5 * 33]); o.w = pk2(s[6 * 33], s[7 * 33]);
        *(u32x4*)(WT + (size_t)(n0 + n) * ldt + k0 + 8 * c) = o; }
    asm volatile("s_waitcnt lgkmcnt(0)" ::: "memory");
}

struct ConvJob { const float* W; int ldw; const float* gain; bf16_t* WT; int K, N, kind; };
__device__ __forceinline__ ConvJob get_job(int j, const Args& a, unsigned char* ws) {
    ConvJob r;
    if (j < 12) { const int l = j / 6, t = j % 6;
        switch (t) {
        case 0: r = ConvJob{a.in[4] + (size_t)l * DM * 2 * DFF, 2 * DFF, a.in[3] + l * DM, (bf16_t*)(ws + WS_WFI + (size_t)(l * 2 + 0) * SZ_WFI), DM, 2 * DFF, 1}; break;
        case 1: r = ConvJob{a.in[8] + (size_t)l * DM * 2 * DFF, 2 * DFF, a.in[7] + l * DM, (bf16_t*)(ws + WS_WFI + (size_t)(l * 2 + 1) * SZ_WFI), DM, 2 * DFF, 1}; break;
        case 2: r = ConvJob{a.in[5] + (size_t)l * DFF * DM, DM, nullptr, (bf16_t*)(ws + WS_WFO + (size_t)(l * 2 + 0) * SZ_WFO), DFF, DM, 0}; break;
        case 3: r = ConvJob{a.in[9] + (size_t)l * DFF * DM, DM, nullptr, (bf16_t*)(ws + WS_WFO + (size_t)(l * 2 + 1) * SZ_WFO), DFF, DM, 0}; break;
        case 4: r = ConvJob{a.in[11] + (size_t)l * DM * DM, DM, a.in[10] + l * DM, (bf16_t*)(ws + WS_WG + (size_t)l * DM * DM * 2), DM, DM, 0}; break;
        default: r = ConvJob{a.in[12] + (size_t)l * PLED * DM, DM, nullptr, (bf16_t*)(ws + WS_WP + (size_t)l * DM * PLED * 2), PLED, DM, 0}; break;
        }
    } else {
        switch (j) {
        case 12: r = ConvJob{a.in[13], 1952, a.in[6], (bf16_t*)(ws + WS_WABI), DM, 2048, 2}; break;
        case 13: r = ConvJob{a.in[15], 768, a.in[14], (bf16_t*)(ws + WS_WUP), 256, 768, 0}; break;
        case 14: r = ConvJob{a.in[17], 1024, a.in[16], (bf16_t*)(ws + WS_WUP + (size_t)768 * 256 * 2), 256, 1024, 5}; break;
        case 15: r = ConvJob{a.in[18], DM, nullptr, (bf16_t*)(ws + WS_WABO), DM, DM, 0}; break;
        case 16: r = ConvJob{a.in[19], 3088, a.in[6] + DM, (bf16_t*)(ws + WS_WFXI), DM, 3072, 0}; break;
        default: r = ConvJob{a.in[21], DM, nullptr, (bf16_t*)(ws + WS_WFXO), DM, DM, 0}; break;
        }
    }
    return r;
}
__device__ __forceinline__ int conv_srccol(int kind, int n0) {
    if (kind == 1) { const int pn = n0 >> 8, j = n0 & 255; return j < 128 ? pn * 128 + j : DFF + pn * 128 + (j - 128); }
    if (kind == 2) { if (n0 < 512) return n0; if (n0 < 1024) { const int o = n0 - 512; return o < 416 ? 1536 + o : -1; } if (n0 < 1536) return 512 + (n0 - 1024); return 1024 + (n0 - 1536); }
    return n0;
}

__device__ __forceinline__ void conv_p_rows(Frame& F, const float* p, bf16_t* pb) {
    const int gw = F.vcu * 8 + F.wave, NGW = F.G * 8;
    for (int m = gw; m < M; m += NGW) { const f32x4 v = *((const f32x4*)(p + (size_t)m * PLED) + F.lane);
        u32x2 w; w.x = pk2(v.x, v.y); w.y = pk2(v.z, v.w); *((u32x2*)(pb + (size_t)m * PLED) + F.lane) = w; }
}

__device__ __forceinline__ void prologue(Frame& F, const Args& a) {
    LAS float* scr = (LAS float*)(F.lds + F.wave * 16384);
    const int gw = F.vcu * 8 + F.wave, NGW = F.G * 8;
    unsigned char* ws = F.ws;
    constexpr int nj = 18;
    int base = 0;
    for (int j = 0; j < nj; ++j) {
        const ConvJob jb = get_job(j, a, ws); const int nblk = jb.N / 32, nit = (jb.K / 64) * nblk;
        int first = (gw - base) % NGW; if (first < 0) first += NGW;
        for (int it = first; it < nit; it += NGW) {
            const int kb = it / nblk, nb = it % nblk, k0 = 64 * kb, n0 = 32 * nb;
            int sc0 = conv_srccol(jb.kind, n0);
            if (jb.kind == 5 && k0 >= 128) sc0 = -1;
            conv_item(jb.W, jb.ldw, sc0, jb.gain, jb.WT, jb.K, n0, k0, scr, F.lane);
        }
        base = (base + nit) % NGW;
    }
    {
        const float* xin = a.in[0]; float* xo = F.x; bf16_t* xb = (bf16_t*)(ws + WS_XB); float* ssq = (float*)(ws + WS_SSQ);
        for (int m = gw; m < M; m += NGW) {
            f32x4 v[4]; float s = 0.f;
#pragma unroll
            for (int j = 0; j < 4; ++j) { v[j] = *((const f32x4*)(xin + (size_t)m * DM) + F.lane + 64 * j); s += (v[j].x * v[j].x + v[j].y * v[j].y) + (v[j].z * v[j].z + v[j].w * v[j].w); }
            s = wave_sum(s);
#pragma unroll
            for (int j = 0; j < 4; ++j) { *((f32x4*)(xo + (size_t)m * DM) + F.lane + 64 * j) = v[j];
                u32x2 w; w.x = pk2(v[j].x, v[j].y); w.y = pk2(v[j].z, v[j].w); *((u32x2*)(xb + (size_t)m * DM) + F.lane + 64 * j) = w; }
            if (F.lane < 16) ssq[(size_t)m * 16 + F.lane] = (F.lane == 0) ? s : 0.f;
        }
    }
    conv_p_rows(F, a.in[1], (bf16_t*)(ws + WS_PB));
    {
        float* rope = (float*)(ws + WS_ROPE); const int gt = F.vcu * 512 + F.tid, NGT = F.G * 512;
        for (int e = gt; e < SEQ * 16; e += NGT) { const int pos = e >> 4, i = e & 15;
            const float inv = powf(10000.f, -(float)i / 16.f); const float ang = (float)pos * inv;
            rope[e] = (float)cos((double)ang); rope[SEQ * 16 + e] = (float)sin((double)ang); }
        float* biasd = (float*)(ws + WS_BIASD); const float* t5 = a.in[2];
        for (int e = gt; e < 8 * 128; e += NGT) { const int h = e >> 7, d = e & 127; int bk;
            if (d < 16) bk = d; else { bk = 16 + (int)(logf((float)d / 16.f) / 2.0794415416798357f * 16.f); if (bk > 31) bk = 31; }
            biasd[e] = t5[bk * 8 + h]; }
    }
}

constexpr int SA_HALF_FLOATS = 64 * 96 + 64 * 64 + 64 + 128;
template <int MODE> __device__ __forceinline__ void sattn_unit(Frame& F, const Args& a, int b, int h, int qb) {
    constexpr int DQ = (MODE == 1) ? 96 : 64;
    const int half = F.tid >> 8, t = F.tid & 255;
    float* ldsf = (float*)F.ldsg + half * SA_HALF_FLOATS;
    float* Ks = ldsf; float* Vs = Ks + 64 * DQ; float* Cs = Vs + 64 * 64; float* Bs = Cs + 64;
    unsigned char* ws = F.ws;
    const bf16_t *Qp, *K1, *K2 = nullptr, *Vp; bf16_t* Op; int ldq, ldk1, ldv, ldo; float scale;
    if (MODE == 0) { const bf16_t* ZZ = (const bf16_t*)(ws + WS_R + R_ZZ); Qp = ZZ + h * 64; ldq = 2048; K1 = ZZ + 1024 + h * 64; ldk1 = 2048; Vp = ZZ + 1536 + h * 64; ldv = 2048; Op = (bf16_t*)ZZ + h * 64; ldo = 2048; scale = 0.125f; }
    else if (MODE == 1) { const bf16_t* QM = (const bf16_t*)(ws + WS_R + R_QMLA); const bf16_t* KV = (const bf16_t*)(ws + WS_R + R_KVMLA);
        Qp = QM + h * 96; ldq = 768; K1 = KV + h * 128; ldk1 = 1024; K2 = (const bf16_t*)(ws + WS_KR); Vp = KV + h * 128 + 64; ldv = 1024; Op = (bf16_t*)(ws + WS_R + R_ZZ) + 512 + h * 64; ldo = 2048; scale = 0.10206207261596577f; }
    else { const bf16_t* QKV = (const bf16_t*)(ws + WS_R + R_QKV); Qp = QKV + h * 64; ldq = 3072; K1 = QKV + 1024 + h * 64; ldk1 = 3072; Vp = QKV + 2048 + h * 64; ldv = 3072; Op = (bf16_t*)QKV + h * 64; ldo = 3072; scale = 0.125f; }
    const int qpos = qb * 256 + t; const size_t row = (size_t)b * SEQ + qpos;
    float q[DQ];
#pragma unroll
    for (int c = 0; c < DQ / 8; ++c) { const u32x4 w = *(const u32x4*)(Qp + row * ldq + c * 8);
        q[c * 8 + 0] = __builtin_bit_cast(float, w.x << 16); q[c * 8 + 1] = __builtin_bit_cast(float, w.x & 0xffff0000u);
        q[c * 8 + 2] = __builtin_bit_cast(float, w.y << 16); q[c * 8 + 3] = __builtin_bit_cast(float, w.y & 0xffff0000u);
        q[c * 8 + 4] = __builtin_bit_cast(float, w.z << 16); q[c * 8 + 5] = __builtin_bit_cast(float, w.z & 0xffff0000u);
        q[c * 8 + 6] = __builtin_bit_cast(float, w.w << 16); q[c * 8 + 7] = __builtin_bit_cast(float, w.w & 0xffff0000u); }
    unsigned sel = 0xffu; float b31 = 0.f;
    if (MODE == 0) {
        const float* kmp = (const float*)(ws + WS_KMP);
        float gsc[8];
#pragma unroll
        for (int n = 0; n < 8; ++n) { gsc[n] = -INFINITY;
            if (n < qb) { const float* k0 = kmp + ((size_t)(b * 8 + n) * 2 + 0) * 512 + h * 64; const float* k1 = k0 + 512; float s = 0.f;
#pragma unroll
                for (int d = 0; d < 64; ++d) s += q[d] * (k0[d] + k1[d]);
                gsc[n] = s; } }
        sel = 0u; const int nsel = qb < 3 ? qb : 3;
        for (int r = 0; r < nsel; ++r) { int best = -1; float bv = -INFINITY;
#pragma unroll
            for (int n = 0; n < 8; ++n) { if (n < qb && !((sel >> n) & 1u) && (best < 0 || gsc[n] > bv)) { best = n; bv = gsc[n]; } }
            sel |= 1u << best; }
        const float* biasd = (const float*)(ws + WS_BIASD) + h * 128;
        if (t < 128) Bs[t] = biasd[t];
        b31 = biasd[127];
    }
#pragma unroll
    for (int d = 0; d < DQ; ++d) q[d] *= scale;
    float cq = 0.f; const float* cum = (const float*)(ws + WS_CUM) + (size_t)(b * 16 + h) * SEQ;
    if (MODE == 2) cq = cum[qpos];
    float o[64];
#pragma unroll
    for (int d = 0; d < 64; ++d) o[d] = 0.f;
    float mrun = -INFINITY, l = 0.f;
    const int ntiles = (qb + 1) * 4;
    for (int kt = 0; kt < ntiles; ++kt) {
        __syncthreads();
        for (int ch = t; ch < 64 * DQ / 8; ch += 256) { const int key = ch / (DQ / 8), c8 = ch % (DQ / 8), d0 = c8 * 8; const size_t kr = (size_t)b * SEQ + kt * 64 + key;
            const bf16_t* src = (d0 < 64) ? (K1 + kr * ldk1 + d0) : (K2 + kr * 32 + (d0 - 64));
            const u32x4 w = *(const u32x4*)src; float* dst = Ks + key * DQ + d0;
            dst[0] = __builtin_bit_cast(float, w.x << 16); dst[1] = __builtin_bit_cast(float, w.x & 0xffff0000u); dst[2] = __builtin_bit_cast(float, w.y << 16); dst[3] = __builtin_bit_cast(float, w.y & 0xffff0000u);
            dst[4] = __builtin_bit_cast(float, w.z << 16); dst[5] = __builtin_bit_cast(float, w.z & 0xffff0000u); dst[6] = __builtin_bit_cast(float, w.w << 16); dst[7] = __builtin_bit_cast(float, w.w & 0xffff0000u); }
        for (int ch = t; ch < 64 * 64 / 8; ch += 256) { const int key = ch / 8, d0 = (ch % 8) * 8; const size_t kr = (size_t)b * SEQ + kt * 64 + key;
            const u32x4 w = *(const u32x4*)(Vp + kr * ldv + d0); float* dst = Vs + key * 64 + d0;
            dst[0] = __builtin_bit_cast(float, w.x << 16); dst[1] = __builtin_bit_cast(float, w.x & 0xffff0000u); dst[2] = __builtin_bit_cast(float, w.y << 16); dst[3] = __builtin_bit_cast(float, w.y & 0xffff0000u);
            dst[4] = __builtin_bit_cast(float, w.z << 16); dst[5] = __builtin_bit_cast(float, w.z & 0xffff0000u); dst[6] = __builtin_bit_cast(float, w.w << 16); dst[7] = __builtin_bit_cast(float, w.w & 0xffff0000u); }
        if (MODE == 2) { if (t < 64) Cs[t] = cum[kt * 64 + t]; }
        __syncthreads();
        bool active = true;
        if (MODE == 0) { const int blk = kt >> 2; active = (blk == qb) || ((sel >> blk) & 1u); }
        if (active) {
#pragma unroll 1
            for (int j = 0; j < 64; ++j) {
                const int kp = kt * 64 + j;
                if (kp <= qpos) {
                    const float* kr = Ks + j * DQ; float acc = 0.f;
#pragma unroll
                    for (int d = 0; d < DQ; d += 4) { const f32x4 kv = *(const f32x4*)(kr + d); acc += q[d] * kv.x + q[d + 1] * kv.y + q[d + 2] * kv.z + q[d + 3] * kv.w; }
                    if (MODE == 0) { const int dist = qpos - kp; acc += (dist >= 128) ? b31 : Bs[dist]; }
                    if (MODE == 2) acc += cq - Cs[j];
                    if (acc > mrun) { const float corr = __expf(mrun - acc); l *= corr;
#pragma unroll
                        for (int d = 0; d < 64; ++d) o[d] *= corr;
                        mrun = acc; }
                    const float p = __expf(acc - mrun); l += p; const float* vr = Vs + j * 64;
#pragma unroll
                    for (int d = 0; d < 64; d += 4) { const f32x4 vv = *(const f32x4*)(vr + d); o[d] += p * vv.x; o[d + 1] += p * vv.y; o[d + 2] += p * vv.z; o[d + 3] += p * vv.w; }
                }
            }
        }
    }
    const float inv = 1.f / l;
#pragma unroll
    for (int c = 0; c < 8; ++c) { u32x4 w; w.x = pk2(o[c * 8] * inv, o[c * 8 + 1] * inv); w.y = pk2(o[c * 8 + 2] * inv, o[c * 8 + 3] * inv); w.z = pk2(o[c * 8 + 4] * inv, o[c * 8 + 5] * inv); w.w = pk2(o[c * 8 + 6] * inv, o[c * 8 + 7] * inv);
        *(u32x4*)(Op + row * ldo + c * 8) = w; }
    __syncthreads();
}
template <int MODE> __device__ __forceinline__ void sattn_phase(Frame& F, const Args& a, int flip) {
    constexpr int NH = (MODE == 2) ? 16 : 8;
    const int npairs = BATCH * (NH / 2) * 8, half = F.tid >> 8;
    for (int u = blockIdx.x, r = 0; u < npairs; u += F.G, ++r) {
        const int j = u & 7, bh2 = u >> 3; const int qb = ((r + flip) & 1) ? 7 - j : j;
        const int b = bh2 / (NH / 2), hp = bh2 % (NH / 2);
        sattn_unit<MODE>(F, a, b, hp * 2 + half, qb);
    }
}

__device__ __forceinline__ void fox_gate_rows(Frame& F, const Args& a) {
    const int gw = F.vcu * 8 + F.wave, NGW = F.G * 8; const float* W = a.in[19]; const float* g = a.in[6] + DM; const float* bfp = a.in[20];
    const float* ssq = (const float*)(F.ws + WS_SSQ); float* LF = (float*)(F.ws + WS_LF);
    for (int m = gw; m < M; m += NGW) {
        float acc[16];
#pragma unroll
        for (int hh = 0; hh < 16; ++hh) acc[hh] = 0.f;
        for (int j = 0; j < 16; ++j) { const int k = F.lane + 64 * j; const float xg = F.x[(size_t)m * DM + k] * g[k]; const f32x4* wr = (const f32x4*)(W + (size_t)k * 3088 + 3072);
#pragma unroll
            for (int c = 0; c < 4; ++c) { const f32x4 w = wr[c]; acc[c * 4] += xg * w.x; acc[c * 4 + 1] += xg * w.y; acc[c * 4 + 2] += xg * w.z; acc[c * 4 + 3] += xg * w.w; } }
        const float rs = rstd_from16(ssq, m); float mine = 0.f;
#pragma unroll
        for (int hh = 0; hh < 16; ++hh) { const float s = wave_sum(acc[hh]); if (F.lane == hh) mine = s; }
        if (F.lane < 16) { const float z = mine * rs + bfp[F.lane]; LF[(size_t)m * 16 + F.lane] = fminf(z, 0.f) - log1pf(__expf(-fabsf(z))); }
    }
}
__device__ __forceinline__ void fox_scan(Frame& F) {
    const int gw = F.vcu * 8 + F.wave, NGW = F.G * 8; const float* LF = (const float*)(F.ws + WS_LF); float* cum = (float*)(F.ws + WS_CUM);
    for (int sc = gw; sc < BATCH * 16; sc += NGW) { const int b = sc >> 4, hh = sc & 15;
        float v[32]; float run = 0.f;
#pragma unroll
        for (int i = 0; i < 32; ++i) { run += LF[((size_t)b * SEQ + F.lane * 32 + i) * 16 + hh]; v[i] = run; }
        float incl = run;
#pragma unroll
        for (int o = 1; o < 64; o <<= 1) { const float tt = __shfl_up(incl, o); if (F.lane >= o) incl += tt; }
        const float excl = incl - run;
#pragma unroll
        for (int i = 0; i < 32; ++i) cum[(size_t)sc * SEQ + F.lane * 32 + i] = v[i] + excl;
    }
}
__device__ __forceinline__ void final_norm(Frame& F, const Args& a) {
    const int gw = F.vcu * 8 + F.wave, NGW = F.G * 8; const float* ssq = (const float*)(F.ws + WS_SSQ); const float* g = a.in[22];
    for (int m = gw; m < M; m += NGW) { const float rs = rstd_from16(ssq, m);
#pragma unroll
        for (int j = 0; j < 4; ++j) { f32x4* p = (f32x4*)(F.x + (size_t)m * DM) + F.lane + 64 * j; const f32x4 gg = *((const f32x4*)g + F.lane + 64 * j); f32x4 v = *p; v = v * rs * gg; *p = v; } }
}

constexpr int NPHASE = 20;
__global__ void __launch_bounds__(512, 2) mk_fwd(Args args) {
    extern __shared__ __attribute__((aligned(16))) unsigned char lds[];
    Frame F;
    F.lds = (LAS unsigned char*)lds; F.ldsg = lds;
    F.MISC = (volatile LAS unsigned*)(F.lds + MISC_OFF);
    F.tid = threadIdx.x; F.lane = F.tid & 63; F.wave = __builtin_amdgcn_readfirstlane(F.tid >> 6);
    F.G = gridDim.x; { const int bx = blockIdx.x; F.vcu = (F.G % 8 == 0) ? (bx % 8) * (F.G / 8) + bx / 8 : bx; }
    F.ws = args.ws; F.x = args.out; F.ctl = (gu32*)(args.ws + WS_CTL);
    for (int u = F.tid; u < (LDS_BYTES - LDSCTL_OFF) / 4; u += 512) ((LAS unsigned*)(F.lds + LDSCTL_OFF))[u] = 0u;
    __syncthreads();
    XcdBarrier bar; bar.bar = (unsigned*)(F.ctl + CW_BAR); bar.x = 0; bar.st = nullptr;
    const bool multi = (args.ph_hi - args.ph_lo) > 1;
    if (multi) bar = xcd_barrier_post((unsigned*)(F.ctl + CW_BAR), F.MISC + 8);
    unsigned char* ws = args.ws;
    bf16_t* XB = (bf16_t*)(ws + WS_XB); float* SSQ = (float*)(ws + WS_SSQ);
    if (args.ph_lo == 0) { prologue(F, args); if (1 < args.ph_hi) xcd_barrier(bar); }
    for (int ph = (args.ph_lo == 0 ? 1 : args.ph_lo); ph < args.ph_hi; ++ph) {
        { unsigned char* w_ = args.ws; asm volatile("" : "+s"(w_)); ws = w_; F.ws = w_; float* x_ = args.out; asm volatile("" : "+s"(x_)); F.x = x_;
          int t_ = threadIdx.x; asm volatile("" : "+v"(t_)); F.tid = t_; F.lane = t_ & 63; F.wave = __builtin_amdgcn_readfirstlane(t_ >> 6);
          XB = (bf16_t*)(ws + WS_XB); SSQ = (float*)(ws + WS_SSQ); }
        const int layer = (ph >= 10) ? 1 : 0; const int lp = (ph == 0 || ph == 19) ? -1 : (ph - 1) - layer * 9;
        if (ph == 19) final_norm(F, args);
        else if (lp == 4) {
#ifndef NO_SATTN
            if (layer == 0) { sattn_phase<0>(F, args, 0); sattn_phase<1>(F, args, 1); }
            else sattn_phase<2>(F, args, 0);
#endif
        } else if (lp == 3 && layer == 1) fox_scan(F);
        else {
            if (lp == 0 && layer == 1) conv_p_rows(F, args.in[1] + (size_t)M * PLED, (bf16_t*)(ws + WS_PB));
            const int njobs = (lp == 8) ? 2 : 1;
            for (int jb = 0; jb < njobs; ++jb) {
                int et; pg8::Gemm g; int N_;
                EpiSwiglu E0{(bf16_t*)(ws + WS_R + R_H), SSQ};
                EpiRes E1{F.x, XB, SSQ, SSQ, (const bf16_t*)(ws + WS_R + R_PP), 1.0f, 0};
                EpiStoreT E2{(bf16_t*)(ws + WS_R + R_QKV), 3072, SSQ};
                EpiStoreF E3{0, (bf16_t*)(ws + WS_R + R_ZZ), nullptr, SSQ, (float*)(ws + WS_SSQCQ), (float*)(ws + WS_SSQCKV), (bf16_t*)(ws + WS_KR), (float*)(ws + WS_KMP), (const float*)(ws + WS_ROPE)};
                if (lp == 0 || lp == 6) { const int wi = layer * 2 + (lp == 6 ? 1 : 0); et = 0; N_ = 2 * DFF;
                    g = pg8::Gemm{XB, XB, (const bf16_t*)(ws + WS_WFI + (size_t)wi * SZ_WFI), M, 2 * DFF, DM, DM, DM, 1 << 30}; }
                else if (lp == 1 || lp == 7) { const int wi = layer * 2 + (lp == 7 ? 1 : 0); et = 1; N_ = DM; E1.alpha = 0.5f;
                    g = pg8::Gemm{(const bf16_t*)(ws + WS_R + R_H), nullptr, (const bf16_t*)(ws + WS_WFO + (size_t)wi * SZ_WFO), M, DM, DFF, DFF, DFF, 1 << 30}; }
                else if (lp == 5) { et = 1; N_ = DM; E1.alpha = 1.0f;
                    if (layer == 0) g = pg8::Gemm{(const bf16_t*)(ws + WS_R + R_ZZ), nullptr, (const bf16_t*)(ws + WS_WABO), M, DM, DM, 2048, DM, 1 << 30};
                    else g = pg8::Gemm{(const bf16_t*)(ws + WS_R + R_QKV), nullptr, (const bf16_t*)(ws + WS_WFXO), M, DM, DM, 3072, DM, 1 << 30}; }
                else if (lp == 2 && layer == 0) { et = 3; N_ = 2048; g = pg8::Gemm{XB, XB, (const bf16_t*)(ws + WS_WABI), M, 2048, DM, DM, DM, 1 << 30}; }
                else if (lp == 2) { et = 2; N_ = 3072; g = pg8::Gemm{XB, XB, (const bf16_t*)(ws + WS_WFXI), M, 3072, DM, DM, DM, 1 << 30}; }
                else if (lp == 3) { et = 3; N_ = 1792; const bf16_t* ZZ = (const bf16_t*)(ws + WS_R + R_ZZ);
                    g = pg8::Gemm{ZZ + 512, ZZ + 768, (const bf16_t*)(ws + WS_WUP), M, 1792, 256, 2048, 256, 3};
                    E3.mode = 1; E3.O = (bf16_t*)(ws + WS_R + R_QMLA); E3.O2 = (bf16_t*)(ws + WS_R + R_KVMLA); }
                else if (jb == 0) { et = 3; N_ = DM; E3.mode = 2; E3.O = (bf16_t*)(ws + WS_R + R_PP);
                    g = pg8::Gemm{(const bf16_t*)(ws + WS_PB), nullptr, (const bf16_t*)(ws + WS_WP + (size_t)layer * DM * PLED * 2), M, DM, PLED, PLED, PLED, 1 << 30}; }
                else { et = 1; N_ = DM; E1.mode = 1; __threadfence(); __syncthreads();
                    g = pg8::Gemm{XB, nullptr, (const bf16_t*)(ws + WS_WG + (size_t)layer * DM * DM * 2), M, DM, DM, DM, DM, 1 << 30}; }
                pg8::StaticOrder S; S.init(M, N_, F.G, (int)blockIdx.x);
#ifndef NO_GEMM
                if (et == 0) pg8::gemm_phase<EpiSwiglu, pg8::StaticOrder, true, true>(F.lds, g, S, E0, F.tid);
                else if (et == 1) pg8::gemm_phase<EpiRes, pg8::StaticOrder, true, true>(F.lds, g, S, E1, F.tid);
                else if (et == 2) pg8::gemm_phase<EpiStoreT, pg8::StaticOrder, true, true>(F.lds, g, S, E2, F.tid);
                else pg8::gemm_phase<EpiStoreF, pg8::StaticOrder, true, true>(F.lds, g, S, E3, F.tid);
#endif
            }
            if (lp == 2 && layer == 1) fox_gate_rows(F, args);
        }
        if (ph + 1 < args.ph_hi) xcd_barrier(bar);
    }
}

extern "C" void kernel_launch(void* const* d_in, const int* in_sizes, int n_in, void* d_out, int out_size, void* d_ws, size_t ws_size, hipStream_t stream) {
    static int grid = 0;
    if (grid == 0) {
        if (n_in != 23 || out_size != M * DM || ws_size < WS_END) { fprintf(stderr, "kernel_launch: unexpected shapes (n_in %d out %d ws %zu)\n", n_in, out_size, ws_size); grid = -1; return; }
        int dev = 0, cus = 0, per_cu = 0;
        if (hipGetDevice(&dev) != hipSuccess || hipDeviceGetAttribute(&cus, hipDeviceAttributeMultiprocessorCount, dev) != hipSuccess) { grid = -1; return; }
        if (hipFuncSetAttribute((const void*)mk_fwd, hipFuncAttributeMaxDynamicSharedMemorySize, LDS_BYTES) != hipSuccess) { fprintf(stderr, "kernel_launch: hipFuncSetAttribute failed\n"); grid = -1; return; }
        if (hipOccupancyMaxActiveBlocksPerMultiprocessor(&per_cu, (const void*)mk_fwd, 512, LDS_BYTES) != hipSuccess || per_cu < 1) { fprintf(stderr, "kernel_launch: occupancy query says %d\n", per_cu); per_cu = 1; }
        (void)hipGetLastError();
        grid = cus;
        if (grid > 256) grid = 256;
        grid -= grid % 8;
    }
    if (grid < 0) return;
    (void)hipMemsetAsync((char*)d_ws + WS_CTL, 0, CTL_ZERO_BYTES, stream);
    Args a{};
    for (int i = 0; i < 23; ++i) a.in[i] = (const float*)d_in[i];
    a.out = (float*)d_out; a.ws = (unsigned char*)d_ws;
#if MK_ONE_LAUNCH
    a.ph_lo = 0; a.ph_hi = NPHASE;
    hipLaunchKernelGGL(mk_fwd, dim3(grid), dim3(512), LDS_BYTES, stream, a);
#else
    for (int ph = 0; ph < NPHASE; ++ph) { a.ph_lo = ph; a.ph_hi = ph + 1; hipLaunchKernelGGL(mk_fwd, dim3(grid), dim3(512), LDS_BYTES, stream, a); }
#endif
}
```

```cpp
#include <hip/hip_runtime.h>
#include <hip/hip_bf16.h>
#include <cstdio>
#include <cstdint>
#include <cmath>

#ifndef MK_ONE_LAUNCH
#define MK_ONE_LAUNCH 1
#endif

constexpr int BATCH = 8, SEQ = 2048, DM = 1024, M = BATCH * SEQ, DFF = 2816, PLED = 256;
constexpr float EPS = 1e-6f;

namespace pg8 {
#define PG8_LAS __attribute__((address_space(3)))
typedef unsigned short bf16_t;
typedef short bf16x8 __attribute__((ext_vector_type(8)));
typedef float f32x4 __attribute__((ext_vector_type(4)));
typedef unsigned u32x4 __attribute__((ext_vector_type(4)));
typedef unsigned u32x2 __attribute__((ext_vector_type(2)));
constexpr int BM = 256, BK = 64, HALF = 128, HTB = HALF * BK * 2, STAGE_BYTES = 8 * HTB, NXCD = 8, WGM = 8;

__host__ __device__ __forceinline__ int lds_byte(int r, int c) { const int st = (r >> 4) * 2 + (c >> 5), rr = r & 15, cc = c & 31, ob = rr * 64 + cc * 2; return st * 1024 + (ob ^ (((ob >> 9) & 1) << 5)); }
__host__ __device__ __forceinline__ void stage_rc(int b, int& R, int& C) { const int st = b / 1024, sb = b % 1024, swz = sb ^ (((sb >> 9) & 1) << 5); R = (st >> 1) * 16 + swz / 64; C = (st & 1) * 32 + (swz % 64) / 2; }
__host__ __device__ __forceinline__ int perm32(int rho) { const int n = rho >> 4, i = rho & 15; return 8 * (i >> 2) + 4 * n + (i & 3); }

struct Unit { int pm, pn; };
struct Gemm { const bf16_t* A; const bf16_t* A2; const bf16_t* Bt; int M, N, K, lda, ldb, pn_split; };

struct StaticOrder {
    int nM, nN, nwg, G, c;
    __host__ __device__ void init(int M_, int N_, int G_, int c_) { nM = M_ / BM; nN = N_ / BM; nwg = nM * nN; G = G_; c = c_; }
    __host__ __device__ bool next(int i, Unit& u) const {
        const long L = (long)i * G + c; if (L >= nwg) return false;
        int wgid = (int)L; { const int q = nwg / NXCD, r = nwg % NXCD, xcd = wgid % NXCD, off = wgid / NXCD; wgid = (xcd < r ? xcd * (q + 1) : r * (q + 1) + (xcd - r) * q) + off; }
        const int nig = WGM * nN, gid = wgid / nig, fm = gid * WGM, gsz = (nM - fm) < WGM ? (nM - fm) : WGM;
        u.pm = fm + ((wgid % nig) % gsz); u.pn = (wgid % nig) / gsz; return true;
    }
    __device__ __forceinline__ void a_ready(const Unit&) const {}
    __device__ __forceinline__ void done(const Unit&) const {}
};

__device__ __forceinline__ unsigned cvt_pk_bf16(float lo, float hi) { unsigned r; asm volatile("v_cvt_pk_bf16_f32 %0, %1, %2" : "=v"(r) : "v"(lo), "v"(hi)); return r; }

template <class Epi, class Sched, bool ALIGN_EPI = false, bool SP2 = false>
__device__ __forceinline__ void gemm_phase(PG8_LAS unsigned char* lds, const Gemm g, const Sched& S, const Epi& E, const int tid) {
    const int wid = __builtin_amdgcn_readfirstlane(tid >> 6), lane = tid & 63, wr = wid >> 2, wc = wid & 3, fr = lane & 15, fq = lane >> 4;
    const int K = g.K, nt = K / BK;
    unsigned voffA[2], voffB[2];
#pragma unroll
    for (int i = 0; i < 2; ++i) { int R, C; stage_rc(tid * 16 + i * 8192, R, C); const int Rb = Epi::PERM ? ((R & ~31) + perm32(R & 31)) : R;
        voffA[i] = (unsigned)(R * g.lda + C) * 2u; voffB[i] = (unsigned)(Rb * g.ldb + C) * 2u; }
    const size_t kstep = (size_t)(BK * 2);
    const size_t hstepA = (size_t)HALF * g.lda * 2, hstepB = (size_t)HALF * g.ldb * 2;
    const size_t tstepA = 2 * hstepA, tstepB = 2 * hstepB;
    const unsigned ldsw = (unsigned)wid * 1024u;
    const int aoff = lds_byte(wr * 64 + fr, fq * 8), boff = lds_byte(wc * 32 + fr, fq * 8);
#define PG8_SA(b, h) (((b) * 2 + (h)) * HTB)
#define PG8_SB(b, h) ((4 + (b) * 2 + (h)) * HTB)
#define PG8_STAGE(bufoff, gbase, voff) do { _Pragma("unroll") for (int _i = 0; _i < 2; ++_i) \
        __builtin_amdgcn_global_load_lds((const unsigned*)((const char*)(gbase) + (voff)[_i]), (PG8_LAS unsigned*)(lds + (bufoff) + ldsw + _i * 8192), 16, 0, 0); } while (0)
#define PG8_LDA(dst, b, h) do { _Pragma("unroll") for (int m = 0; m < 4; ++m) _Pragma("unroll") for (int k = 0; k < 2; ++k) dst[m][k] = *(const PG8_LAS bf16x8*)(lds + PG8_SA(b, h) + aoff + m * 2048 + k * 1024); } while (0)
#define PG8_LDB(dst, b, h) do { _Pragma("unroll") for (int n = 0; n < 2; ++n) _Pragma("unroll") for (int k = 0; k < 2; ++k) dst[n][k] = *(const PG8_LAS bf16x8*)(lds + PG8_SB(b, h) + boff + n * 2048 + k * 1024); } while (0)
#define PG8_MMA(ai, bj, At, Bt) do { __builtin_amdgcn_s_setprio(1); _Pragma("unroll") for (int m = 0; m < 4; ++m) _Pragma("unroll") for (int n = 0; n < 2; ++n) _Pragma("unroll") for (int k = 0; k < 2; ++k) \
        acc[ai][bj][m][n] = __builtin_amdgcn_mfma_f32_16x16x32_bf16(Bt[n][k], At[m][k], acc[ai][bj][m][n], 0, 0, 0); __builtin_amdgcn_s_setprio(0); } while (0)
#define PG8_WAIT_V(n) asm volatile("s_waitcnt vmcnt(" #n ")" ::: "memory")
#define PG8_WAIT_L(n) asm volatile("s_waitcnt lgkmcnt(" #n ")" ::: "memory")
#define PG8_BAR __builtin_amdgcn_s_barrier()
#define PG8_SCHED __builtin_amdgcn_sched_barrier(0)
#define PG8_ABASE(u) ((const char*)(((u).pn >= g.pn_split) ? g.A2 : g.A) + (size_t)(u).pm * tstepA)
    Unit cur, nxt; int ui = 0;
    if (!S.next(0, cur)) return;
    f32x4 acc[2][2][4][2];
#pragma unroll
    for (int a = 0; a < 2; ++a)
#pragma unroll
        for (int b = 0; b < 2; ++b)
#pragma unroll
            for (int m = 0; m < 4; ++m)
#pragma unroll
                for (int n = 0; n < 2; ++n) acc[a][b][m][n] = (f32x4){0.f, 0.f, 0.f, 0.f};
    bf16x8 At[4][2], B0[2][2], B1[2][2];
    const char* cA = PG8_ABASE(cur); const char* cB = (const char*)g.Bt + (size_t)cur.pn * tstepB;
    S.a_ready(cur);
    if constexpr (SP2) {
        PG8_STAGE(PG8_SB(0, 0), cB, voffB); PG8_STAGE(PG8_SB(0, 1), cB + hstepB, voffB); PG8_STAGE(PG8_SA(0, 0), cA, voffA); PG8_STAGE(PG8_SA(0, 1), cA + hstepA, voffA);
        if (wr == 1) PG8_BAR;
        PG8_WAIT_V(2); PG8_BAR;
        PG8_STAGE(PG8_SB(1, 0), cB + kstep, voffB); PG8_STAGE(PG8_SA(1, 0), cA + kstep, voffA); PG8_STAGE(PG8_SB(1, 1), cB + hstepB + kstep, voffB);
        PG8_WAIT_V(6); PG8_BAR;
    } else {
        PG8_STAGE(PG8_SB(0, 0), cB, voffB); PG8_STAGE(PG8_SA(0, 0), cA, voffA); PG8_STAGE(PG8_SB(0, 1), cB + hstepB, voffB); PG8_STAGE(PG8_SA(0, 1), cA + hstepA, voffA);
        if (wr == 1) PG8_BAR;
        PG8_WAIT_V(4); PG8_BAR;
        PG8_STAGE(PG8_SB(1, 0), cB + kstep, voffB); PG8_STAGE(PG8_SA(1, 0), cA + kstep, voffA); PG8_STAGE(PG8_SB(1, 1), cB + hstepB + kstep, voffB);
        PG8_WAIT_V(6); PG8_BAR;
    }
    for (;;) {
        const bool has_next = S.next(ui + 1, nxt);
        const char* nA = has_next ? PG8_ABASE(nxt) : cA; const char* nB = has_next ? (const char*)g.Bt + (size_t)nxt.pn * tstepB : cB;
        for (int t = 0; t < nt; t += 2) {
            const bool last = (t == nt - 2);
            const char* a1 = cA + (size_t)(t + 1) * kstep;
            const char* a2 = last ? nA : cA + (size_t)(t + 2) * kstep; const char* b2 = last ? nB : cB + (size_t)(t + 2) * kstep;
            const char* a3 = a2 + kstep; const char* b3 = b2 + kstep;
            if (last && has_next) S.a_ready(nxt);
            if constexpr (SP2) {
            PG8_LDB(B0, 0, 0); PG8_LDB(B1, 0, 1); PG8_SCHED; PG8_LDA(At, 0, 0); PG8_STAGE(PG8_SA(1, 1), a1 + hstepA, voffA);
            PG8_WAIT_V(8); PG8_WAIT_L(0); PG8_BAR; PG8_MMA(0, 0, At, B0); PG8_MMA(0, 1, At, B1); PG8_BAR; PG8_SCHED;
            PG8_LDA(At, 0, 1); PG8_STAGE(PG8_SB(0, 0), b2, voffB); PG8_STAGE(PG8_SB(0, 1), b2 + hstepB, voffB); PG8_STAGE(PG8_SA(0, 0), a2, voffA);
            PG8_WAIT_V(8); PG8_WAIT_L(0); PG8_BAR; PG8_MMA(1, 0, At, B0); PG8_MMA(1, 1, At, B1); PG8_BAR; PG8_SCHED;
            PG8_LDB(B0, 1, 0); PG8_LDB(B1, 1, 1); PG8_SCHED; PG8_LDA(At, 1, 0); PG8_STAGE(PG8_SA(0, 1), a2 + hstepA, voffA);
            PG8_WAIT_V(8); PG8_WAIT_L(0); PG8_BAR; PG8_MMA(0, 0, At, B0); PG8_MMA(0, 1, At, B1); PG8_BAR; PG8_SCHED;
            PG8_LDA(At, 1, 1); PG8_STAGE(PG8_SB(1, 0), b3, voffB); PG8_STAGE(PG8_SB(1, 1), b3 + hstepB, voffB); PG8_STAGE(PG8_SA(1, 0), a3, voffA);
            PG8_WAIT_V(8); PG8_WAIT_L(0); PG8_BAR; PG8_MMA(1, 0, At, B0); PG8_MMA(1, 1, At, B1); PG8_BAR; PG8_SCHED;
            } else {
            PG8_LDB(B0, 0, 0); PG8_SCHED; PG8_LDA(At, 0, 0); PG8_STAGE(PG8_SA(1, 1), a1 + hstepA, voffA);
            PG8_WAIT_L(8); PG8_BAR; PG8_WAIT_L(0); PG8_MMA(0, 0, At, B0); PG8_BAR; PG8_SCHED;
            PG8_LDB(B1, 0, 1); PG8_STAGE(PG8_SB(0, 0), b2, voffB);
            PG8_BAR; PG8_WAIT_L(0); PG8_MMA(0, 1, At, B1); PG8_BAR;
            PG8_LDA(At, 0, 1); PG8_STAGE(PG8_SA(0, 0), a2, voffA);
            PG8_BAR; PG8_WAIT_L(0); PG8_MMA(1, 0, At, B0); PG8_BAR; PG8_SCHED;
            PG8_STAGE(PG8_SB(0, 1), b2 + hstepB, voffB);
            PG8_WAIT_V(6); PG8_BAR; PG8_MMA(1, 1, At, B1); PG8_BAR;
            PG8_LDB(B0, 1, 0); PG8_SCHED; PG8_LDA(At, 1, 0); PG8_STAGE(PG8_SA(0, 1), a2 + hstepA, voffA);
            PG8_WAIT_L(8); PG8_BAR; PG8_WAIT_L(0); PG8_MMA(0, 0, At, B0); PG8_BAR; PG8_SCHED;
            PG8_LDB(B1, 1, 1); PG8_STAGE(PG8_SB(1, 0), b3, voffB);
            PG8_BAR; PG8_WAIT_L(0); PG8_MMA(0, 1, At, B1); PG8_BAR;
            PG8_LDA(At, 1, 1); PG8_STAGE(PG8_SA(1, 0), a3, voffA);
            PG8_BAR; PG8_WAIT_L(0); PG8_MMA(1, 0, At, B0); PG8_BAR; PG8_SCHED;
            PG8_STAGE(PG8_SB(1, 1), b3 + hstepB, voffB);
            PG8_WAIT_V(6); PG8_BAR; PG8_MMA(1, 1, At, B1); PG8_BAR;
            }
        }
        if constexpr (ALIGN_EPI) { if (wr == 0) PG8_BAR; }
        E(acc, cur, wr, wc, fr, fq);
        if (!has_next) break;
#pragma unroll
        for (int a = 0; a < 2; ++a)
#pragma unroll
            for (int b = 0; b < 2; ++b)
#pragma unroll
                for (int m = 0; m < 4; ++m)
#pragma unroll
                    for (int n = 0; n < 2; ++n) acc[a][b][m][n] = (f32x4){0.f, 0.f, 0.f, 0.f};
        cur = nxt; cA = nA; cB = nB; ++ui;
        if constexpr (ALIGN_EPI) { if (wr == 1) PG8_BAR; }
    }
    PG8_WAIT_V(0);
    if constexpr (!ALIGN_EPI) { if (wr == 0) PG8_BAR; }
    PG8_BAR;
#undef PG8_SA
#undef PG8_SB
#undef PG8_STAGE
#undef PG8_LDA
#undef PG8_LDB
#undef PG8_MMA
#undef PG8_WAIT_V
#undef PG8_WAIT_L
#undef PG8_BAR
#undef PG8_SCHED
#undef PG8_ABASE
}
}

using pg8::bf16_t; using pg8::f32x4; using pg8::u32x4; using pg8::u32x2; using pg8::Unit; using pg8::cvt_pk_bf16;

#define GAS __attribute__((address_space(1)))
#define LAS __attribute__((address_space(3)))
typedef GAS unsigned gu32;
#define RLX_AGENT __ATOMIC_RELAXED, __HIP_MEMORY_SCOPE_AGENT

constexpr size_t MiB = 1u << 20;
constexpr size_t WS_CTL = 0, CTL_ZERO_BYTES = 1 * MiB;
constexpr size_t WS_SSQ = 1 * MiB;
constexpr size_t WS_LF = 2 * MiB;
constexpr size_t WS_CUM = 3 * MiB;
constexpr size_t WS_ROPE = 4 * MiB;
constexpr size_t WS_BIASD = WS_ROPE + 256 * 1024;
constexpr size_t WS_KMP = WS_BIASD + 64 * 1024;
constexpr size_t WS_SSQCQ = WS_KMP + 256 * 1024;
constexpr size_t WS_SSQCKV = WS_SSQCQ + 256 * 1024;
constexpr size_t WS_KR = WS_SSQCKV + 256 * 1024;
constexpr size_t WS_W = 7 * MiB;
constexpr size_t SZ_WFI = (size_t)2 * DFF * DM * 2, SZ_WFO = (size_t)DM * DFF * 2;
constexpr size_t WS_WFI = WS_W;
constexpr size_t WS_WFO = WS_WFI + 4 * SZ_WFI;
constexpr size_t WS_WABI = WS_WFO + 4 * SZ_WFO;
constexpr size_t WS_WUP = WS_WABI + (size_t)2048 * 1024 * 2;
constexpr size_t WS_WABO = WS_WUP + (size_t)1792 * 256 * 2;
constexpr size_t WS_WFXI = WS_WABO + (size_t)1024 * 1024 * 2;
constexpr size_t WS_WFXO = WS_WFXI + (size_t)3072 * 1024 * 2;
constexpr size_t WS_WG = WS_WFXO + (size_t)1024 * 1024 * 2;
constexpr size_t WS_WP = WS_WG + (size_t)2 * 1024 * 1024 * 2;
constexpr size_t WS_WEND = WS_WP + (size_t)2 * 1024 * 256 * 2;
constexpr size_t WS_XB = 96 * MiB;
constexpr size_t WS_R = 128 * MiB;
constexpr size_t WS_PB = 248 * MiB;
constexpr size_t WS_END = 256 * MiB;
static_assert(WS_WEND <= WS_XB, "weights fit");
constexpr size_t R_H = 0;
constexpr size_t R_ZZ = 0;
constexpr size_t R_QMLA = 64 * MiB;
constexpr size_t R_KVMLA = 88 * MiB;
constexpr size_t R_QKV = 0;
constexpr size_t R_PP = 0;

constexpr int CW_BAR = 4096;

constexpr int RING_BYTES = 131072;
constexpr int LDSCTL_OFF = RING_BYTES, MISC_OFF = LDSCTL_OFF + 320;
constexpr int LDS_BYTES = 147456;

#define XB_TMO      128
#define XB_XCNT(j)  (256  + 64 * (j))
#define XB_XSUB(j)  (1280 + 64 * (j))
#define XB_XGEN(j)  (2304 + 64 * (j))
#define XB_TOP      3328
#define XB_TOPGEN   3392
#define XCD_BAR_WORDS 3456
#define XB_SPIN_CAP (1u << 22)
__device__ __forceinline__ unsigned xb_ld(unsigned* p)              { return __hip_atomic_load(p, __ATOMIC_RELAXED, __HIP_MEMORY_SCOPE_AGENT); }
__device__ __forceinline__ unsigned xb_add(unsigned* p, unsigned v) { return __hip_atomic_fetch_add(p, v, __ATOMIC_RELAXED, __HIP_MEMORY_SCOPE_AGENT); }
__device__ __forceinline__ unsigned xb_xcc_id() { return (unsigned)__builtin_amdgcn_s_getreg((3 << 11) | 20) & 0xFu; }
#define XB_SPIN(cond, bar) do { unsigned _sp = 0; while (cond) { __builtin_amdgcn_s_sleep(1); \
    if ((++_sp & 255u) == 0u) { if (xb_ld(&(bar)[XB_TMO])) break; if (_sp > XB_SPIN_CAP) { atomicAdd(&(bar)[XB_TMO], 1u); break; } } } } while (0)
struct XcdBarrier { unsigned* bar; unsigned x; volatile LAS unsigned* st; };
__device__ __forceinline__ XcdBarrier xcd_barrier_post(unsigned* bar, volatile LAS unsigned* st) {
    XcdBarrier b; b.bar = bar; b.x = xb_xcc_id(); b.st = st;
    if (threadIdx.x == 0) (void)xb_add(&bar[XB_XCNT(b.x)], 1u);
    return b;
}
__device__ __forceinline__ void xcd_barrier_complete(unsigned* bar, unsigned x, unsigned& nloc, unsigned& nx) {
    const unsigned G = gridDim.x * gridDim.y * gridDim.z;
    unsigned sum, cnt, mine, sp = 0u;
    for (;;) {
        sum = 0u; cnt = 0u; mine = 0u;
#pragma unroll
        for (unsigned j = 0; j < 16; ++j) { const unsigned c = xb_ld(&bar[XB_XCNT(j)]); sum += c; cnt += (c > 0u) ? 1u : 0u; mine = (j == x) ? c : mine; }
        if (sum == G) break;
        __builtin_amdgcn_s_sleep(1);
        if ((++sp & 255u) == 0u) { if (xb_ld(&bar[XB_TMO])) break; if (sp > XB_SPIN_CAP) { atomicAdd(&bar[XB_TMO], 1u); break; } }
    }
    nloc = mine > 0u ? mine : 1u; nx = cnt > 0u ? cnt : 1u;
}
__device__ __forceinline__ void xcd_barrier(const XcdBarrier& b) {
    asm volatile("s_waitcnt vmcnt(0)" ::: "memory");
    __syncthreads();
    if (threadIdx.x == 0) {
        unsigned* bar = b.bar;
        __builtin_amdgcn_s_waitcnt(0);
        unsigned nloc = b.st[0], nx = b.st[1];
        if (nloc == 0u) { xcd_barrier_complete(bar, b.x, nloc, nx); b.st[0] = nloc; b.st[1] = nx; }
        const unsigned old = xb_add(&bar[XB_XSUB(b.x)], 1u);
        const unsigned gen = old / nloc;
        if (old + 1u == (gen + 1u) * nloc) {
            __builtin_amdgcn_fence(__ATOMIC_RELEASE, "agent");
            asm volatile("s_waitcnt vmcnt(0)" ::: "memory");
            const unsigned og = xb_add(&bar[XB_TOP], 1u);
            const unsigned tg = og / nx;
            if (og + 1u == (tg + 1u) * nx) xb_add(&bar[XB_TOPGEN], 1u);
            else XB_SPIN(xb_ld(&bar[XB_TOPGEN]) == tg, bar);
            __builtin_amdgcn_fence(__ATOMIC_ACQUIRE, "agent");
            xb_add(&bar[XB_XGEN(b.x)], 1u);
            asm volatile("s_waitcnt vmcnt(0)" ::: "memory");
        } else {
            XB_SPIN(xb_ld(&bar[XB_XGEN(b.x)]) == gen, bar);
            __builtin_amdgcn_fence(__ATOMIC_ACQUIRE, "agent");
            asm volatile("s_waitcnt vmcnt(0)" ::: "memory");
        }
    }
    __syncthreads();
}

__device__ __forceinline__ unsigned f2bf(float f) { unsigned u = __builtin_bit_cast(unsigned, f); return (u + 0x7fffu + ((u >> 16) & 1u)) >> 16; }
__device__ __forceinline__ unsigned pk2(float lo, float hi) { return f2bf(lo) | (f2bf(hi) << 16); }
__device__ __forceinline__ float bf2f(unsigned short b) { return __builtin_bit_cast(float, (unsigned)b << 16); }
__device__ __forceinline__ float wave_sum(float v) {
#pragma unroll
    for (int o = 1; o < 64; o <<= 1) v += __shfl_xor(v, o);
    return v;
}
__device__ __forceinline__ float sum4(f32x4 a) { return (a.x + a.y) + (a.z + a.w); }
__device__ __forceinline__ float rstd_from16(const float* ssq, int row) {
    const f32x4* p = (const f32x4*)(ssq + (size_t)row * 16);
    const float s = (sum4(p[0]) + sum4(p[1])) + (sum4(p[2]) + sum4(p[3]));
    return rsqrtf(s * (1.f / 1024.f) + EPS);
}
__device__ __forceinline__ float rstd_from4(const float* ssq, int row, float invn) {
    const f32x4 a = *(const f32x4*)(ssq + (size_t)row * 4);
    return rsqrtf(sum4(a) * invn + EPS);
}
__device__ __forceinline__ float sigmoidf_(float a) { return __builtin_amdgcn_rcpf(1.f + __expf(-a)); }

struct EpiSwiglu {
    static constexpr bool PERM = true;
    bf16_t* H; const float* ssq;
    __device__ __forceinline__ void operator()(const f32x4 (&acc)[2][2][4][2], const Unit& u, int wr, int wc, int fr, int fq) const {
        const int row0 = u.pm * 256 + wr * 64 + fr, col0 = u.pn * 128 + wc * 32 + 8 * fq;
#pragma unroll
        for (int ai = 0; ai < 2; ++ai)
#pragma unroll
            for (int m = 0; m < 4; ++m) {
                const int row = row0 + ai * 128 + m * 16; const float rs = rstd_from16(ssq, row);
                float h[8];
#pragma unroll
                for (int n = 0; n < 2; ++n)
#pragma unroll
                    for (int j = 0; j < 4; ++j) { const float a = acc[ai][0][m][n][j] * rs, uu = acc[ai][1][m][n][j] * rs; h[n * 4 + j] = a * sigmoidf_(a) * uu; }
                u32x4 w; w.x = cvt_pk_bf16(h[0], h[1]); w.y = cvt_pk_bf16(h[2], h[3]); w.z = cvt_pk_bf16(h[4], h[5]); w.w = cvt_pk_bf16(h[6], h[7]);
                *(u32x4*)(H + (size_t)row * DFF + col0) = w;
            }
    }
};

struct EpiRes {
    static constexpr bool PERM = false;
    float* x; bf16_t* xb; float* ssq_out; const float* ssq_in; const bf16_t* pp; float alpha; int mode;
    __device__ __forceinline__ void operator()(const f32x4 (&acc)[2][2][4][2], const Unit& u, int wr, int wc, int fr, int fq) const {
        const int row0 = u.pm * 256 + wr * 64 + fr, col0 = u.pn * 256 + wc * 32 + 4 * fq;
#pragma unroll
        for (int ai = 0; ai < 2; ++ai)
#pragma unroll
            for (int m = 0; m < 4; ++m) {
                const int row = row0 + ai * 128 + m * 16; float q = 0.f;
                float rs = 1.f; if (mode == 1) rs = rstd_from16(ssq_in, row);
#pragma unroll
                for (int bj = 0; bj < 2; ++bj)
#pragma unroll
                    for (int n = 0; n < 2; ++n) {
                        const size_t off = (size_t)row * DM + col0 + bj * 128 + n * 16;
                        const f32x4 xo = *(const f32x4*)(x + off); f32x4 xn;
                        if (mode == 1) { const u32x2 pw = *(const u32x2*)(pp + off);
                            const float p0 = __builtin_bit_cast(float, pw.x << 16), p1 = __builtin_bit_cast(float, pw.x & 0xffff0000u), p2 = __builtin_bit_cast(float, pw.y << 16), p3 = __builtin_bit_cast(float, pw.y & 0xffff0000u);
                            const f32x4 a = acc[ai][bj][m][n] * rs;
                            xn.x = xo.x + sigmoidf_(a.x) * p0; xn.y = xo.y + sigmoidf_(a.y) * p1; xn.z = xo.z + sigmoidf_(a.z) * p2; xn.w = xo.w + sigmoidf_(a.w) * p3;
                        } else xn = xo + acc[ai][bj][m][n] * alpha;
                        *(f32x4*)(x + off) = xn;
                        u32x2 w; w.x = cvt_pk_bf16(xn.x, xn.y); w.y = cvt_pk_bf16(xn.z, xn.w); *(u32x2*)(xb + off) = w;
                        q += (xn.x * xn.x + xn.y * xn.y) + (xn.z * xn.z + xn.w * xn.w);
                    }
                q += __shfl_xor(q, 16); q += __shfl_xor(q, 32);
                if (fq == 0) ssq_out[(size_t)row * 16 + u.pn * 4 + wc] = q;
            }
    }
};

struct EpiStoreT {
    static constexpr bool PERM = true;
    bf16_t* O; int ldo; const float* ssq;
    __device__ __forceinline__ void operator()(const f32x4 (&acc)[2][2][4][2], const Unit& u, int wr, int wc, int fr, int fq) const {
        const int row0 = u.pm * 256 + wr * 64 + fr, col0 = u.pn * 256 + wc * 32 + 8 * fq;
#pragma unroll
        for (int ai = 0; ai < 2; ++ai)
#pragma unroll
            for (int m = 0; m < 4; ++m) {
                const int row = row0 + ai * 128 + m * 16; const float rs = rstd_from16(ssq, row);
#pragma unroll
                for (int bj = 0; bj < 2; ++bj) { const f32x4 v0 = acc[ai][bj][m][0] * rs, v1 = acc[ai][bj][m][1] * rs;
                    u32x4 w; w.x = cvt_pk_bf16(v0.x, v0.y); w.y = cvt_pk_bf16(v0.z, v0.w); w.z = cvt_pk_bf16(v1.x, v1.y); w.w = cvt_pk_bf16(v1.z, v1.w);
                    *(u32x4*)(O + (size_t)row * ldo + col0 + bj * 128) = w; }
            }
    }
};

struct EpiStoreF {
    static constexpr bool PERM = false;
    int mode; bf16_t* O; bf16_t* O2; const float* ssq; float* ssq_cq; float* ssq_ckv; bf16_t* kr; float* kmp; const float* rope;
    __device__ __forceinline__ void operator()(const f32x4 (&acc)[2][2][4][2], const Unit& u, int wr, int wc, int fr, int fq) const {
        const int row0 = u.pm * 256 + wr * 64 + fr;
        float colsum[2][2][4];
#pragma unroll
        for (int bj = 0; bj < 2; ++bj)
#pragma unroll
            for (int n = 0; n < 2; ++n)
#pragma unroll
                for (int j = 0; j < 4; ++j) colsum[bj][n][j] = 0.f;
#pragma unroll
        for (int ai = 0; ai < 2; ++ai)
#pragma unroll
            for (int m = 0; m < 4; ++m) {
                const int row = row0 + ai * 128 + m * 16;
                float rs = 1.f;
                if (mode == 0) rs = rstd_from16(ssq, row);
                else if (mode == 1) rs = (u.pn < 3) ? rstd_from4(ssq_cq, row, 1.f / 256.f) : rstd_from4(ssq_ckv, row, 1.f / 128.f);
                f32x4 v[2][2];
#pragma unroll
                for (int bj = 0; bj < 2; ++bj)
#pragma unroll
                    for (int n = 0; n < 2; ++n) v[bj][n] = acc[ai][bj][m][n] * rs;
                bf16_t* orow; int ocol;
                if (mode == 0) { orow = O + (size_t)row * 2048; ocol = u.pn * 256 + wc * 32 + 4 * fq; }
                else if (mode == 1) { if (u.pn < 3) { orow = O + (size_t)row * 768; ocol = u.pn * 256 + wc * 32 + 4 * fq; } else { orow = O2 + (size_t)row * 1024; ocol = (u.pn - 3) * 256 + wc * 32 + 4 * fq; } }
                else { orow = O + (size_t)row * 1024; ocol = u.pn * 256 + wc * 32 + 4 * fq; }
                if (mode == 0) {
                    if (u.pn == 2) { float q = 0.f;
#pragma unroll
                        for (int bj = 0; bj < 2; ++bj)
#pragma unroll
                            for (int n = 0; n < 2; ++n) q += (v[bj][n].x * v[bj][n].x + v[bj][n].y * v[bj][n].y) + (v[bj][n].z * v[bj][n].z + v[bj][n].w * v[bj][n].w);
                        q += __shfl_xor(q, 16); q += __shfl_xor(q, 32); if (fq == 0) ssq_cq[(size_t)row * 4 + wc] = q; }
                    if (u.pn == 3) { float q = 0.f;
#pragma unroll
                        for (int n = 0; n < 2; ++n) q += (v[0][n].x * v[0][n].x + v[0][n].y * v[0][n].y) + (v[0][n].z * v[0][n].z + v[0][n].w * v[0][n].w);
                        q += __shfl_xor(q, 16); q += __shfl_xor(q, 32); if (fq == 0) ssq_ckv[(size_t)row * 4 + wc] = q;
                        if (wc == 0) {
                            const int pos = row & (SEQ - 1);
                            const f32x4 cs = *(const f32x4*)(rope + (size_t)pos * 16 + 4 * fq), sn = *(const f32x4*)(rope + (size_t)SEQ * 16 + (size_t)pos * 16 + 4 * fq);
                            const f32x4 x1 = v[1][0], x2 = v[1][1];
                            const f32x4 y1 = x1 * cs - x2 * sn, y2 = x1 * sn + x2 * cs;
                            u32x2 w1, w2; w1.x = cvt_pk_bf16(y1.x, y1.y); w1.y = cvt_pk_bf16(y1.z, y1.w); w2.x = cvt_pk_bf16(y2.x, y2.y); w2.y = cvt_pk_bf16(y2.z, y2.w);
                            *(u32x2*)(kr + (size_t)row * 32 + 4 * fq) = w1; *(u32x2*)(kr + (size_t)row * 32 + 16 + 4 * fq) = w2;
                        } }
                    if (u.pn == 4 || u.pn == 5) {
#pragma unroll
                        for (int bj = 0; bj < 2; ++bj)
#pragma unroll
                            for (int n = 0; n < 2; ++n) { colsum[bj][n][0] += v[bj][n].x; colsum[bj][n][1] += v[bj][n].y; colsum[bj][n][2] += v[bj][n].z; colsum[bj][n][3] += v[bj][n].w; }
                    }
                }
                if (mode == 1 && u.pn < 3) {
#pragma unroll
                    for (int bj = 0; bj < 2; ++bj) {
                        const int g32 = u.pn * 8 + bj * 4 + wc;
                        if (g32 % 3 == 2) {
                            const int pos = row & (SEQ - 1);
                            const f32x4 cs = *(const f32x4*)(rope + (size_t)pos * 16 + 4 * fq), sn = *(const f32x4*)(rope + (size_t)SEQ * 16 + (size_t)pos * 16 + 4 * fq);
                            const f32x4 x1 = v[bj][0], x2 = v[bj][1];
                            v[bj][0] = x1 * cs - x2 * sn; v[bj][1] = x1 * sn + x2 * cs;
                        }
                    }
                }
#pragma unroll
                for (int bj = 0; bj < 2; ++bj)
#pragma unroll
                    for (int n = 0; n < 2; ++n) { u32x2 w; w.x = cvt_pk_bf16(v[bj][n].x, v[bj][n].y); w.y = cvt_pk_bf16(v[bj][n].z, v[bj][n].w);
                        *(u32x2*)(orow + ocol + bj * 128 + n * 16) = w; }
            }
        if (mode == 0 && (u.pn == 4 || u.pn == 5)) {
#pragma unroll
            for (int bj = 0; bj < 2; ++bj)
#pragma unroll
                for (int n = 0; n < 2; ++n)
#pragma unroll
                    for (int j = 0; j < 4; ++j) { float s = colsum[bj][n][j];
                        s += __shfl_xor(s, 1); s += __shfl_xor(s, 2); s += __shfl_xor(s, 4); s += __shfl_xor(s, 8);
                        if (fr == 0) kmp[((size_t)u.pm * 2 + wr) * 512 + (u.pn - 4) * 256 + bj * 128 + wc * 32 + n * 16 + 4 * fq + j] = s; }
        }
    }
};

struct Args {
    const float* in[23]; float* out; unsigned char* ws; int ph_lo, ph_hi;
};
struct Frame {
    LAS unsigned char* lds; unsigned char* ldsg; volatile LAS unsigned* MISC; gu32* ctl;
    int tid, lane, wave, vcu, G;
    unsigned char* ws; float* x;
};

__device__ __forceinline__ void conv_item(const float* W, int ldw, int sc0, const float* gain, bf16_t* WT, int ldt, int n0, int k0, LAS float* scr, int lane) {
#pragma unroll 8
    for (int i = 0; i < 32; ++i) { const int kk = 2 * i + (lane >> 5);
        float v = 0.f; if (sc0 >= 0) { v = W[(size_t)(k0 + kk) * ldw + sc0 + (lane & 31)]; if (gain) v *= gain[k0 + kk]; }
        scr[kk * 33 + (lane & 31)] = v; }
    asm volatile("s_waitcnt lgkmcnt(0)" ::: "memory");
    const int c = lane & 7;
#pragma unroll
    for (int j = 0; j < 4; ++j) { const int n = (lane >> 3) + 8 * j; const LAS float* s = scr + (8 * c) * 33 + n;
        u32x4 o; o.x = pk2(s[0 * 33], s[1 * 33]); o.y = pk2(s[2 * 33], s[3 * 33]); o.z = pk2(s[4 * 33], s[5 * 33]); o.w = pk2(s[6 * 33], s[7 * 33]);
        *(u32x4*)(WT + (size_t)(n0 + n) * ldt + k0 + 8 * c) = o; }
    asm volatile("s_waitcnt lgkmcnt(0)" ::: "memory");
}

struct ConvJob { const float* W; int ldw; const float* gain; bf16_t* WT; int K, N, kind; };
__device__ __forceinline__ ConvJob get_job(int j, const Args& a, unsigned char* ws) {
    ConvJob r;
    if (j < 12) { const int l = j / 6, t = j % 6;
        switch (t) {
        case 0: r = ConvJob{a.in[4] + (size_t)l * DM * 2 * DFF, 2 * DFF, a.in[3] + l * DM, (bf16_t*)(ws + WS_WFI + (size_t)(l * 2 + 0) * SZ_WFI), DM, 2 * DFF, 1}; break;
        case 1: r = ConvJob{a.in[8] + (size_t)l * DM * 2 * DFF, 2 * DFF, a.in[7] + l * DM, (bf16_t*)(ws + WS_WFI + (size_t)(l * 2 + 1) * SZ_WFI), DM, 2 * DFF, 1}; break;
        case 2: r = ConvJob{a.in[5] + (size_t)l * DFF * DM, DM, nullptr, (bf16_t*)(ws + WS_WFO + (size_t)(l * 2 + 0) * SZ_WFO), DFF, DM, 0}; break;
        case 3: r = ConvJob{a.in[9] + (size_t)l * DFF * DM, DM, nullptr, (bf16_t*)(ws + WS_WFO + (size_t)(l * 2 + 1) * SZ_WFO), DFF, DM, 0}; break;
        case 4: r = ConvJob{a.in[11] + (size_t)l * DM * DM, DM, a.in[10] + l * DM, (bf16_t*)(ws + WS_WG + (size_t)l * DM * DM * 2), DM, DM, 0}; break;
        default: r = ConvJob{a.in[12] + (size_t)l * PLED * DM, DM, nullptr, (bf16_t*)(ws + WS_WP + (size_t)l * DM * PLED * 2), PLED, DM, 0}; break;
        }
    } else {
        switch (j) {
        case 12: r = ConvJob{a.in[13], 1952, a.in[6], (bf16_t*)(ws + WS_WABI), DM, 2048, 2}; break;
        case 13: r = ConvJob{a.in[15], 768, a.in[14], (bf16_t*)(ws + WS_WUP), 256, 768, 0}; break;
        case 14: r = ConvJob{a.in[17], 1024, a.in[16], (bf16_t*)(ws + WS_WUP + (size_t)768 * 256 * 2), 256, 1024, 5}; break;
        case 15: r = ConvJob{a.in[18], DM, nullptr, (bf16_t*)(ws + WS_WABO), DM, DM, 0}; break;
        case 16: r = ConvJob{a.in[19], 3088, a.in[6] + DM, (bf16_t*)(ws + WS_WFXI), DM, 3072, 0}; break;
        default: r = ConvJob{a.in[21], DM, nullptr, (bf16_t*)(ws + WS_WFXO), DM, DM, 0}; break;
        }
    }
    return r;
}
__device__ __forceinline__ int conv_srccol(int kind, int n0) {
    if (kind == 1) { const int pn = n0 >> 8, j = n0 & 255; return j < 128 ? pn * 128 + j : DFF + pn * 128 + (j - 128); }
    if (kind == 2) { if (n0 < 512) return n0; if (n0 < 1024) { const int o = n0 - 512; return o < 416 ? 1536 + o : -1; } if (n0 < 1536) return 512 + (n0 - 1024); return 1024 + (n0 - 1536); }
    return n0;
}

__device__ __forceinline__ void conv_p_rows(Frame& F, const float* p, bf16_t* pb) {
    const int gw = F.vcu * 8 + F.wave, NGW = F.G * 8;
    for (int m = gw; m < M; m += NGW) { const f32x4 v = *((const f32x4*)(p + (size_t)m * PLED) + F.lane);
        u32x2 w; w.x = pk2(v.x, v.y); w.y = pk2(v.z, v.w); *((u32x2*)(pb + (size_t)m * PLED) + F.lane) = w; }
}

__device__ __forceinline__ void prologue(Frame& F, const Args& a) {
    LAS float* scr = (LAS float*)(F.lds + F.wave * 16384);
    const int gw = F.vcu * 8 + F.wave, NGW = F.G * 8;
    unsigned char* ws = F.ws;
    constexpr int nj = 18;
    int base = 0;
    for (int j = 0; j < nj; ++j) {
        const ConvJob jb = get_job(j, a, ws); const int nblk = jb.N / 32, nit = (jb.K / 64) * nblk;
        int first = (gw - base) % NGW; if (first < 0) first += NGW;
        for (int it = first; it < nit; it += NGW) {
            const int kb = it / nblk, nb = it % nblk, k0 = 64 * kb, n0 = 32 * nb;
            int sc0 = conv_srccol(jb.kind, n0);
            if (jb.kind == 5 && k0 >= 128) sc0 = -1;
            conv_item(jb.W, jb.ldw, sc0, jb.gain, jb.WT, jb.K, n0, k0, scr, F.lane);
        }
        base = (base + nit) % NGW;
    }
    {
        const float* xin = a.in[0]; float* xo = F.x; bf16_t* xb = (bf16_t*)(ws + WS_XB); float* ssq = (float*)(ws + WS_SSQ);
        for (int m = gw; m < M; m += NGW) {
            f32x4 v[4]; float s = 0.f;
#pragma unroll
            for (int j = 0; j < 4; ++j) { v[j] = *((const f32x4*)(xin + (size_t)m * DM) + F.lane + 64 * j); s += (v[j].x * v[j].x + v[j].y * v[j].y) + (v[j].z * v[j].z + v[j].w * v[j].w); }
            s = wave_sum(s);
#pragma unroll
            for (int j = 0; j < 4; ++j) { *((f32x4*)(xo + (size_t)m * DM) + F.lane + 64 * j) = v[j];
                u32x2 w; w.x = pk2(v[j].x, v[j].y); w.y = pk2(v[j].z, v[j].w); *((u32x2*)(xb + (size_t)m * DM) + F.lane + 64 * j) = w; }
            if (F.lane < 16) ssq[(size_t)m * 16 + F.lane] = (F.lane == 0) ? s : 0.f;
        }
    }
    conv_p_rows(F, a.in[1], (bf16_t*)(ws + WS_PB));
    {
        float* rope = (float*)(ws + WS_ROPE); const int gt = F.vcu * 512 + F.tid, NGT = F.G * 512;
        for (int e = gt; e < SEQ * 16; e += NGT) { const int pos = e >> 4, i = e & 15;
            const float inv = powf(10000.f, -(float)i / 16.f); const float ang = (float)pos * inv;
            rope[e] = (float)cos((double)ang); rope[SEQ * 16 + e] = (float)sin((double)ang); }
        float* biasd = (float*)(ws + WS_BIASD); const float* t5 = a.in[2];
        for (int e = gt; e < 8 * 128; e += NGT) { const int h = e >> 7, d = e & 127; int bk;
            if (d < 16) bk = d; else { bk = 16 + (int)(logf((float)d / 16.f) / 2.0794415416798357f * 16.f); if (bk > 31) bk = 31; }
            biasd[e] = t5[bk * 8 + h]; }
    }
}

constexpr int SA_HALF_FLOATS = 64 * 96 + 64 * 64 + 64 + 128;
template <int MODE> __device__ __forceinline__ void sattn_unit(Frame& F, const Args& a, int b, int h, int qb) {
    constexpr int DQ = (MODE == 1) ? 96 : 64;
    const int half = F.tid >> 8, t = F.tid & 255;
    float* ldsf = (float*)F.ldsg + half * SA_HALF_FLOATS;
    float* Ks = ldsf; float* Vs = Ks + 64 * DQ; float* Cs = Vs + 64 * 64; float* Bs = Cs + 64;
    unsigned char* ws = F.ws;
    const bf16_t *Qp, *K1, *K2 = nullptr, *Vp; bf16_t* Op; int ldq, ldk1, ldv, ldo; float scale;
    if (MODE == 0) { const bf16_t* ZZ = (const bf16_t*)(ws + WS_R + R_ZZ); Qp = ZZ + h * 64; ldq = 2048; K1 = ZZ + 1024 + h * 64; ldk1 = 2048; Vp = ZZ + 1536 + h * 64; ldv = 2048; Op = (bf16_t*)ZZ + h * 64; ldo = 2048; scale = 0.125f; }
    else if (MODE == 1) { const bf16_t* QM = (const bf16_t*)(ws + WS_R + R_QMLA); const bf16_t* KV = (const bf16_t*)(ws + WS_R + R_KVMLA);
        Qp = QM + h * 96; ldq = 768; K1 = KV + h * 128; ldk1 = 1024; K2 = (const bf16_t*)(ws + WS_KR); Vp = KV + h * 128 + 64; ldv = 1024; Op = (bf16_t*)(ws + WS_R + R_ZZ) + 512 + h * 64; ldo = 2048; scale = 0.10206207261596577f; }
    else { const bf16_t* QKV = (const bf16_t*)(ws + WS_R + R_QKV); Qp = QKV + h * 64; ldq = 3072; K1 = QKV + 1024 + h * 64; ldk1 = 3072; Vp = QKV + 2048 + h * 64; ldv = 3072; Op = (bf16_t*)QKV + h * 64; ldo = 3072; scale = 0.125f; }
    const int qpos = qb * 256 + t; const size_t row = (size_t)b * SEQ + qpos;
    float q[DQ];
#pragma unroll
    for (int c = 0; c < DQ / 8; ++c) { const u32x4 w = *(const u32x4*)(Qp + row * ldq + c * 8);
        q[c * 8 + 0] = __builtin_bit_cast(float, w.x << 16); q[c * 8 + 1] = __builtin_bit_cast(float, w.x & 0xffff0000u);
        q[c * 8 + 2] = __builtin_bit_cast(float, w.y << 16); q[c * 8 + 3] = __builtin_bit_cast(float, w.y & 0xffff0000u);
        q[c * 8 + 4] = __builtin_bit_cast(float, w.z << 16); q[c * 8 + 5] = __builtin_bit_cast(float, w.z & 0xffff0000u);
        q[c * 8 + 6] = __builtin_bit_cast(float, w.w << 16); q[c * 8 + 7] = __builtin_bit_cast(float, w.w & 0xffff0000u); }
    unsigned sel = 0xffu; float b31 = 0.f;
    if (MODE == 0) {
        const float* kmp = (const float*)(ws + WS_KMP);
        float gsc[8];
#pragma unroll
        for (int n = 0; n < 8; ++n) { gsc[n] = -INFINITY;
            if (n < qb) { const float* k0 = kmp + ((size_t)(b * 8 + n) * 2 + 0) * 512 + h * 64; const float* k1 = k0 + 512; float s = 0.f;
#pragma unroll
                for (int d = 0; d < 64; ++d) s += q[d] * (k0[d] + k1[d]);
                gsc[n] = s; } }
        sel = 0u; const int nsel = qb < 3 ? qb : 3;
        for (int r = 0; r < nsel; ++r) { int best = -1; float bv = -INFINITY;
#pragma unroll
            for (int n = 0; n < 8; ++n) { if (n < qb && !((sel >> n) & 1u) && (best < 0 || gsc[n] > bv)) { best = n; bv = gsc[n]; } }
            sel |= 1u << best; }
        const float* biasd = (const float*)(ws + WS_BIASD) + h * 128;
        if (t < 128) Bs[t] = biasd[t];
        b31 = biasd[127];
    }
#pragma unroll
    for (int d = 0; d < DQ; ++d) q[d] *= scale;
    float cq = 0.f; const float* cum = (const float*)(ws + WS_CUM) + (size_t)(b * 16 + h) * SEQ;
    if (MODE == 2) cq = cum[qpos];
    float o[64];
#pragma unroll
    for (int d = 0; d < 64; ++d) o[d] = 0.f;
    float mrun = -INFINITY, l = 0.f;
    const int ntiles = (qb + 1) * 4;
    for (int kt = 0; kt < ntiles; ++kt) {
        __syncthreads();
        for (int ch = t; ch < 64 * DQ / 8; ch += 256) { const int key = ch / (DQ / 8), c8 = ch % (DQ / 8), d0 = c8 * 8; const size_t kr = (size_t)b * SEQ + kt * 64 + key;
            const bf16_t* src = (d0 < 64) ? (K1 + kr * ldk1 + d0) : (K2 + kr * 32 + (d0 - 64));
            const u32x4 w = *(const u32x4*)src; float* dst = Ks + key * DQ + d0;
            dst[0] = __builtin_bit_cast(float, w.x << 16); dst[1] = __builtin_bit_cast(float, w.x & 0xffff0000u); dst[2] = __builtin_bit_cast(float, w.y << 16); dst[3] = __builtin_bit_cast(float, w.y & 0xffff0000u);
            dst[4] = __builtin_bit_cast(float, w.z << 16); dst[5] = __builtin_bit_cast(float, w.z & 0xffff0000u); dst[6] = __builtin_bit_cast(float, w.w << 16); dst[7] = __builtin_bit_cast(float, w.w & 0xffff0000u); }
        for (int ch = t; ch < 64 * 64 / 8; ch += 256) { const int key = ch / 8, d0 = (ch % 8) * 8; const size_t kr = (size_t)b * SEQ + kt * 64 + key;
            const u32x4 w = *(const u32x4*)(Vp + kr * ldv + d0); float* dst = Vs + key * 64 + d0;
            dst[0] = __builtin_bit_cast(float, w.x << 16); dst[1] = __builtin_bit_cast(float, w.x & 0xffff0000u); dst[2] = __builtin_bit_cast(float, w.y << 16); dst[3] = __builtin_bit_cast(float, w.y & 0xffff0000u);
            dst[4] = __builtin_bit_cast(float, w.z << 16); dst[5] = __builtin_bit_cast(float, w.z & 0xffff0000u); dst[6] = __builtin_bit_cast(float, w.w << 16); dst[7] = __builtin_bit_cast(float, w.w & 0xffff0000u); }
        if (MODE == 2) { if (t < 64) Cs[t] = cum[kt * 64 + t]; }
        __syncthreads();
        bool active = true;
        if (MODE == 0) { const int blk = kt >> 2; active = (blk == qb) || ((sel >> blk) & 1u); }
        if (active) {
#pragma unroll 1
            for (int j = 0; j < 64; ++j) {
                const int kp = kt * 64 + j;
                if (kp <= qpos) {
                    const float* kr = Ks + j * DQ; float acc = 0.f;
#pragma unroll
                    for (int d = 0; d < DQ; d += 4) { const f32x4 kv = *(const f32x4*)(kr + d); acc += q[d] * kv.x + q[d + 1] * kv.y + q[d + 2] * kv.z + q[d + 3] * kv.w; }
                    if (MODE == 0) { const int dist = qpos - kp; acc += (dist >= 128) ? b31 : Bs[dist]; }
                    if (MODE == 2) acc += cq - Cs[j];
                    if (acc > mrun) { const float corr = __expf(mrun - acc); l *= corr;
#pragma unroll
                        for (int d = 0; d < 64; ++d) o[d] *= corr;
                        mrun = acc; }
                    const float p = __expf(acc - mrun); l += p; const float* vr = Vs + j * 64;
#pragma unroll
                    for (int d = 0; d < 64; d += 4) { const f32x4 vv = *(const f32x4*)(vr + d); o[d] += p * vv.x; o[d + 1] += p * vv.y; o[d + 2] += p * vv.z; o[d + 3] += p * vv.w; }
                }
            }
        }
    }
    const float inv = 1.f / l;
#pragma unroll
    for (int c = 0; c < 8; ++c) { u32x4 w; w.x = pk2(o[c * 8] * inv, o[c * 8 + 1] * inv); w.y = pk2(o[c * 8 + 2] * inv, o[c * 8 + 3] * inv); w.z = pk2(o[c * 8 + 4] * inv, o[c * 8 + 5] * inv); w.w = pk2(o[c * 8 + 6] * inv, o[c * 8 + 7] * inv);
        *(u32x4*)(Op + row * ldo + c * 8) = w; }
    __syncthreads();
}
template <int MODE> __device__ __forceinline__ void sattn_phase(Frame& F, const Args& a, int flip) {
    constexpr int NH = (MODE == 2) ? 16 : 8;
    const int npairs = BATCH * (NH / 2) * 8, half = F.tid >> 8;
    for (int u = blockIdx.x, r = 0; u < npairs; u += F.G, ++r) {
        const int j = u & 7, bh2 = u >> 3; const int qb = ((r + flip) & 1) ? 7 - j : j;
        const int b = bh2 / (NH / 2), hp = bh2 % (NH / 2);
        sattn_unit<MODE>(F, a, b, hp * 2 + half, qb);
    }
}

__device__ __forceinline__ void fox_gate_rows(Frame& F, const Args& a) {
    const int gw = F.vcu * 8 + F.wave, NGW = F.G * 8; const float* W = a.in[19]; const float* g = a.in[6] + DM; const float* bfp = a.in[20];
    const float* ssq = (const float*)(F.ws + WS_SSQ); float* LF = (float*)(F.ws + WS_LF);
    for (int m = gw; m < M; m += NGW) {
        float acc[16];
#pragma unroll
        for (int hh = 0; hh < 16; ++hh) acc[hh] = 0.f;
        for (int j = 0; j < 16; ++j) { const int k = F.lane + 64 * j; const float xg = F.x[(size_t)m * DM + k] * g[k]; const f32x4* wr = (const f32x4*)(W + (size_t)k * 3088 + 3072);
#pragma unroll
            for (int c = 0; c < 4; ++c) { const f32x4 w = wr[c]; acc[c * 4] += xg * w.x; acc[c * 4 + 1] += xg * w.y; acc[c * 4 + 2] += xg * w.z; acc[c * 4 + 3] += xg * w.w; } }
        const float rs = rstd_from16(ssq, m); float mine = 0.f;
#pragma unroll
        for (int hh = 0; hh < 16; ++hh) { const float s = wave_sum(acc[hh]); if (F.lane == hh) mine = s; }
        if (F.lane < 16) { const float z = mine * rs + bfp[F.lane]; LF[(size_t)m * 16 + F.lane] = fminf(z, 0.f) - log1pf(__expf(-fabsf(z))); }
    }
}
__device__ __forceinline__ void fox_scan(Frame& F) {
    const int gw = F.vcu * 8 + F.wave, NGW = F.G * 8; const float* LF = (const float*)(F.ws + WS_LF); float* cum = (float*)(F.ws + WS_CUM);
    for (int sc = gw; sc < BATCH * 16; sc += NGW) { const int b = sc >> 4, hh = sc & 15;
        float v[32]; float run = 0.f;
#pragma unroll
        for (int i = 0; i < 32; ++i) { run += LF[((size_t)b * SEQ + F.lane * 32 + i) * 16 + hh]; v[i] = run; }
        float incl = run;
#pragma unroll
        for (int o = 1; o < 64; o <<= 1) { const float tt = __shfl_up(incl, o); if (F.lane >= o) incl += tt; }
        const float excl = incl - run;
#pragma unroll
        for (int i = 0; i < 32; ++i) cum[(size_t)sc * SEQ + F.lane * 32 + i] = v[i] + excl;
    }
}
__device__ __forceinline__ void final_norm(Frame& F, const Args& a) {
    const int gw = F.vcu * 8 + F.wave, NGW = F.G * 8; const float* ssq = (const float*)(F.ws + WS_SSQ); const float* g = a.in[22];
    for (int m = gw; m < M; m += NGW) { const float rs = rstd_from16(ssq, m);
#pragma unroll
        for (int j = 0; j < 4; ++j) { f32x4* p = (f32x4*)(F.x + (size_t)m * DM) + F.lane + 64 * j; const f32x4 gg = *((const f32x4*)g + F.lane + 64 * j); f32x4 v = *p; v = v * rs * gg; *p = v; } }
}

constexpr int NPHASE = 20;
__global__ void __launch_bounds__(512, 2) mk_fwd(Args args) {
    extern __shared__ __attribute__((aligned(16))) unsigned char lds[];
    Frame F;
    F.lds = (LAS unsigned char*)lds; F.ldsg = lds;
    F.MISC = (volatile LAS unsigned*)(F.lds + MISC_OFF);
    F.tid = threadIdx.x; F.lane = F.tid & 63; F.wave = __builtin_amdgcn_readfirstlane(F.tid >> 6);
    F.G = gridDim.x; { const int bx = blockIdx.x; F.vcu = (F.G % 8 == 0) ? (bx % 8) * (F.G / 8) + bx / 8 : bx; }
    F.ws = args.ws; F.x = args.out; F.ctl = (gu32*)(args.ws + WS_CTL);
    for (int u = F.tid; u < (LDS_BYTES - LDSCTL_OFF) / 4; u += 512) ((LAS unsigned*)(F.lds + LDSCTL_OFF))[u] = 0u;
    __syncthreads();
    XcdBarrier bar; bar.bar = (unsigned*)(F.ctl + CW_BAR); bar.x = 0; bar.st = nullptr;
    const bool multi = (args.ph_hi - args.ph_lo) > 1;
    if (multi) bar = xcd_barrier_post((unsigned*)(F.ctl + CW_BAR), F.MISC + 8);
    unsigned char* ws = args.ws;
    bf16_t* XB = (bf16_t*)(ws + WS_XB); float* SSQ = (float*)(ws + WS_SSQ);
    if (args.ph_lo == 0) { prologue(F, args); if (1 < args.ph_hi) xcd_barrier(bar); }
    for (int ph = (args.ph_lo == 0 ? 1 : args.ph_lo); ph < args.ph_hi; ++ph) {
        { unsigned char* w_ = args.ws; asm volatile("" : "+s"(w_)); ws = w_; F.ws = w_; float* x_ = args.out; asm volatile("" : "+s"(x_)); F.x = x_;
          int t_ = threadIdx.x; asm volatile("" : "+v"(t_)); F.tid = t_; F.lane = t_ & 63; F.wave = __builtin_amdgcn_readfirstlane(t_ >> 6);
          XB = (bf16_t*)(ws + WS_XB); SSQ = (float*)(ws + WS_SSQ); }
        const int layer = (ph >= 10) ? 1 : 0; const int lp = (ph == 0 || ph == 19) ? -1 : (ph - 1) - layer * 9;
        if (ph == 19) final_norm(F, args);
        else if (lp == 4) {
#ifndef NO_SATTN
            if (layer == 0) { sattn_phase<0>(F, args, 0); sattn_phase<1>(F, args, 1); }
            else sattn_phase<2>(F, args, 0);
#endif
        } else if (lp == 3 && layer == 1) fox_scan(F);
        else {
            if (lp == 0 && layer == 1) conv_p_rows(F, args.in[1] + (size_t)M * PLED, (bf16_t*)(ws + WS_PB));
            const int njobs = (lp == 8) ? 2 : 1;
            for (int jb = 0; jb < njobs; ++jb) {
                int et; pg8::Gemm g; int N_;
                EpiSwiglu E0{(bf16_t*)(ws + WS_R + R_H), SSQ};
                EpiRes E1{F.x, XB, SSQ, SSQ, (const bf16_t*)(ws + WS_R + R_PP), 1.0f, 0};
                EpiStoreT E2{(bf16_t*)(ws + WS_R + R_QKV), 3072, SSQ};
                EpiStoreF E3{0, (bf16_t*)(ws + WS_R + R_ZZ), nullptr, SSQ, (float*)(ws + WS_SSQCQ), (float*)(ws + WS_SSQCKV), (bf16_t*)(ws + WS_KR), (float*)(ws + WS_KMP), (const float*)(ws + WS_ROPE)};
                if (lp == 0 || lp == 6) { const int wi = layer * 2 + (lp == 6 ? 1 : 0); et = 0; N_ = 2 * DFF;
                    g = pg8::Gemm{XB, XB, (const bf16_t*)(ws + WS_WFI + (size_t)wi * SZ_WFI), M, 2 * DFF, DM, DM, DM, 1 << 30}; }
                else if (lp == 1 || lp == 7) { const int wi = layer * 2 + (lp == 7 ? 1 : 0); et = 1; N_ = DM; E1.alpha = 0.5f;
                    g = pg8::Gemm{(const bf16_t*)(ws + WS_R + R_H), nullptr, (const bf16_t*)(ws + WS_WFO + (size_t)wi * SZ_WFO), M, DM, DFF, DFF, DFF, 1 << 30}; }
                else if (lp == 5) { et = 1; N_ = DM; E1.alpha = 1.0f;
                    if (layer == 0) g = pg8::Gemm{(const bf16_t*)(ws + WS_R + R_ZZ), nullptr, (const bf16_t*)(ws + WS_WABO), M, DM, DM, 2048, DM, 1 << 30};
                    else g = pg8::Gemm{(const bf16_t*)(ws + WS_R + R_QKV), nullptr, (const bf16_t*)(ws + WS_WFXO), M, DM, DM, 3072, DM, 1 << 30}; }
                else if (lp == 2 && layer == 0) { et = 3; N_ = 2048; g = pg8::Gemm{XB, XB, (const bf16_t*)(ws + WS_WABI), M, 2048, DM, DM, DM, 1 << 30}; }
                else if (lp == 2) { et = 2; N_ = 3072; g = pg8::Gemm{XB, XB, (const bf16_t*)(ws + WS_WFXI), M, 3072, DM, DM, DM, 1 << 30}; }
                else if (lp == 3) { et = 3; N_ = 1792; const bf16_t* ZZ = (const bf16_t*)(ws + WS_R + R_ZZ);
                    g = pg8::Gemm{ZZ + 512, ZZ + 768, (const bf16_t*)(ws + WS_WUP), M, 1792, 256, 2048, 256, 3};
                    E3.mode = 1; E3.O = (bf16_t*)(ws + WS_R + R_QMLA); E3.O2 = (bf16_t*)(ws + WS_R + R_KVMLA); }
                else if (jb == 0) { et = 3; N_ = DM; E3.mode = 2; E3.O = (bf16_t*)(ws + WS_R + R_PP);
                    g = pg8::Gemm{(const bf16_t*)(ws + WS_PB), nullptr, (const bf16_t*)(ws + WS_WP + (size_t)layer * DM * PLED * 2), M, DM, PLED, PLED, PLED, 1 << 30}; }
                else { et = 1; N_ = DM; E1.mode = 1; __threadfence(); __syncthreads();
                    g = pg8::Gemm{XB, nullptr, (const bf16_t*)(ws + WS_WG + (size_t)layer * DM * DM * 2), M, DM, DM, DM, DM, 1 << 30}; }
                pg8::StaticOrder S; S.init(M, N_, F.G, (int)blockIdx.x);
#ifndef NO_GEMM
                if (et == 0) pg8::gemm_phase<EpiSwiglu, pg8::StaticOrder, true, true>(F.lds, g, S, E0, F.tid);
                else if (et == 1) pg8::gemm_phase<EpiRes, pg8::StaticOrder, true, true>(F.lds, g, S, E1, F.tid);
                else if (et == 2) pg8::gemm_phase<EpiStoreT, pg8::StaticOrder, true, true>(F.lds, g, S, E2, F.tid);
                else pg8::gemm_phase<EpiStoreF, pg8::StaticOrder, true, true>(F.lds, g, S, E3, F.tid);
#endif
            }
            if (lp == 2 && layer == 1) fox_gate_rows(F, args);
        }
        if (ph + 1 < args.ph_hi) xcd_barrier(bar);
    }
}

extern "C" void kernel_launch(void* const* d_in, const int* in_sizes, int n_in, void* d_out, int out_size, void* d_ws, size_t ws_size, hipStream_t stream) {
    static int grid = 0;
    if (grid == 0) {
        if (n_in != 23 || out_size != M * DM || ws_size < WS_END) { fprintf(stderr, "kernel_launch: unexpected shapes (n_in %d out %d ws %zu)\n", n_in, out_size, ws_size); grid = -1; return; }
        int dev = 0, cus = 0, per_cu = 0;
        if (hipGetDevice(&dev) != hipSuccess || hipDeviceGetAttribute(&cus, hipDeviceAttributeMultiprocessorCount, dev) != hipSuccess) { grid = -1; return; }
        if (hipFuncSetAttribute((const void*)mk_fwd, hipFuncAttributeMaxDynamicSharedMemorySize, LDS_BYTES) != hipSuccess) { fprintf(stderr, "kernel_launch: hipFuncSetAttribute failed\n"); grid = -1; return; }
        if (hipOccupancyMaxActiveBlocksPerMultiprocessor(&per_cu, (const void*)mk_fwd, 512, LDS_BYTES) != hipSuccess || per_cu < 1) { fprintf(stderr, "kernel_launch: occupancy query says %d\n", per_cu); per_cu = 1; }
        (void)hipGetLastError();
        grid = cus;
        if (grid > 256) grid = 256;
        grid -= grid % 8;
    }
    if (grid < 0) return;
    (void)hipMemsetAsync((char*)d_ws + WS_CTL, 0, CTL_ZERO_BYTES, stream);
    Args a{};
    for (int i = 0; i < 23; ++i) a.in[i] = (const float*)d_in[i];
    a.out = (float*)d_out; a.ws = (unsigned char*)d_ws;
#if MK_ONE_LAUNCH
    a.ph_lo = 0; a.ph_hi = NPHASE;
    hipLaunchKernelGGL(mk_fwd, dim3(grid), dim3(512), LDS_BYTES, stream, a);
#else
    for (int ph = 0; ph < NPHASE; ++ph) { a.ph_lo = ph; a.ph_hi = ph + 1; hipLaunchKernelGGL(mk_fwd, dim3(grid), dim3(512), LDS_BYTES, stream, a); }
#endif
}
```

```cpp
#include <hip/hip_runtime.h>
#include <hip/hip_bf16.h>
#include <cstdio>
#include <cstdint>
#include <cmath>

#ifndef MK_SCALAR_ATTN
#define MK_SCALAR_ATTN 0
#endif
#ifndef MK_ONE_LAUNCH
#define MK_ONE_LAUNCH 1
#endif

constexpr int BATCH = 8, SEQ = 2048, DM = 1024, M = BATCH * SEQ, DFF = 2816, PLED = 256;
constexpr float EPS = 1e-6f;
constexpr float LOG2E = 1.4426950408889634f, LN2 = 0.6931471805599453f;
constexpr float C2A = 0.125f * LOG2E, C2M = 0.10206207261596577f * LOG2E;

namespace pg8 {
#define PG8_LAS __attribute__((address_space(3)))
typedef unsigned short bf16_t;
typedef short bf16x8 __attribute__((ext_vector_type(8)));
typedef float f32x4 __attribute__((ext_vector_type(4)));
typedef unsigned u32x4 __attribute__((ext_vector_type(4)));
typedef unsigned u32x2 __attribute__((ext_vector_type(2)));
constexpr int BM = 256, BK = 64, HALF = 128, HTB = HALF * BK * 2, STAGE_BYTES = 8 * HTB, NXCD = 8, WGM = 8;

__host__ __device__ __forceinline__ int lds_byte(int r, int c) { const int st = (r >> 4) * 2 + (c >> 5), rr = r & 15, cc = c & 31, ob = rr * 64 + cc * 2; return st * 1024 + (ob ^ (((ob >> 9) & 1) << 5)); }
__host__ __device__ __forceinline__ void stage_rc(int b, int& R, int& C) { const int st = b / 1024, sb = b % 1024, swz = sb ^ (((sb >> 9) & 1) << 5); R = (st >> 1) * 16 + swz / 64; C = (st & 1) * 32 + (swz % 64) / 2; }
__host__ __device__ __forceinline__ int perm32(int rho) { const int n = rho >> 4, i = rho & 15; return 8 * (i >> 2) + 4 * n + (i & 3); }

struct Unit { int pm, pn; };
struct Gemm { const bf16_t* A; const bf16_t* A2; const bf16_t* Bt; int M, N, K, lda, ldb, pn_split; };

struct StaticOrder {
    int nM, nN, nwg, G, c;
    __host__ __device__ void init(int M_, int N_, int G_, int c_) { nM = M_ / BM; nN = N_ / BM; nwg = nM * nN; G = G_; c = c_; }
    __host__ __device__ bool next(int i, Unit& u) const {
        const long L = (long)i * G + c; if (L >= nwg) return false;
        int wgid = (int)L; { const int q = nwg / NXCD, r = nwg % NXCD, xcd = wgid % NXCD, off = wgid / NXCD; wgid = (xcd < r ? xcd * (q + 1) : r * (q + 1) + (xcd - r) * q) + off; }
        const int nig = WGM * nN, gid = wgid / nig, fm = gid * WGM, gsz = (nM - fm) < WGM ? (nM - fm) : WGM;
        u.pm = fm + ((wgid % nig) % gsz); u.pn = (wgid % nig) / gsz; return true;
    }
    __device__ __forceinline__ void a_ready(const Unit&) const {}
    __device__ __forceinline__ void done(const Unit&) const {}
};

__device__ __forceinline__ unsigned cvt_pk_bf16(float lo, float hi) { unsigned r; asm volatile("v_cvt_pk_bf16_f32 %0, %1, %2" : "=v"(r) : "v"(lo), "v"(hi)); return r; }

template <class Epi, class Sched, bool ALIGN_EPI = false, bool SP2 = false>
__device__ __forceinline__ void gemm_phase(PG8_LAS unsigned char* lds, const Gemm g, const Sched& S, const Epi& E, int tid) {
    asm volatile("" : "+v"(tid));
    const int wid = __builtin_amdgcn_readfirstlane(tid >> 6), lane = tid & 63, wr = wid >> 2, wc = wid & 3, fr = lane & 15, fq = lane >> 4;
    const int K = g.K, nt = K / BK;
    unsigned voffA[2], voffB[2];
#pragma unroll
    for (int i = 0; i < 2; ++i) { int R, C; stage_rc(tid * 16 + i * 8192, R, C); const int Rb = Epi::PERM ? ((R & ~31) + perm32(R & 31)) : R;
        voffA[i] = (unsigned)(R * g.lda + C) * 2u; voffB[i] = (unsigned)(Rb * g.ldb + C) * 2u; }
    const size_t kstep = (size_t)(BK * 2);
    const size_t hstepA = (size_t)HALF * g.lda * 2, hstepB = (size_t)HALF * g.ldb * 2;
    const size_t tstepA = 2 * hstepA, tstepB = 2 * hstepB;
    const unsigned ldsw = (unsigned)wid * 1024u;
    const int aoff = lds_byte(wr * 64 + fr, fq * 8), boff = lds_byte(wc * 32 + fr, fq * 8);
#define PG8_SA(b, h) (((b) * 2 + (h)) * HTB)
#define PG8_SB(b, h) ((4 + (b) * 2 + (h)) * HTB)
#define PG8_STAGE(bufoff, gbase, voff) do { _Pragma("unroll") for (int _i = 0; _i < 2; ++_i) \
        __builtin_amdgcn_global_load_lds((const unsigned*)((const char*)(gbase) + (voff)[_i]), (PG8_LAS unsigned*)(lds + (bufoff) + ldsw + _i * 8192), 16, 0, 0); } while (0)
#define PG8_LDA(dst, b, h) do { _Pragma("unroll") for (int m = 0; m < 4; ++m) _Pragma("unroll") for (int k = 0; k < 2; ++k) dst[m][k] = *(const PG8_LAS bf16x8*)(lds + PG8_SA(b, h) + aoff + m * 2048 + k * 1024); } while (0)
#define PG8_LDB(dst, b, h) do { _Pragma("unroll") for (int n = 0; n < 2; ++n) _Pragma("unroll") for (int k = 0; k < 2; ++k) dst[n][k] = *(const PG8_LAS bf16x8*)(lds + PG8_SB(b, h) + boff + n * 2048 + k * 1024); } while (0)
#define PG8_MMA(ai, bj, At, Bt) do { __builtin_amdgcn_s_setprio(1); _Pragma("unroll") for (int m = 0; m < 4; ++m) _Pragma("unroll") for (int n = 0; n < 2; ++n) _Pragma("unroll") for (int k = 0; k < 2; ++k) \
        acc[ai][bj][m][n] = __builtin_amdgcn_mfma_f32_16x16x32_bf16(Bt[n][k], At[m][k], acc[ai][bj][m][n], 0, 0, 0); __builtin_amdgcn_s_setprio(0); } while (0)
#define PG8_WAIT_V(n) asm volatile("s_waitcnt vmcnt(" #n ")" ::: "memory")
#define PG8_WAIT_L(n) asm volatile("s_waitcnt lgkmcnt(" #n ")" ::: "memory")
#define PG8_BAR __builtin_amdgcn_s_barrier()
#define PG8_SCHED __builtin_amdgcn_sched_barrier(0)
#define PG8_ABASE(u) ((const char*)(((u).pn >= g.pn_split) ? g.A2 : g.A) + (size_t)(u).pm * tstepA)
    Unit cur, nxt; int ui = 0;
    if (!S.next(0, cur)) return;
    f32x4 acc[2][2][4][2];
#pragma unroll
    for (int a = 0; a < 2; ++a)
#pragma unroll
        for (int b = 0; b < 2; ++b)
#pragma unroll
            for (int m = 0; m < 4; ++m)
#pragma unroll
                for (int n = 0; n < 2; ++n) acc[a][b][m][n] = (f32x4){0.f, 0.f, 0.f, 0.f};
    bf16x8 At[4][2], B0[2][2], B1[2][2];
    const char* cA = PG8_ABASE(cur); const char* cB = (const char*)g.Bt + (size_t)cur.pn * tstepB;
    S.a_ready(cur);
    if constexpr (SP2) {
        PG8_STAGE(PG8_SB(0, 0), cB, voffB); PG8_STAGE(PG8_SB(0, 1), cB + hstepB, voffB); PG8_STAGE(PG8_SA(0, 0), cA, voffA); PG8_STAGE(PG8_SA(0, 1), cA + hstepA, voffA);
        if (wr == 1) PG8_BAR;
        PG8_WAIT_V(2); PG8_BAR;
        PG8_STAGE(PG8_SB(1, 0), cB + kstep, voffB); PG8_STAGE(PG8_SA(1, 0), cA + kstep, voffA); PG8_STAGE(PG8_SB(1, 1), cB + hstepB + kstep, voffB);
        PG8_WAIT_V(6); PG8_BAR;
    } else {
        PG8_STAGE(PG8_SB(0, 0), cB, voffB); PG8_STAGE(PG8_SA(0, 0), cA, voffA); PG8_STAGE(PG8_SB(0, 1), cB + hstepB, voffB); PG8_STAGE(PG8_SA(0, 1), cA + hstepA, voffA);
        if (wr == 1) PG8_BAR;
        PG8_WAIT_V(4); PG8_BAR;
        PG8_STAGE(PG8_SB(1, 0), cB + kstep, voffB); PG8_STAGE(PG8_SA(1, 0), cA + kstep, voffA); PG8_STAGE(PG8_SB(1, 1), cB + hstepB + kstep, voffB);
        PG8_WAIT_V(6); PG8_BAR;
    }
    for (;;) {
        const bool has_next = S.next(ui + 1, nxt);
        const char* nA = has_next ? PG8_ABASE(nxt) : cA; const char* nB = has_next ? (const char*)g.Bt + (size_t)nxt.pn * tstepB : cB;
        for (int t = 0; t < nt; t += 2) {
            const bool last = (t == nt - 2);
            const char* a1 = cA + (size_t)(t + 1) * kstep;
            const char* a2 = last ? nA : cA + (size_t)(t + 2) * kstep; const char* b2 = last ? nB : cB + (size_t)(t + 2) * kstep;
            const char* a3 = a2 + kstep; const char* b3 = b2 + kstep;
            if (last && has_next) S.a_ready(nxt);
            if constexpr (SP2) {
            PG8_LDB(B0, 0, 0); PG8_LDB(B1, 0, 1); PG8_SCHED; PG8_LDA(At, 0, 0); PG8_STAGE(PG8_SA(1, 1), a1 + hstepA, voffA);
            PG8_WAIT_V(8); PG8_WAIT_L(0); PG8_BAR; PG8_MMA(0, 0, At, B0); PG8_MMA(0, 1, At, B1); PG8_BAR; PG8_SCHED;
            PG8_LDA(At, 0, 1); PG8_STAGE(PG8_SB(0, 0), b2, voffB); PG8_STAGE(PG8_SB(0, 1), b2 + hstepB, voffB); PG8_STAGE(PG8_SA(0, 0), a2, voffA);
            PG8_WAIT_V(8); PG8_WAIT_L(0); PG8_BAR; PG8_MMA(1, 0, At, B0); PG8_MMA(1, 1, At, B1); PG8_BAR; PG8_SCHED;
            PG8_LDB(B0, 1, 0); PG8_LDB(B1, 1, 1); PG8_SCHED; PG8_LDA(At, 1, 0); PG8_STAGE(PG8_SA(0, 1), a2 + hstepA, voffA);
            PG8_WAIT_V(8); PG8_WAIT_L(0); PG8_BAR; PG8_MMA(0, 0, At, B0); PG8_MMA(0, 1, At, B1); PG8_BAR; PG8_SCHED;
            PG8_LDA(At, 1, 1); PG8_STAGE(PG8_SB(1, 0), b3, voffB); PG8_STAGE(PG8_SB(1, 1), b3 + hstepB, voffB); PG8_STAGE(PG8_SA(1, 0), a3, voffA);
            PG8_WAIT_V(8); PG8_WAIT_L(0); PG8_BAR; PG8_MMA(1, 0, At, B0); PG8_MMA(1, 1, At, B1); PG8_BAR; PG8_SCHED;
            } else {
            PG8_LDB(B0, 0, 0); PG8_SCHED; PG8_LDA(At, 0, 0); PG8_STAGE(PG8_SA(1, 1), a1 + hstepA, voffA);
            PG8_WAIT_L(8); PG8_BAR; PG8_WAIT_L(0); PG8_MMA(0, 0, At, B0); PG8_BAR; PG8_SCHED;
            PG8_LDB(B1, 0, 1); PG8_STAGE(PG8_SB(0, 0), b2, voffB);
            PG8_BAR; PG8_WAIT_L(0); PG8_MMA(0, 1, At, B1); PG8_BAR;
            PG8_LDA(At, 0, 1); PG8_STAGE(PG8_SA(0, 0), a2, voffA);
            PG8_BAR; PG8_WAIT_L(0); PG8_MMA(1, 0, At, B0); PG8_BAR; PG8_SCHED;
            PG8_STAGE(PG8_SB(0, 1), b2 + hstepB, voffB);
            PG8_WAIT_V(6); PG8_BAR; PG8_MMA(1, 1, At, B1); PG8_BAR;
            PG8_LDB(B0, 1, 0); PG8_SCHED; PG8_LDA(At, 1, 0); PG8_STAGE(PG8_SA(0, 1), a2 + hstepA, voffA);
            PG8_WAIT_L(8); PG8_BAR; PG8_WAIT_L(0); PG8_MMA(0, 0, At, B0); PG8_BAR; PG8_SCHED;
            PG8_LDB(B1, 1, 1); PG8_STAGE(PG8_SB(1, 0), b3, voffB);
            PG8_BAR; PG8_WAIT_L(0); PG8_MMA(0, 1, At, B1); PG8_BAR;
            PG8_LDA(At, 1, 1); PG8_STAGE(PG8_SA(1, 0), a3, voffA);
            PG8_BAR; PG8_WAIT_L(0); PG8_MMA(1, 0, At, B0); PG8_BAR; PG8_SCHED;
            PG8_STAGE(PG8_SB(1, 1), b3 + hstepB, voffB);
            PG8_WAIT_V(6); PG8_BAR; PG8_MMA(1, 1, At, B1); PG8_BAR;
            }
        }
        if constexpr (ALIGN_EPI) { if (wr == 0) PG8_BAR; }
        E(acc, cur, wr, wc, fr, fq);
        if (!has_next) break;
#pragma unroll
        for (int a = 0; a < 2; ++a)
#pragma unroll
            for (int b = 0; b < 2; ++b)
#pragma unroll
                for (int m = 0; m < 4; ++m)
#pragma unroll
                    for (int n = 0; n < 2; ++n) acc[a][b][m][n] = (f32x4){0.f, 0.f, 0.f, 0.f};
        cur = nxt; cA = nA; cB = nB; ++ui;
        if constexpr (ALIGN_EPI) { if (wr == 1) PG8_BAR; }
    }
    PG8_WAIT_V(0);
    if constexpr (!ALIGN_EPI) { if (wr == 0) PG8_BAR; }
    PG8_BAR;
#undef PG8_SA
#undef PG8_SB
#undef PG8_STAGE
#undef PG8_LDA
#undef PG8_LDB
#undef PG8_MMA
#undef PG8_WAIT_V
#undef PG8_WAIT_L
#undef PG8_BAR
#undef PG8_SCHED
#undef PG8_ABASE
}
}

using pg8::bf16_t; using pg8::f32x4; using pg8::u32x4; using pg8::u32x2; using pg8::Unit; using pg8::cvt_pk_bf16;

#define GAS __attribute__((address_space(1)))
#define LAS __attribute__((address_space(3)))
typedef GAS unsigned gu32;
#define RLX_AGENT __ATOMIC_RELAXED, __HIP_MEMORY_SCOPE_AGENT

constexpr size_t MiB = 1u << 20;
constexpr size_t WS_CTL = 0, CTL_ZERO_BYTES = 1 * MiB;
constexpr size_t WS_SSQ = 1 * MiB;
constexpr size_t WS_LF = 2 * MiB;
constexpr size_t WS_CUM = 3 * MiB;
constexpr size_t WS_ROPE = 4 * MiB;
constexpr size_t WS_BIASD = WS_ROPE + 256 * 1024;
constexpr size_t WS_KMP = WS_BIASD + 64 * 1024;
constexpr size_t WS_SSQCQ = WS_KMP + 256 * 1024;
constexpr size_t WS_SSQCKV = WS_SSQCQ + 256 * 1024;
constexpr size_t WS_KR = WS_SSQCKV + 256 * 1024;
constexpr size_t WS_W = 7 * MiB;
constexpr size_t SZ_WFI = (size_t)2 * DFF * DM * 2, SZ_WFO = (size_t)DM * DFF * 2;
constexpr size_t WS_WFI = WS_W;
constexpr size_t WS_WFO = WS_WFI + 4 * SZ_WFI;
constexpr size_t WS_WABI = WS_WFO + 4 * SZ_WFO;
constexpr size_t WS_WUP = WS_WABI + (size_t)2048 * 1024 * 2;
constexpr size_t WS_WABO = WS_WUP + (size_t)1792 * 256 * 2;
constexpr size_t WS_WFXI = WS_WABO + (size_t)1024 * 1024 * 2;
constexpr size_t WS_WFXO = WS_WFXI + (size_t)3072 * 1024 * 2;
constexpr size_t WS_WG = WS_WFXO + (size_t)1024 * 1024 * 2;
constexpr size_t WS_WP = WS_WG + (size_t)2 * 1024 * 1024 * 2;
constexpr size_t WS_WEND = WS_WP + (size_t)2 * 1024 * 256 * 2;
constexpr size_t WS_XB = 96 * MiB;
constexpr size_t WS_R = 128 * MiB;
constexpr size_t WS_PB = 248 * MiB;
constexpr size_t WS_END = 256 * MiB;
static_assert(WS_WEND <= WS_XB, "weights fit");
constexpr size_t R_H = 0;
constexpr size_t R_ZZ = 0;
constexpr size_t R_QMLA = 64 * MiB;
constexpr size_t R_KVMLA = 88 * MiB;
constexpr size_t R_QKV = 0;
constexpr size_t R_PP = 0;

constexpr int CW_BAR = 4096;

constexpr int RING_BYTES = 131072;
constexpr int LDSCTL_OFF = RING_BYTES, MISC_OFF = LDSCTL_OFF + 320;
constexpr int LDS_BYTES = 147456;

#define XB_TMO      128
#define XB_XCNT(j)  (256  + 64 * (j))
#define XB_XSUB(j)  (1280 + 64 * (j))
#define XB_XGEN(j)  (2304 + 64 * (j))
#define XB_TOP      3328
#define XB_TOPGEN   3392
#define XCD_BAR_WORDS 3456
#define XB_SPIN_CAP (1u << 22)
__device__ __forceinline__ unsigned xb_ld(unsigned* p)              { return __hip_atomic_load(p, __ATOMIC_RELAXED, __HIP_MEMORY_SCOPE_AGENT); }
__device__ __forceinline__ unsigned xb_add(unsigned* p, unsigned v) { return __hip_atomic_fetch_add(p, v, __ATOMIC_RELAXED, __HIP_MEMORY_SCOPE_AGENT); }
__device__ __forceinline__ unsigned xb_xcc_id() { return (unsigned)__builtin_amdgcn_s_getreg((3 << 11) | 20) & 0xFu; }
#define XB_SPIN(cond, bar) do { unsigned _sp = 0; while (cond) { __builtin_amdgcn_s_sleep(1); \
    if ((++_sp & 255u) == 0u) { if (xb_ld(&(bar)[XB_TMO])) break; if (_sp > XB_SPIN_CAP) { atomicAdd(&(bar)[XB_TMO], 1u); break; } } } } while (0)
struct XcdBarrier { unsigned* bar; unsigned x; volatile LAS unsigned* st; };
__device__ __forceinline__ XcdBarrier xcd_barrier_post(unsigned* bar, volatile LAS unsigned* st) {
    XcdBarrier b; b.bar = bar; b.x = xb_xcc_id(); b.st = st;
    if (threadIdx.x == 0) (void)xb_add(&bar[XB_XCNT(b.x)], 1u);
    return b;
}
__device__ __forceinline__ void xcd_barrier_complete(unsigned* bar, unsigned x, unsigned& nloc, unsigned& nx) {
    const unsigned G = gridDim.x * gridDim.y * gridDim.z;
    unsigned sum, cnt, mine, sp = 0u;
    for (;;) {
        sum = 0u; cnt = 0u; mine = 0u;
#pragma unroll
        for (unsigned j = 0; j < 16; ++j) { const unsigned c = xb_ld(&bar[XB_XCNT(j)]); sum += c; cnt += (c > 0u) ? 1u : 0u; mine = (j == x) ? c : mine; }
        if (sum == G) break;
        __builtin_amdgcn_s_sleep(1);
        if ((++sp & 255u) == 0u) { if (xb_ld(&bar[XB_TMO])) break; if (sp > XB_SPIN_CAP) { atomicAdd(&bar[XB_TMO], 1u); break; } }
    }
    nloc = mine > 0u ? mine : 1u; nx = cnt > 0u ? cnt : 1u;
}
__device__ __forceinline__ void xcd_barrier(const XcdBarrier& b) {
    asm volatile("s_waitcnt vmcnt(0)" ::: "memory");
    __syncthreads();
    if (threadIdx.x == 0) {
        unsigned* bar = b.bar;
        __builtin_amdgcn_s_waitcnt(0);
        unsigned nloc = b.st[0], nx = b.st[1];
        if (nloc == 0u) { xcd_barrier_complete(bar, b.x, nloc, nx); b.st[0] = nloc; b.st[1] = nx; }
        const unsigned old = xb_add(&bar[XB_XSUB(b.x)], 1u);
        const unsigned gen = old / nloc;
        if (old + 1u == (gen + 1u) * nloc) {
            __builtin_amdgcn_fence(__ATOMIC_RELEASE, "agent");
            asm volatile("s_waitcnt vmcnt(0)" ::: "memory");
            const unsigned og = xb_add(&bar[XB_TOP], 1u);
            const unsigned tg = og / nx;
            if (og + 1u == (tg + 1u) * nx) xb_add(&bar[XB_TOPGEN], 1u);
            else XB_SPIN(xb_ld(&bar[XB_TOPGEN]) == tg, bar);
            __builtin_amdgcn_fence(__ATOMIC_ACQUIRE, "agent");
            xb_add(&bar[XB_XGEN(b.x)], 1u);
            asm volatile("s_waitcnt vmcnt(0)" ::: "memory");
        } else {
            XB_SPIN(xb_ld(&bar[XB_XGEN(b.x)]) == gen, bar);
            __builtin_amdgcn_fence(__ATOMIC_ACQUIRE, "agent");
            asm volatile("s_waitcnt vmcnt(0)" ::: "memory");
        }
    }
    __syncthreads();
}

__device__ __forceinline__ unsigned f2bf(float f) { unsigned u = __builtin_bit_cast(unsigned, f); return (u + 0x7fffu + ((u >> 16) & 1u)) >> 16; }
__device__ __forceinline__ unsigned pk2(float lo, float hi) { return f2bf(lo) | (f2bf(hi) << 16); }
__device__ __forceinline__ float bf2f(unsigned short b) { return __builtin_bit_cast(float, (unsigned)b << 16); }
__device__ __forceinline__ float wave_sum(float v) {
#pragma unroll
    for (int o = 1; o < 64; o <<= 1) v += __shfl_xor(v, o);
    return v;
}
__device__ __forceinline__ float sum4(f32x4 a) { return (a.x + a.y) + (a.z + a.w); }
__device__ __forceinline__ float rstd_from16(const float* ssq, int row) {
    const f32x4* p = (const f32x4*)(ssq + (size_t)row * 16);
    const float s = (sum4(p[0]) + sum4(p[1])) + (sum4(p[2]) + sum4(p[3]));
    return rsqrtf(s * (1.f / 1024.f) + EPS);
}
__device__ __forceinline__ float rstd_from4(const float* ssq, int row, float invn) {
    const f32x4 a = *(const f32x4*)(ssq + (size_t)row * 4);
    return rsqrtf(sum4(a) * invn + EPS);
}
__device__ __forceinline__ float sigmoidf_(float a) { return __builtin_amdgcn_rcpf(1.f + __expf(-a)); }

struct EpiSwiglu {
    static constexpr bool PERM = true;
    bf16_t* H; const float* ssq;
    __device__ __forceinline__ void operator()(const f32x4 (&acc)[2][2][4][2], const Unit& u, int wr, int wc, int fr, int fq) const {
        const int row0 = u.pm * 256 + wr * 64 + fr, col0 = u.pn * 128 + wc * 32 + 8 * fq;
#pragma unroll
        for (int ai = 0; ai < 2; ++ai)
#pragma unroll
            for (int m = 0; m < 4; ++m) {
                const int row = row0 + ai * 128 + m * 16; const float rs = rstd_from16(ssq, row);
                float h[8];
#pragma unroll
                for (int n = 0; n < 2; ++n)
#pragma unroll
                    for (int j = 0; j < 4; ++j) { const float a = acc[ai][0][m][n][j] * rs, uu = acc[ai][1][m][n][j] * rs; h[n * 4 + j] = a * sigmoidf_(a) * uu; }
                u32x4 w; w.x = cvt_pk_bf16(h[0], h[1]); w.y = cvt_pk_bf16(h[2], h[3]); w.z = cvt_pk_bf16(h[4], h[5]); w.w = cvt_pk_bf16(h[6], h[7]);
                *(u32x4*)(H + (size_t)row * DFF + col0) = w;
            }
    }
};

struct EpiRes {
    static constexpr bool PERM = false;
    float* x; bf16_t* xb; float* ssq_out; const float* ssq_in; const bf16_t* pp; float alpha; int mode;
    __device__ __forceinline__ void operator()(const f32x4 (&acc)[2][2][4][2], const Unit& u, int wr, int wc, int fr, int fq) const {
        const int row0 = u.pm * 256 + wr * 64 + fr, col0 = u.pn * 256 + wc * 32 + 4 * fq;
#pragma unroll
        for (int ai = 0; ai < 2; ++ai)
#pragma unroll
            for (int m = 0; m < 4; ++m) {
                const int row = row0 + ai * 128 + m * 16; float q = 0.f;
                float rs = 1.f; if (mode == 1) rs = rstd_from16(ssq_in, row);
#pragma unroll
                for (int bj = 0; bj < 2; ++bj)
#pragma unroll
                    for (int n = 0; n < 2; ++n) {
                        const size_t off = (size_t)row * DM + col0 + bj * 128 + n * 16;
                        const f32x4 xo = *(const f32x4*)(x + off); f32x4 xn;
                        if (mode == 1) { const u32x2 pw = *(const u32x2*)(pp + off);
                            const float p0 = __builtin_bit_cast(float, pw.x << 16), p1 = __builtin_bit_cast(float, pw.x & 0xffff0000u), p2 = __builtin_bit_cast(float, pw.y << 16), p3 = __builtin_bit_cast(float, pw.y & 0xffff0000u);
                            const f32x4 a = acc[ai][bj][m][n] * rs;
                            xn.x = xo.x + sigmoidf_(a.x) * p0; xn.y = xo.y + sigmoidf_(a.y) * p1; xn.z = xo.z + sigmoidf_(a.z) * p2; xn.w = xo.w + sigmoidf_(a.w) * p3;
                        } else xn = xo + acc[ai][bj][m][n] * alpha;
                        *(f32x4*)(x + off) = xn;
                        u32x2 w; w.x = cvt_pk_bf16(xn.x, xn.y); w.y = cvt_pk_bf16(xn.z, xn.w); *(u32x2*)(xb + off) = w;
                        q += (xn.x * xn.x + xn.y * xn.y) + (xn.z * xn.z + xn.w * xn.w);
                    }
                q += __shfl_xor(q, 16); q += __shfl_xor(q, 32);
                if (fq == 0) ssq_out[(size_t)row * 16 + u.pn * 4 + wc] = q;
            }
    }
};

struct EpiStoreT {
    static constexpr bool PERM = true;
    bf16_t* O; int ldo; const float* ssq; int qtiles; float qscale;
    __device__ __forceinline__ void operator()(const f32x4 (&acc)[2][2][4][2], const Unit& u, int wr, int wc, int fr, int fq) const {
        const int row0 = u.pm * 256 + wr * 64 + fr, col0 = u.pn * 256 + wc * 32 + 8 * fq; const float qs = (u.pn < qtiles) ? qscale : 1.f;
#pragma unroll
        for (int ai = 0; ai < 2; ++ai)
#pragma unroll
            for (int m = 0; m < 4; ++m) {
                const int row = row0 + ai * 128 + m * 16; const float rs = rstd_from16(ssq, row) * qs;
#pragma unroll
                for (int bj = 0; bj < 2; ++bj) { const f32x4 v0 = acc[ai][bj][m][0] * rs, v1 = acc[ai][bj][m][1] * rs;
                    u32x4 w; w.x = cvt_pk_bf16(v0.x, v0.y); w.y = cvt_pk_bf16(v0.z, v0.w); w.z = cvt_pk_bf16(v1.x, v1.y); w.w = cvt_pk_bf16(v1.z, v1.w);
                    *(u32x4*)(O + (size_t)row * ldo + col0 + bj * 128) = w; }
            }
    }
};

struct EpiStoreF {
    static constexpr bool PERM = false;
    int mode; bf16_t* O; bf16_t* O2; const float* ssq; float* ssq_cq; float* ssq_ckv; bf16_t* kr; float* kmp; const float* rope; float qscale;
    __device__ __forceinline__ void operator()(const f32x4 (&acc)[2][2][4][2], const Unit& u, int wr, int wc, int fr, int fq) const {
        const int row0 = u.pm * 256 + wr * 64 + fr;
        float colsum[2][2][4];
#pragma unroll
        for (int bj = 0; bj < 2; ++bj)
#pragma unroll
            for (int n = 0; n < 2; ++n)
#pragma unroll
                for (int j = 0; j < 4; ++j) colsum[bj][n][j] = 0.f;
#pragma unroll
        for (int ai = 0; ai < 2; ++ai)
#pragma unroll
            for (int m = 0; m < 4; ++m) {
                const int row = row0 + ai * 128 + m * 16;
                float rs = 1.f;
                if (mode == 0) { rs = rstd_from16(ssq, row); if (u.pn < 2) rs *= qscale; }
                else if (mode == 1) rs = (u.pn < 3) ? rstd_from4(ssq_cq, row, 1.f / 256.f) * qscale : rstd_from4(ssq_ckv, row, 1.f / 128.f);
                f32x4 v[2][2];
#pragma unroll
                for (int bj = 0; bj < 2; ++bj)
#pragma unroll
                    for (int n = 0; n < 2; ++n) v[bj][n] = acc[ai][bj][m][n] * rs;
                bf16_t* orow; int ocol;
                if (mode == 0) { orow = O + (size_t)row * 2048; ocol = u.pn * 256 + wc * 32 + 4 * fq; }
                else if (mode == 1) { if (u.pn < 3) { orow = O + (size_t)row * 768; ocol = u.pn * 256 + wc * 32 + 4 * fq; } else { orow = O2 + (size_t)row * 1024; ocol = (u.pn - 3) * 256 + wc * 32 + 4 * fq; } }
                else { orow = O + (size_t)row * 1024; ocol = u.pn * 256 + wc * 32 + 4 * fq; }
                if (mode == 0) {
                    if (u.pn == 2) { float q = 0.f;
#pragma unroll
                        for (int bj = 0; bj < 2; ++bj)
#pragma unroll
                            for (int n = 0; n < 2; ++n) q += (v[bj][n].x * v[bj][n].x + v[bj][n].y * v[bj][n].y) + (v[bj][n].z * v[bj][n].z + v[bj][n].w * v[bj][n].w);
                        q += __shfl_xor(q, 16); q += __shfl_xor(q, 32); if (fq == 0) ssq_cq[(size_t)row * 4 + wc] = q; }
                    if (u.pn == 3) { float q = 0.f;
#pragma unroll
                        for (int n = 0; n < 2; ++n) q += (v[0][n].x * v[0][n].x + v[0][n].y * v[0][n].y) + (v[0][n].z * v[0][n].z + v[0][n].w * v[0][n].w);
                        q += __shfl_xor(q, 16); q += __shfl_xor(q, 32); if (fq == 0) ssq_ckv[(size_t)row * 4 + wc] = q;
                        if (wc == 0) {
                            const int pos = row & (SEQ - 1);
                            const f32x4 cs = *(const f32x4*)(rope + (size_t)pos * 16 + 4 * fq), sn = *(const f32x4*)(rope + (size_t)SEQ * 16 + (size_t)pos * 16 + 4 * fq);
                            const f32x4 x1 = v[1][0], x2 = v[1][1];
                            const f32x4 y1 = x1 * cs - x2 * sn, y2 = x1 * sn + x2 * cs;
                            u32x2 w1, w2; w1.x = cvt_pk_bf16(y1.x, y1.y); w1.y = cvt_pk_bf16(y1.z, y1.w); w2.x = cvt_pk_bf16(y2.x, y2.y); w2.y = cvt_pk_bf16(y2.z, y2.w);
                            *(u32x2*)(kr + (size_t)row * 32 + 4 * fq) = w1; *(u32x2*)(kr + (size_t)row * 32 + 16 + 4 * fq) = w2;
                        } }
                    if (u.pn == 4 || u.pn == 5) {
#pragma unroll
                        for (int bj = 0; bj < 2; ++bj)
#pragma unroll
                            for (int n = 0; n < 2; ++n) { colsum[bj][n][0] += v[bj][n].x; colsum[bj][n][1] += v[bj][n].y; colsum[bj][n][2] += v[bj][n].z; colsum[bj][n][3] += v[bj][n].w; }
                    }
                }
                if (mode == 1 && u.pn < 3) {
#pragma unroll
                    for (int bj = 0; bj < 2; ++bj) {
                        const int g32 = u.pn * 8 + bj * 4 + wc;
                        if (g32 % 3 == 2) {
                            const int pos = row & (SEQ - 1);
                            const f32x4 cs = *(const f32x4*)(rope + (size_t)pos * 16 + 4 * fq), sn = *(const f32x4*)(rope + (size_t)SEQ * 16 + (size_t)pos * 16 + 4 * fq);
                            const f32x4 x1 = v[bj][0], x2 = v[bj][1];
                            v[bj][0] = x1 * cs - x2 * sn; v[bj][1] = x1 * sn + x2 * cs;
                        }
                    }
                }
#pragma unroll
                for (int bj = 0; bj < 2; ++bj)
#pragma unroll
                    for (int n = 0; n < 2; ++n) { u32x2 w; w.x = cvt_pk_bf16(v[bj][n].x, v[bj][n].y); w.y = cvt_pk_bf16(v[bj][n].z, v[bj][n].w);
                        *(u32x2*)(orow + ocol + bj * 128 + n * 16) = w; }
            }
        if (mode == 0 && (u.pn == 4 || u.pn == 5)) {
#pragma unroll
            for (int bj = 0; bj < 2; ++bj)
#pragma unroll
                for (int n = 0; n < 2; ++n)
#pragma unroll
                    for (int j = 0; j < 4; ++j) { float s = colsum[bj][n][j];
                        s += __shfl_xor(s, 1); s += __shfl_xor(s, 2); s += __shfl_xor(s, 4); s += __shfl_xor(s, 8);
                        if (fr == 0) kmp[((size_t)u.pm * 2 + wr) * 512 + (u.pn - 4) * 256 + bj * 128 + wc * 32 + n * 16 + 4 * fq + j] = s; }
        }
    }
};

struct Args {
    const float* in[23]; float* out; unsigned char* ws; int ph_lo, ph_hi;
};
struct Frame {
    LAS unsigned char* lds; unsigned char* ldsg; volatile LAS unsigned* MISC; gu32* ctl;
    int tid, lane, wave, vcu, G;
    unsigned char* ws; float* x;
};

__device__ __forceinline__ void conv_item(const float* W, int ldw, int sc0, const float* gain, bf16_t* WT, int ldt, int n0, int k0, LAS float* scr, int lane) {
#pragma unroll 8
    for (int i = 0; i < 32; ++i) { const int kk = 2 * i + (lane >> 5);
        float v = 0.f; if (sc0 >= 0) { v = W[(size_t)(k0 + kk) * ldw + sc0 + (lane & 31)]; if (gain) v *= gain[k0 + kk]; }
        scr[kk * 33 + (lane & 31)] = v; }
    asm volatile("s_waitcnt lgkmcnt(0)" ::: "memory");
    const int c = lane & 7;
#pragma unroll
    for (int j = 0; j < 4; ++j) { const int n = (lane >> 3) + 8 * j; const LAS float* s = scr + (8 * c) * 33 + n;
        u32x4 o; o.x = pk2(s[0 * 33], s[1 * 33]); o.y = pk2(s[2 * 33], s[3 * 33]); o.z = pk2(s[4 * 33], s[5 * 33]); o.w = pk2(s[6 * 33], s[7 * 33]);
        *(u32x4*)(WT + (size_t)(n0 + n) * ldt + k0 + 8 * c) = o; }
    asm volatile("s_waitcnt lgkmcnt(0)" ::: "memory");
}

struct ConvJob { const float* W; int ldw; const float* gain; bf16_t* WT; int K, N, kind; };
__device__ __forceinline__ ConvJob get_job(int j, const Args& a, unsigned char* ws) {
    ConvJob r;
    if (j < 12) { const int l = j / 6, t = j % 6;
        switch (t) {
        case 0: r = ConvJob{a.in[4] + (size_t)l * DM * 2 * DFF, 2 * DFF, a.in[3] + l * DM, (bf16_t*)(ws + WS_WFI + (size_t)(l * 2 + 0) * SZ_WFI), DM, 2 * DFF, 1}; break;
        case 1: r = ConvJob{a.in[8] + (size_t)l * DM * 2 * DFF, 2 * DFF, a.in[7] + l * DM, (bf16_t*)(ws + WS_WFI + (size_t)(l * 2 + 1) * SZ_WFI), DM, 2 * DFF, 1}; break;
        case 2: r = ConvJob{a.in[5] + (size_t)l * DFF * DM, DM, nullptr, (bf16_t*)(ws + WS_WFO + (size_t)(l * 2 + 0) * SZ_WFO), DFF, DM, 0}; break;
        case 3: r = ConvJob{a.in[9] + (size_t)l * DFF * DM, DM, nullptr, (bf16_t*)(ws + WS_WFO + (size_t)(l * 2 + 1) * SZ_WFO), DFF, DM, 0}; break;
        case 4: r = ConvJob{a.in[11] + (size_t)l * DM * DM, DM, a.in[10] + l * DM, (bf16_t*)(ws + WS_WG + (size_t)l * DM * DM * 2), DM, DM, 0}; break;
        default: r = ConvJob{a.in[12] + (size_t)l * PLED * DM, DM, nullptr, (bf16_t*)(ws + WS_WP + (size_t)l * DM * PLED * 2), PLED, DM, 0}; break;
        }
    } else {
        switch (j) {
        case 12: r = ConvJob{a.in[13], 1952, a.in[6], (bf16_t*)(ws + WS_WABI), DM, 2048, 2}; break;
        case 13: r = ConvJob{a.in[15], 768, a.in[14], (bf16_t*)(ws + WS_WUP), 256, 768, 0}; break;
        case 14: r = ConvJob{a.in[17], 1024, a.in[16], (bf16_t*)(ws + WS_WUP + (size_t)768 * 256 * 2), 256, 1024, 5}; break;
        case 15: r = ConvJob{a.in[18], DM, nullptr, (bf16_t*)(ws + WS_WABO), DM, DM, 0}; break;
        case 16: r = ConvJob{a.in[19], 3088, a.in[6] + DM, (bf16_t*)(ws + WS_WFXI), DM, 3072, 0}; break;
        default: r = ConvJob{a.in[21], DM, nullptr, (bf16_t*)(ws + WS_WFXO), DM, DM, 0}; break;
        }
    }
    return r;
}
__device__ __forceinline__ int conv_srccol(int kind, int n0) {
    if (kind == 1) { const int pn = n0 >> 8, j = n0 & 255; return j < 128 ? pn * 128 + j : DFF + pn * 128 + (j - 128); }
    if (kind == 2) { if (n0 < 512) return n0; if (n0 < 1024) { const int o = n0 - 512; return o < 416 ? 1536 + o : -1; } if (n0 < 1536) return 512 + (n0 - 1024); return 1024 + (n0 - 1536); }
    return n0;
}

__device__ __forceinline__ void conv_p_rows(Frame& F, const float* p, bf16_t* pb) {
    const int gw = F.vcu * 8 + F.wave, NGW = F.G * 8;
    for (int m = gw; m < M; m += NGW) { const f32x4 v = *((const f32x4*)(p + (size_t)m * PLED) + F.lane);
        u32x2 w; w.x = pk2(v.x, v.y); w.y = pk2(v.z, v.w); *((u32x2*)(pb + (size_t)m * PLED) + F.lane) = w; }
}

__device__ __forceinline__ void prologue(Frame& F, const Args& a) {
    LAS float* scr = (LAS float*)(F.lds + F.wave * 16384);
    const int gw = F.vcu * 8 + F.wave, NGW = F.G * 8;
    unsigned char* ws = F.ws;
    constexpr int nj = 18;
    int base = 0;
    for (int j = 0; j < nj; ++j) {
        const ConvJob jb = get_job(j, a, ws); const int nblk = jb.N / 32, nit = (jb.K / 64) * nblk;
        int first = (gw - base) % NGW; if (first < 0) first += NGW;
        for (int it = first; it < nit; it += NGW) {
            const int kb = it / nblk, nb = it % nblk, k0 = 64 * kb, n0 = 32 * nb;
            int sc0 = conv_srccol(jb.kind, n0);
            if (jb.kind == 5 && k0 >= 128) sc0 = -1;
            conv_item(jb.W, jb.ldw, sc0, jb.gain, jb.WT, jb.K, n0, k0, scr, F.lane);
        }
        base = (base + nit) % NGW;
    }
    {
        const float* xin = a.in[0]; float* xo = F.x; bf16_t* xb = (bf16_t*)(ws + WS_XB); float* ssq = (float*)(ws + WS_SSQ);
        for (int m = gw; m < M; m += NGW) {
            f32x4 v[4]; float s = 0.f;
#pragma unroll
            for (int j = 0; j < 4; ++j) { v[j] = *((const f32x4*)(xin + (size_t)m * DM) + F.lane + 64 * j); s += (v[j].x * v[j].x + v[j].y * v[j].y) + (v[j].z * v[j].z + v[j].w * v[j].w); }
            s = wave_sum(s);
#pragma unroll
            for (int j = 0; j < 4; ++j) { *((f32x4*)(xo + (size_t)m * DM) + F.lane + 64 * j) = v[j];
                u32x2 w; w.x = pk2(v[j].x, v[j].y); w.y = pk2(v[j].z, v[j].w); *((u32x2*)(xb + (size_t)m * DM) + F.lane + 64 * j) = w; }
            if (F.lane < 16) ssq[(size_t)m * 16 + F.lane] = (F.lane == 0) ? s : 0.f;
        }
    }
    conv_p_rows(F, a.in[1], (bf16_t*)(ws + WS_PB));
    {
        float* rope = (float*)(ws + WS_ROPE); const int gt = F.vcu * 512 + F.tid, NGT = F.G * 512;
        for (int e = gt; e < SEQ * 16; e += NGT) { const int pos = e >> 4, i = e & 15;
            const float inv = powf(10000.f, -(float)i / 16.f); const float ang = (float)pos * inv;
            rope[e] = (float)cos((double)ang); rope[SEQ * 16 + e] = (float)sin((double)ang); }
        float* biasd = (float*)(ws + WS_BIASD); const float* t5 = a.in[2];
        for (int e = gt; e < 8 * 128; e += NGT) { const int h = e >> 7, d = e & 127; int bk;
            if (d < 16) bk = d; else { bk = 16 + (int)(logf((float)d / 16.f) / 2.0794415416798357f * 16.f); if (bk > 31) bk = 31; }
            biasd[e] = t5[bk * 8 + h]; }
    }
}

constexpr int SA_HALF_FLOATS = 64 * 96 + 64 * 64 + 64 + 128;
template <int MODE> __device__ __forceinline__ void sattn_unit(Frame& F, const Args& a, int b, int h, int qb) {
    constexpr int DQ = (MODE == 1) ? 96 : 64;
    const int half = F.tid >> 8, t = F.tid & 255;
    float* ldsf = (float*)F.ldsg + half * SA_HALF_FLOATS;
    float* Ks = ldsf; float* Vs = Ks + 64 * DQ; float* Cs = Vs + 64 * 64; float* Bs = Cs + 64;
    unsigned char* ws = F.ws;
    const bf16_t *Qp, *K1, *K2 = nullptr, *Vp; bf16_t* Op; int ldq, ldk1, ldv, ldo; float scale;
    if (MODE == 0) { const bf16_t* ZZ = (const bf16_t*)(ws + WS_R + R_ZZ); Qp = ZZ + h * 64; ldq = 2048; K1 = ZZ + 1024 + h * 64; ldk1 = 2048; Vp = ZZ + 1536 + h * 64; ldv = 2048; Op = (bf16_t*)ZZ + h * 64; ldo = 2048; scale = LN2; }
    else if (MODE == 1) { const bf16_t* QM = (const bf16_t*)(ws + WS_R + R_QMLA); const bf16_t* KV = (const bf16_t*)(ws + WS_R + R_KVMLA);
        Qp = QM + h * 96; ldq = 768; K1 = KV + h * 128; ldk1 = 1024; K2 = (const bf16_t*)(ws + WS_KR); Vp = KV + h * 128 + 64; ldv = 1024; Op = (bf16_t*)(ws + WS_R + R_ZZ) + 512 + h * 64; ldo = 2048; scale = LN2; }
    else { const bf16_t* QKV = (const bf16_t*)(ws + WS_R + R_QKV); Qp = QKV + h * 64; ldq = 3072; K1 = QKV + 1024 + h * 64; ldk1 = 3072; Vp = QKV + 2048 + h * 64; ldv = 3072; Op = (bf16_t*)QKV + h * 64; ldo = 3072; scale = LN2; }
    const int qpos = qb * 256 + t; const size_t row = (size_t)b * SEQ + qpos;
    float q[DQ];
#pragma unroll
    for (int c = 0; c < DQ / 8; ++c) { const u32x4 w = *(const u32x4*)(Qp + row * ldq + c * 8);
        q[c * 8 + 0] = __builtin_bit_cast(float, w.x << 16); q[c * 8 + 1] = __builtin_bit_cast(float, w.x & 0xffff0000u);
        q[c * 8 + 2] = __builtin_bit_cast(float, w.y << 16); q[c * 8 + 3] = __builtin_bit_cast(float, w.y & 0xffff0000u);
        q[c * 8 + 4] = __builtin_bit_cast(float, w.z << 16); q[c * 8 + 5] = __builtin_bit_cast(float, w.z & 0xffff0000u);
        q[c * 8 + 6] = __builtin_bit_cast(float, w.w << 16); q[c * 8 + 7] = __builtin_bit_cast(float, w.w & 0xffff0000u); }
    unsigned sel = 0xffu; float b31 = 0.f;
    if (MODE == 0) {
        const float* kmp = (const float*)(ws + WS_KMP);
        float gsc[8];
#pragma unroll
        for (int n = 0; n < 8; ++n) { gsc[n] = -INFINITY;
            if (n < qb) { const float* k0 = kmp + ((size_t)(b * 8 + n) * 2 + 0) * 512 + h * 64; const float* k1 = k0 + 512; float s = 0.f;
#pragma unroll
                for (int d = 0; d < 64; ++d) s += q[d] * (k0[d] + k1[d]);
                gsc[n] = s; } }
        sel = 0u; const int nsel = qb < 3 ? qb : 3;
        for (int r = 0; r < nsel; ++r) { int best = -1; float bv = -INFINITY;
#pragma unroll
            for (int n = 0; n < 8; ++n) { if (n < qb && !((sel >> n) & 1u) && (best < 0 || gsc[n] > bv)) { best = n; bv = gsc[n]; } }
            sel |= 1u << best; }
        const float* biasd = (const float*)(ws + WS_BIASD) + h * 128;
        if (t < 128) Bs[t] = biasd[t];
        b31 = biasd[127];
    }
#pragma unroll
    for (int d = 0; d < DQ; ++d) q[d] *= scale;
    float cq = 0.f; const float* cum = (const float*)(ws + WS_CUM) + (size_t)(b * 16 + h) * SEQ;
    if (MODE == 2) cq = cum[qpos];
    float o[64];
#pragma unroll
    for (int d = 0; d < 64; ++d) o[d] = 0.f;
    float mrun = -INFINITY, l = 0.f;
    const int ntiles = (qb + 1) * 4;
    for (int kt = 0; kt < ntiles; ++kt) {
        __syncthreads();
        for (int ch = t; ch < 64 * DQ / 8; ch += 256) { const int key = ch / (DQ / 8), c8 = ch % (DQ / 8), d0 = c8 * 8; const size_t kr = (size_t)b * SEQ + kt * 64 + key;
            const bf16_t* src = (d0 < 64) ? (K1 + kr * ldk1 + d0) : (K2 + kr * 32 + (d0 - 64));
            const u32x4 w = *(const u32x4*)src; float* dst = Ks + key * DQ + d0;
            dst[0] = __builtin_bit_cast(float, w.x << 16); dst[1] = __builtin_bit_cast(float, w.x & 0xffff0000u); dst[2] = __builtin_bit_cast(float, w.y << 16); dst[3] = __builtin_bit_cast(float, w.y & 0xffff0000u);
            dst[4] = __builtin_bit_cast(float, w.z << 16); dst[5] = __builtin_bit_cast(float, w.z & 0xffff0000u); dst[6] = __builtin_bit_cast(float, w.w << 16); dst[7] = __builtin_bit_cast(float, w.w & 0xffff0000u); }
        for (int ch = t; ch < 64 * 64 / 8; ch += 256) { const int key = ch / 8, d0 = (ch % 8) * 8; const size_t kr = (size_t)b * SEQ + kt * 64 + key;
            const u32x4 w = *(const u32x4*)(Vp + kr * ldv + d0); float* dst = Vs + key * 64 + d0;
            dst[0] = __builtin_bit_cast(float, w.x << 16); dst[1] = __builtin_bit_cast(float, w.x & 0xffff0000u); dst[2] = __builtin_bit_cast(float, w.y << 16); dst[3] = __builtin_bit_cast(float, w.y & 0xffff0000u);
            dst[4] = __builtin_bit_cast(float, w.z << 16); dst[5] = __builtin_bit_cast(float, w.z & 0xffff0000u); dst[6] = __builtin_bit_cast(float, w.w << 16); dst[7] = __builtin_bit_cast(float, w.w & 0xffff0000u); }
        if (MODE == 2) { if (t < 64) Cs[t] = cum[kt * 64 + t]; }
        __syncthreads();
        bool active = true;
        if (MODE == 0) { const int blk = kt >> 2; active = (blk == qb) || ((sel >> blk) & 1u); }
        if (active) {
#pragma unroll 1
            for (int j = 0; j < 64; ++j) {
                const int kp = kt * 64 + j;
                if (kp <= qpos) {
                    const float* kr = Ks + j * DQ; float acc = 0.f;
#pragma unroll
                    for (int d = 0; d < DQ; d += 4) { const f32x4 kv = *(const f32x4*)(kr + d); acc += q[d] * kv.x + q[d + 1] * kv.y + q[d + 2] * kv.z + q[d + 3] * kv.w; }
                    if (MODE == 0) { const int dist = qpos - kp; acc += (dist >= 128) ? b31 : Bs[dist]; }
                    if (MODE == 2) acc += cq - Cs[j];
                    if (acc > mrun) { const float corr = __expf(mrun - acc); l *= corr;
#pragma unroll
                        for (int d = 0; d < 64; ++d) o[d] *= corr;
                        mrun = acc; }
                    const float p = __expf(acc - mrun); l += p; const float* vr = Vs + j * 64;
#pragma unroll
                    for (int d = 0; d < 64; d += 4) { const f32x4 vv = *(const f32x4*)(vr + d); o[d] += p * vv.x; o[d + 1] += p * vv.y; o[d + 2] += p * vv.z; o[d + 3] += p * vv.w; }
                }
            }
        }
    }
    const float inv = 1.f / l;
#pragma unroll
    for (int c = 0; c < 8; ++c) { u32x4 w; w.x = pk2(o[c * 8] * inv, o[c * 8 + 1] * inv); w.y = pk2(o[c * 8 + 2] * inv, o[c * 8 + 3] * inv); w.z = pk2(o[c * 8 + 4] * inv, o[c * 8 + 5] * inv); w.w = pk2(o[c * 8 + 6] * inv, o[c * 8 + 7] * inv);
        *(u32x4*)(Op + row * ldo + c * 8) = w; }
    __syncthreads();
}
template <int MODE> __device__ __forceinline__ void sattn_phase(Frame& F, const Args& a, int flip) {
    constexpr int NH = (MODE == 2) ? 16 : 8;
    const int npairs = BATCH * (NH / 2) * 8, half = F.tid >> 8;
    for (int u = blockIdx.x, r = 0; u < npairs; u += F.G, ++r) {
        const int j = u & 7, bh2 = u >> 3; const int qb = ((r + flip) & 1) ? 7 - j : j;
        const int b = bh2 / (NH / 2), hp = bh2 % (NH / 2);
        sattn_unit<MODE>(F, a, b, hp * 2 + half, qb);
    }
}


typedef short bf16x8_t __attribute__((ext_vector_type(8)));
typedef short s16x4 __attribute__((ext_vector_type(4)));
typedef float f32x16 __attribute__((ext_vector_type(16)));
typedef short v4i16_t __attribute__((ext_vector_type(4)));
typedef float f32x2_t __attribute__((ext_vector_type(2))); typedef __bf16 bf16x2_t __attribute__((ext_vector_type(2)));
constexpr int MA_K = 0, MA_KSLOT = 12288, MA_V = 24576, MA_VSLOT = 8192, MA_WS = 40960, MA_OST = 43008, MA_C2 = 75776, MA_BT = 83968, MA_KM = 84992, MA_END = 89088;
constexpr float MA_THR = 6.0f;
__device__ __forceinline__ int crow(int r, int hi) { return (r & 3) + 8 * (r >> 2) + 4 * hi; }
__device__ __forceinline__ s16x4 vtr(const LAS unsigned char* p) { return __builtin_bit_cast(s16x4, __builtin_amdgcn_ds_read_tr16_b64_v4i16((LAS v4i16_t*)p)); }
__device__ __forceinline__ unsigned cvtpk_s(float lo, float hi) { f32x2_t v = {lo, hi}; bf16x2_t b = __builtin_convertvector(v, bf16x2_t); return __builtin_bit_cast(unsigned, b); }
__device__ __forceinline__ float swapmax(float m) { auto rr = __builtin_amdgcn_permlane32_swap(__float_as_uint(m), __float_as_uint(m), false, false); return fmaxf(__uint_as_float(rr[0]), __uint_as_float(rr[1])); }

template <int MODE> __device__ __forceinline__ void mattn_unit(Frame& F, int b, int h, int qb) {
    constexpr int DQ = (MODE == 1) ? 96 : 64, NKS = DQ / 16;
    int tid = F.tid; asm volatile("" : "+v"(tid));
    const int lane = tid & 63, wid = __builtin_amdgcn_readfirstlane(tid >> 6), r32 = lane & 31, hi = lane >> 5;
    LAS unsigned char* L = F.lds; unsigned char* ws = F.ws;
    const bf16_t *Qp, *K1, *K2 = nullptr, *Vp; bf16_t* Op; int ldq, ldk, ldv, ldo;
    if (MODE == 0) { const bf16_t* ZZ = (const bf16_t*)(ws + WS_R + R_ZZ); Qp = ZZ + h * 64; ldq = 2048; K1 = ZZ + 1024 + h * 64; ldk = 2048; Vp = ZZ + 1536 + h * 64; ldv = 2048; Op = (bf16_t*)ZZ + h * 64; ldo = 2048; }
    else if (MODE == 1) { const bf16_t* QM = (const bf16_t*)(ws + WS_R + R_QMLA); const bf16_t* KV = (const bf16_t*)(ws + WS_R + R_KVMLA);
        Qp = QM + h * 96; ldq = 768; K1 = KV + h * 128; ldk = 1024; K2 = (const bf16_t*)(ws + WS_KR); Vp = KV + h * 128 + 64; ldv = 1024; Op = (bf16_t*)(ws + WS_R + R_ZZ) + 512 + h * 64; ldo = 2048; }
    else { const bf16_t* QKV = (const bf16_t*)(ws + WS_R + R_QKV); Qp = QKV + h * 64; ldq = 3072; K1 = QKV + 1024 + h * 64; ldk = 3072; Vp = QKV + 2048 + h * 64; ldv = 3072; Op = (bf16_t*)QKV + h * 64; ldo = 3072; }
    const size_t rowb = (size_t)b * SEQ; const int q0 = qb * 256 + wid * 32;
    bf16x8_t qr[NKS];
#pragma unroll
    for (int d0 = 0; d0 < NKS; ++d0) qr[d0] = *(const bf16x8_t*)(Qp + (rowb + q0 + r32) * ldq + d0 * 16 + hi * 8);
    const int NT = 4 * qb + 4, tlast = 4 * qb + (wid >> 1);
    LAS float* wsf = (LAS float*)(L + MA_WS) + wid * 64;
    LAS float* C2 = (LAS float*)(L + MA_C2); LAS float* BT = (LAS float*)(L + MA_BT);
#define MA_DMA(t, slot) do { \
    { const bf16_t* s_ = K1 + (rowb + (size_t)(t) * 64 + lane) * ldk + wid * 8; \
      __builtin_amdgcn_global_load_lds((const unsigned*)s_, (LAS unsigned*)(L + MA_K + (slot) * MA_KSLOT + wid * 1024), 16, 0, 0); } \
    if (MODE == 1) { if (wid < 4) { const bf16_t* s_ = K2 + (rowb + (size_t)(t) * 64 + lane) * 32 + wid * 8; \
      __builtin_amdgcn_global_load_lds((const unsigned*)s_, (LAS unsigned*)(L + MA_K + (slot) * MA_KSLOT + (8 + wid) * 1024), 16, 0, 0); } } \
    { const bf16_t* s_ = Vp + (rowb + (size_t)(t) * 64 + 16 * (wid & 3) + (lane >> 2)) * ldv + (wid >> 2) * 32 + (lane & 3) * 8; \
      __builtin_amdgcn_global_load_lds((const unsigned*)s_, (LAS unsigned*)(L + MA_V + (slot) * MA_VSLOT + wid * 1024), 16, 0, 0); } } while (0)
    if (MODE == 2) { const float* cum = (const float*)(ws + WS_CUM) + (size_t)(b * 16 + h) * SEQ; for (int i = tid; i < NT * 64; i += 512) C2[i] = cum[i] * LOG2E; }
    if (MODE == 0) {
        const float* biasd = (const float*)(ws + WS_BIASD) + h * 128;
        if (tid < 256) BT[tid] = tid < 128 ? (biasd[tid] - biasd[127]) * LOG2E : 0.f;
        if (tid < 256) {
            const int c = tid >> 5, row = tid & 31, n = row & 7, part = row >> 3; u32x4 w = (u32x4){0u, 0u, 0u, 0u};
            if (part < 2) { const float* k0 = (const float*)(ws + WS_KMP) + ((size_t)(b * 8 + n) * 2) * 512 + h * 64 + c * 8; const float* k1 = k0 + 512; unsigned e[8];
#pragma unroll
                for (int j = 0; j < 8; ++j) { const float v = (k0[j] + k1[j]) * (1.f / 256.f); const unsigned hb = f2bf(v); const unsigned lb = f2bf(v - __builtin_bit_cast(float, hb << 16)); e[j] = part == 0 ? hb : lb; }
                w.x = e[0] | (e[1] << 16); w.y = e[2] | (e[3] << 16); w.z = e[4] | (e[5] << 16); w.w = e[6] | (e[7] << 16); }
            *(LAS u32x4*)(L + MA_KM + c * 512 + row * 16) = w; }
    }
    MA_DMA(0, 0);
    __syncthreads();
    unsigned sel = 0u;
    if (MODE == 0) {
        f32x16 g;
#pragma unroll
        for (int r = 0; r < 16; ++r) g[r] = 0.f;
#pragma unroll
        for (int d0 = 0; d0 < 4; ++d0) { const bf16x8_t kf = *(const LAS bf16x8_t*)(L + MA_KM + (2 * d0 + hi) * 512 + r32 * 16); g = __builtin_amdgcn_mfma_f32_32x32x16_bf16(kf, qr[d0], g, 0, 0, 0); }
        float gate[8];
#pragma unroll
        for (int j = 0; j < 4; ++j) { const float gv = g[j] + g[4 + j]; auto rr = __builtin_amdgcn_permlane32_swap(__float_as_uint(gv), __float_as_uint(gv), false, false); gate[j] = __uint_as_float(rr[0]); gate[4 + j] = __uint_as_float(rr[1]); }
        const int nsel = qb < 3 ? qb : 3;
        for (int r = 0; r < nsel; ++r) { int best = -1; float bv = -INFINITY;
#pragma unroll
            for (int n = 0; n < 8; ++n) { if (n < qb && !((sel >> n) & 1u) && (best < 0 || gate[n] > bv)) { best = n; bv = gate[n]; } }
            sel |= 1u << (best & 7); }
    }
    float mhat = -1000.f, l_reg = 0.f; f32x16 o[2];
#pragma unroll
    for (int r = 0; r < 16; ++r) { o[0][r] = 0.f; o[1][r] = 0.f; }
    for (int t = 0; t < NT; ++t) {
        const int slot = t & 1;
        if (t + 1 < NT) MA_DMA(t + 1, slot ^ 1);
        if (t <= tlast) {
            float cinit = -mhat;
            if (MODE == 0) { const int n = t >> 2; const bool valid = (n == qb) || ((sel >> n) & 1u); cinit = valid ? cinit : -1e30f; }
            f32x16 p0, p1;
#pragma unroll
            for (int r = 0; r < 16; ++r) { p0[r] = cinit; p1[r] = cinit; }
            const LAS unsigned char* kb = L + MA_K + slot * MA_KSLOT + hi * 1024 + r32 * 16;
#pragma unroll
            for (int d0 = 0; d0 < NKS; ++d0) { const bf16x8_t b0 = *(const LAS bf16x8_t*)(kb + d0 * 2048), b1 = *(const LAS bf16x8_t*)(kb + d0 * 2048 + 512);
                p0 = __builtin_amdgcn_mfma_f32_32x32x16_bf16(b0, qr[d0], p0, 0, 0, 0); p1 = __builtin_amdgcn_mfma_f32_32x32x16_bf16(b1, qr[d0], p1, 0, 0, 0); }
            if (MODE == 2) {
#pragma unroll
                for (int g = 0; g < 4; ++g) { const f32x4 c0 = *(const LAS f32x4*)(C2 + t * 64 + 4 * hi + 8 * g), c1 = *(const LAS f32x4*)(C2 + t * 64 + 32 + 4 * hi + 8 * g);
#pragma unroll
                    for (int j = 0; j < 4; ++j) { p0[4 * g + j] -= c0[j]; p1[4 * g + j] -= c1[j]; } }
            }
            const int dl = q0 - 64 * t + r32 - 4 * hi;
            if (MODE == 0) {
                if (t + 3 >= tlast) {
#pragma unroll
                    for (int r = 0; r < 16; ++r) { const int i0 = dl - ((r & 3) + 8 * (r >> 2)), i1 = i0 - 32;
                        const float b0 = BT[min(max(i0, 0), 128)], b1 = BT[min(max(i1, 0), 128)];
                        p0[r] = i0 < 0 ? -1e30f : p0[r] + b0; p1[r] = i1 < 0 ? -1e30f : p1[r] + b1; }
                }
            } else if (t == tlast) {
#pragma unroll
                for (int r = 0; r < 16; ++r) { const int i0 = dl - ((r & 3) + 8 * (r >> 2)), i1 = i0 - 32; if (i0 < 0) p0[r] = -1e30f; if (i1 < 0) p1[r] = -1e30f; }
            }
            float rm = fmaxf(p0[0], p1[0]);
#pragma unroll
            for (int r = 1; r < 16; ++r) rm = fmaxf(rm, fmaxf(p0[r], p1[r]));
            rm = swapmax(rm);
            if (__any(rm > MA_THR)) {
                const float dlt = fmaxf(rm, 0.f); mhat += dlt;
#pragma unroll
                for (int r = 0; r < 16; ++r) { p0[r] -= dlt; p1[r] -= dlt; }
                const float f = __builtin_amdgcn_exp2f(-dlt); l_reg *= f; if (hi == 0) wsf[r32] = f;
#pragma unroll
                for (int r = 0; r < 16; ++r) { const float fr_ = wsf[crow(r, hi)]; o[0][r] *= fr_; o[1][r] *= fr_; }
            }
            float sacc = 0.f;
#pragma unroll
            for (int r = 0; r < 16; ++r) { p0[r] = __builtin_amdgcn_exp2f(p0[r]); p1[r] = __builtin_amdgcn_exp2f(p1[r]); sacc += p0[r] + p1[r]; }
            l_reg += sacc;
            u32x4 pw[4];
            pw[0] = (u32x4){cvtpk_s(p0[0], p0[1]), cvtpk_s(p0[2], p0[3]), cvtpk_s(p0[4], p0[5]), cvtpk_s(p0[6], p0[7])};
            pw[1] = (u32x4){cvtpk_s(p0[8], p0[9]), cvtpk_s(p0[10], p0[11]), cvtpk_s(p0[12], p0[13]), cvtpk_s(p0[14], p0[15])};
            pw[2] = (u32x4){cvtpk_s(p1[0], p1[1]), cvtpk_s(p1[2], p1[3]), cvtpk_s(p1[4], p1[5]), cvtpk_s(p1[6], p1[7])};
            pw[3] = (u32x4){cvtpk_s(p1[8], p1[9]), cvtpk_s(p1[10], p1[11]), cvtpk_s(p1[12], p1[13]), cvtpk_s(p1[14], p1[15])};
            const LAS unsigned char* vp = L + MA_V + slot * MA_VSLOT + ((lane >> 4) & 1) * 32 + (lane & 3) * 8 + (4 * hi + ((lane & 15) >> 2)) * 64;
#pragma unroll
            for (int dh = 0; dh < 2; ++dh)
#pragma unroll
                for (int ks = 0; ks < 4; ++ks) { const s16x4 lo = vtr(vp + dh * 4096 + ks * 1024), hh = vtr(vp + dh * 4096 + ks * 1024 + 512);
                    const bf16x8_t vf = (bf16x8_t){lo[0], lo[1], lo[2], lo[3], hh[0], hh[1], hh[2], hh[3]};
                    o[dh] = __builtin_amdgcn_mfma_f32_32x32x16_bf16(__builtin_bit_cast(bf16x8_t, pw[ks]), vf, o[dh], 0, 0, 0); }
        }
        __syncthreads();
    }
#undef MA_DMA
    { auto rr = __builtin_amdgcn_permlane32_swap(__float_as_uint(l_reg), __float_as_uint(l_reg), false, false); l_reg = __uint_as_float(rr[0]) + __uint_as_float(rr[1]); }
    if (hi == 0) wsf[32 + r32] = l_reg;
    LAS bf16_t* stg = (LAS bf16_t*)(L + MA_OST) + wid * 2048;
#pragma unroll
    for (int r = 0; r < 16; ++r) { const int orow = crow(r, hi); const float rli = __builtin_amdgcn_rcpf(wsf[32 + orow]);
        stg[orow * 64 + r32] = (bf16_t)f2bf(o[0][r] * rli); stg[orow * 64 + 32 + r32] = (bf16_t)f2bf(o[1][r] * rli); }
    bf16_t* Ow = Op + (rowb + q0) * ldo;
#pragma unroll
    for (int i = 0; i < 4; ++i) { const int row = i * 8 + (lane >> 3), ch = lane & 7; const u32x4 v = *(const LAS u32x4*)(stg + row * 64 + ch * 8); *(u32x4*)(Ow + (size_t)row * ldo + ch * 8) = v; }
    __syncthreads();
}
template <int MODE> __device__ __forceinline__ void mattn_phase(Frame& F) {
    constexpr int NH = (MODE == 2) ? 16 : 8;
    const int nunits = BATCH * NH * 8;
    for (int u = F.vcu, r = 0; u < nunits; u += F.G, ++r) {
        const int j = u & 7, bh = u >> 3; const int qb = (r & 1) ? 7 - j : j;
        mattn_unit<MODE>(F, bh / NH, bh % NH, qb);
    }
}

__device__ __forceinline__ void fox_gate_rows(Frame& F, const Args& a) {
    { int t_ = F.tid; asm volatile("" : "+v"(t_)); F.tid = t_; F.lane = t_ & 63; F.wave = __builtin_amdgcn_readfirstlane(t_ >> 6); }
    const int gw = F.vcu * 8 + F.wave, NGW = F.G * 8; const float* W = a.in[19]; const float* g = a.in[6] + DM; const float* bfp = a.in[20];
    const float* ssq = (const float*)(F.ws + WS_SSQ); float* LF = (float*)(F.ws + WS_LF);
    for (int m = gw; m < M; m += NGW) {
        float acc[16];
#pragma unroll
        for (int hh = 0; hh < 16; ++hh) acc[hh] = 0.f;
        for (int j = 0; j < 16; ++j) { const int k = F.lane + 64 * j; const float xg = F.x[(size_t)m * DM + k] * g[k]; const f32x4* wr = (const f32x4*)(W + (size_t)k * 3088 + 3072);
#pragma unroll
            for (int c = 0; c < 4; ++c) { const f32x4 w = wr[c]; acc[c * 4] += xg * w.x; acc[c * 4 + 1] += xg * w.y; acc[c * 4 + 2] += xg * w.z; acc[c * 4 + 3] += xg * w.w; } }
        const float rs = rstd_from16(ssq, m); float mine = 0.f;
#pragma unroll
        for (int hh = 0; hh < 16; ++hh) { const float s = wave_sum(acc[hh]); if (F.lane == hh) mine = s; }
        if (F.lane < 16) { const float z = mine * rs + bfp[F.lane]; LF[(size_t)m * 16 + F.lane] = fminf(z, 0.f) - log1pf(__expf(-fabsf(z))); }
    }
}
__device__ __forceinline__ void fox_scan(Frame& F) {
    { int t_ = F.tid; asm volatile("" : "+v"(t_)); F.tid = t_; F.lane = t_ & 63; F.wave = __builtin_amdgcn_readfirstlane(t_ >> 6); }
    const int gw = F.vcu * 8 + F.wave, NGW = F.G * 8; const float* LF = (const float*)(F.ws + WS_LF); float* cum = (float*)(F.ws + WS_CUM);
    for (int sc = gw; sc < BATCH * 16; sc += NGW) { const int b = sc >> 4, hh = sc & 15;
        float v[32]; float run = 0.f;
#pragma unroll
        for (int i = 0; i < 32; ++i) { run += LF[((size_t)b * SEQ + F.lane * 32 + i) * 16 + hh]; v[i] = run; }
        float incl = run;
#pragma unroll
        for (int o = 1; o < 64; o <<= 1) { const float tt = __shfl_up(incl, o); if (F.lane >= o) incl += tt; }
        const float excl = incl - run;
#pragma unroll
        for (int i = 0; i < 32; ++i) cum[(size_t)sc * SEQ + F.lane * 32 + i] = v[i] + excl;
    }
}
__device__ __forceinline__ void final_norm(Frame& F, const Args& a) {
    { int t_ = F.tid; asm volatile("" : "+v"(t_)); F.tid = t_; F.lane = t_ & 63; F.wave = __builtin_amdgcn_readfirstlane(t_ >> 6); }
    const int gw = F.vcu * 8 + F.wave, NGW = F.G * 8; const float* ssq = (const float*)(F.ws + WS_SSQ); const float* g = a.in[22];
    for (int m = gw; m < M; m += NGW) { const float rs = rstd_from16(ssq, m);
#pragma unroll
        for (int j = 0; j < 4; ++j) { f32x4* p = (f32x4*)(F.x + (size_t)m * DM) + F.lane + 64 * j; const f32x4 gg = *((const f32x4*)g + F.lane + 64 * j); f32x4 v = *p; v = v * rs * gg; *p = v; } }
}

constexpr int NPHASE = 20;
__global__ void __launch_bounds__(512, 2) mk_fwd(Args args) {
    extern __shared__ __attribute__((aligned(16))) unsigned char lds[];
    Frame F;
    F.lds = (LAS unsigned char*)lds; F.ldsg = lds;
    F.MISC = (volatile LAS unsigned*)(F.lds + MISC_OFF);
    F.tid = threadIdx.x; F.lane = F.tid & 63; F.wave = __builtin_amdgcn_readfirstlane(F.tid >> 6);
    F.G = gridDim.x; { const int bx = blockIdx.x; F.vcu = (F.G % 8 == 0) ? (bx % 8) * (F.G / 8) + bx / 8 : bx; }
    F.ws = args.ws; F.x = args.out; F.ctl = (gu32*)(args.ws + WS_CTL);
    for (int u = F.tid; u < (LDS_BYTES - LDSCTL_OFF) / 4; u += 512) ((LAS unsigned*)(F.lds + LDSCTL_OFF))[u] = 0u;
    __syncthreads();
    XcdBarrier bar; bar.bar = (unsigned*)(F.ctl + CW_BAR); bar.x = 0; bar.st = nullptr;
    const bool multi = (args.ph_hi - args.ph_lo) > 1;
    if (multi) bar = xcd_barrier_post((unsigned*)(F.ctl + CW_BAR), F.MISC + 8);
    unsigned char* ws = args.ws;
    bf16_t* XB = (bf16_t*)(ws + WS_XB); float* SSQ = (float*)(ws + WS_SSQ);
    if (args.ph_lo == 0) { prologue(F, args); if (1 < args.ph_hi) xcd_barrier(bar); }
    for (int ph = (args.ph_lo == 0 ? 1 : args.ph_lo); ph < args.ph_hi; ++ph) {
        { unsigned char* w_ = args.ws; asm volatile("" : "+s"(w_)); ws = w_; F.ws = w_; float* x_ = args.out; asm volatile("" : "+s"(x_)); F.x = x_;
          int t_ = threadIdx.x; asm volatile("" : "+v"(t_)); F.tid = t_; F.lane = t_ & 63; F.wave = __builtin_amdgcn_readfirstlane(t_ >> 6);
          XB = (bf16_t*)(ws + WS_XB); SSQ = (float*)(ws + WS_SSQ); }
        const int layer = (ph >= 10) ? 1 : 0; const int lp = (ph == 0 || ph == 19) ? -1 : (ph - 1) - layer * 9;
        if (ph == 19) final_norm(F, args);
        else if (lp == 4) {
#if MK_SCALAR_ATTN
            if (layer == 0) { sattn_phase<0>(F, args, 0); sattn_phase<1>(F, args, 1); }
            else sattn_phase<2>(F, args, 0);
#else
            if (layer == 0) { mattn_phase<0>(F); mattn_phase<1>(F); }
            else mattn_phase<2>(F);
#endif
        } else if (lp == 3 && layer == 1) fox_scan(F);
        else {
            if (lp == 0 && layer == 1) conv_p_rows(F, args.in[1] + (size_t)M * PLED, (bf16_t*)(ws + WS_PB));
            const int njobs = (lp == 8) ? 2 : 1;
            for (int jb = 0; jb < njobs; ++jb) {
                int et; pg8::Gemm g; int N_;
                EpiSwiglu E0{(bf16_t*)(ws + WS_R + R_H), SSQ};
                EpiRes E1{F.x, XB, SSQ, SSQ, (const bf16_t*)(ws + WS_R + R_PP), 1.0f, 0};
                EpiStoreT E2{(bf16_t*)(ws + WS_R + R_QKV), 3072, SSQ, 4, C2A};
                EpiStoreF E3{0, (bf16_t*)(ws + WS_R + R_ZZ), nullptr, SSQ, (float*)(ws + WS_SSQCQ), (float*)(ws + WS_SSQCKV), (bf16_t*)(ws + WS_KR), (float*)(ws + WS_KMP), (const float*)(ws + WS_ROPE), C2A};
                if (lp == 0 || lp == 6) { const int wi = layer * 2 + (lp == 6 ? 1 : 0); et = 0; N_ = 2 * DFF;
                    g = pg8::Gemm{XB, XB, (const bf16_t*)(ws + WS_WFI + (size_t)wi * SZ_WFI), M, 2 * DFF, DM, DM, DM, 1 << 30}; }
                else if (lp == 1 || lp == 7) { const int wi = layer * 2 + (lp == 7 ? 1 : 0); et = 1; N_ = DM; E1.alpha = 0.5f;
                    g = pg8::Gemm{(const bf16_t*)(ws + WS_R + R_H), nullptr, (const bf16_t*)(ws + WS_WFO + (size_t)wi * SZ_WFO), M, DM, DFF, DFF, DFF, 1 << 30}; }
                else if (lp == 5) { et = 1; N_ = DM; E1.alpha = 1.0f;
                    if (layer == 0) g = pg8::Gemm{(const bf16_t*)(ws + WS_R + R_ZZ), nullptr, (const bf16_t*)(ws + WS_WABO), M, DM, DM, 2048, DM, 1 << 30};
                    else g = pg8::Gemm{(const bf16_t*)(ws + WS_R + R_QKV), nullptr, (const bf16_t*)(ws + WS_WFXO), M, DM, DM, 3072, DM, 1 << 30}; }
                else if (lp == 2 && layer == 0) { et = 3; N_ = 2048; g = pg8::Gemm{XB, XB, (const bf16_t*)(ws + WS_WABI), M, 2048, DM, DM, DM, 1 << 30}; }
                else if (lp == 2) { et = 2; N_ = 3072; g = pg8::Gemm{XB, XB, (const bf16_t*)(ws + WS_WFXI), M, 3072, DM, DM, DM, 1 << 30}; }
                else if (lp == 3) { et = 3; N_ = 1792; const bf16_t* ZZ = (const bf16_t*)(ws + WS_R + R_ZZ);
                    g = pg8::Gemm{ZZ + 512, ZZ + 768, (const bf16_t*)(ws + WS_WUP), M, 1792, 256, 2048, 256, 3};
                    E3.mode = 1; E3.qscale = C2M; E3.O = (bf16_t*)(ws + WS_R + R_QMLA); E3.O2 = (bf16_t*)(ws + WS_R + R_KVMLA); }
                else if (jb == 0) { et = 3; N_ = DM; E3.mode = 2; E3.O = (bf16_t*)(ws + WS_R + R_PP);
                    g = pg8::Gemm{(const bf16_t*)(ws + WS_PB), nullptr, (const bf16_t*)(ws + WS_WP + (size_t)layer * DM * PLED * 2), M, DM, PLED, PLED, PLED, 1 << 30}; }
                else { et = 1; N_ = DM; E1.mode = 1; __threadfence(); __syncthreads();
                    g = pg8::Gemm{XB, nullptr, (const bf16_t*)(ws + WS_WG + (size_t)layer * DM * DM * 2), M, DM, DM, DM, DM, 1 << 30}; }
                pg8::StaticOrder S; S.init(M, N_, F.G, (int)blockIdx.x);
#ifndef NO_GEMM
                if (et == 0) pg8::gemm_phase<EpiSwiglu, pg8::StaticOrder, true, true>(F.lds, g, S, E0, F.tid);
                else if (et == 1) pg8::gemm_phase<EpiRes, pg8::StaticOrder, true, true>(F.lds, g, S, E1, F.tid);
                else if (et == 2) pg8::gemm_phase<EpiStoreT, pg8::StaticOrder, true, true>(F.lds, g, S, E2, F.tid);
                else pg8::gemm_phase<EpiStoreF, pg8::StaticOrder, true, true>(F.lds, g, S, E3, F.tid);
#endif
            }
            if (lp == 2 && layer == 1) fox_gate_rows(F, args);
        }
        if (ph + 1 < args.ph_hi) xcd_barrier(bar);
    }
}

extern "C" void kernel_launch(void* const* d_in, const int* in_sizes, int n_in, void* d_out, int out_size, void* d_ws, size_t ws_size, hipStream_t stream) {
    static int grid = 0;
    if (grid == 0) {
        if (n_in != 23 || out_size != M * DM || ws_size < WS_END) { fprintf(stderr, "kernel_launch: unexpected shapes (n_in %d out %d ws %zu)\n", n_in, out_size, ws_size); grid = -1; return; }
        int dev = 0, cus = 0, per_cu = 0;
        if (hipGetDevice(&dev) != hipSuccess || hipDeviceGetAttribute(&cus, hipDeviceAttributeMultiprocessorCount, dev) != hipSuccess) { grid = -1; return; }
        if (hipFuncSetAttribute((const void*)mk_fwd, hipFuncAttributeMaxDynamicSharedMemorySize, LDS_BYTES) != hipSuccess) { fprintf(stderr, "kernel_launch: hipFuncSetAttribute failed\n"); grid = -1; return; }
        if (hipOccupancyMaxActiveBlocksPerMultiprocessor(&per_cu, (const void*)mk_fwd, 512, LDS_BYTES) != hipSuccess || per_cu < 1) { fprintf(stderr, "kernel_launch: occupancy query says %d\n", per_cu); per_cu = 1; }
        (void)hipGetLastError();
        grid = cus;
        if (grid > 256) grid = 256;
        grid -= grid % 8;
    }
    if (grid < 0) return;
    (void)hipMemsetAsync((char*)d_ws + WS_CTL, 0, CTL_ZERO_BYTES, stream);
    Args a{};
    for (int i = 0; i < 23; ++i) a.in[i] = (const float*)d_in[i];
    a.out = (float*)d_out; a.ws = (unsigned char*)d_ws;
#if MK_ONE_LAUNCH
    a.ph_lo = 0; a.ph_hi = NPHASE;
    hipLaunchKernelGGL(mk_fwd, dim3(grid), dim3(512), LDS_BYTES, stream, a);
#else
    for (int ph = 0; ph < NPHASE; ++ph) { a.ph_lo = ph; a.ph_hi = ph + 1; hipLaunchKernelGGL(mk_fwd, dim3(grid), dim3(512), LDS_BYTES, stream, a); }
#endif
}
```

```cpp
#include <hip/hip_runtime.h>
#include <hip/hip_bf16.h>
#include <cstdio>
#include <cstdint>
#include <cmath>

#ifndef MK_SCALAR_ATTN
#define MK_SCALAR_ATTN 0
#endif
#ifndef MK_ONE_LAUNCH
#define MK_ONE_LAUNCH 1
#endif

constexpr int BATCH = 8, SEQ = 2048, DM = 1024, M = BATCH * SEQ, DFF = 2816, PLED = 256;
constexpr float EPS = 1e-6f;
constexpr float LOG2E = 1.4426950408889634f, LN2 = 0.6931471805599453f;
constexpr float C2A = 0.125f * LOG2E, C2M = 0.10206207261596577f * LOG2E;

namespace pg8 {
#define PG8_LAS __attribute__((address_space(3)))
typedef unsigned short bf16_t;
typedef short bf16x8 __attribute__((ext_vector_type(8)));
typedef float f32x4 __attribute__((ext_vector_type(4)));
typedef unsigned u32x4 __attribute__((ext_vector_type(4)));
typedef unsigned u32x2 __attribute__((ext_vector_type(2)));
constexpr int BM = 256, BK = 64, HALF = 128, HTB = HALF * BK * 2, STAGE_BYTES = 8 * HTB, NXCD = 8, WGM = 8;

__host__ __device__ __forceinline__ int lds_byte(int r, int c) { const int st = (r >> 4) * 2 + (c >> 5), rr = r & 15, cc = c & 31, ob = rr * 64 + cc * 2; return st * 1024 + (ob ^ (((ob >> 9) & 1) << 5)); }
__host__ __device__ __forceinline__ void stage_rc(int b, int& R, int& C) { const int st = b / 1024, sb = b % 1024, swz = sb ^ (((sb >> 9) & 1) << 5); R = (st >> 1) * 16 + swz / 64; C = (st & 1) * 32 + (swz % 64) / 2; }
__host__ __device__ __forceinline__ int perm32(int rho) { const int n = rho >> 4, i = rho & 15; return 8 * (i >> 2) + 4 * n + (i & 3); }

struct Unit { int pm, pn; };
struct Gemm { const bf16_t* A; const bf16_t* A2; const bf16_t* Bt; int M, N, K, lda, ldb, pn_split; };

struct StaticOrder {
    int nM, nN, nwg, G, c; int lcnt, lpm, lpn0;
    __host__ __device__ void init(int M_, int N_, int G_, int c_) { nM = M_ / BM; nN = N_ / BM; nwg = nM * nN; G = G_; c = c_; lcnt = 0; lpm = 0; lpn0 = 0; }
    __host__ __device__ bool next(int i, Unit& u) const {
        if (lcnt > 0) { if (i >= lcnt) return false; u.pm = lpm; u.pn = lpn0 + i; return true; }
        const long L = (long)i * G + c; if (L >= nwg) return false;
        int wgid = (int)L; { const int q = nwg / NXCD, r = nwg % NXCD, xcd = wgid % NXCD, off = wgid / NXCD; wgid = (xcd < r ? xcd * (q + 1) : r * (q + 1) + (xcd - r) * q) + off; }
        const int nig = WGM * nN, gid = wgid / nig, fm = gid * WGM, gsz = (nM - fm) < WGM ? (nM - fm) : WGM;
        u.pm = fm + ((wgid % nig) % gsz); u.pn = (wgid % nig) / gsz; return true;
    }
    __device__ __forceinline__ void a_ready(const Unit&) const {}
    __device__ __forceinline__ void done(const Unit&) const {}
};

__device__ __forceinline__ unsigned cvt_pk_bf16(float lo, float hi) { unsigned r; asm volatile("v_cvt_pk_bf16_f32 %0, %1, %2" : "=v"(r) : "v"(lo), "v"(hi)); return r; }

template <class Epi, class Sched, bool ALIGN_EPI = false, bool SP2 = false>
__device__ __forceinline__ void gemm_phase(PG8_LAS unsigned char* lds, const Gemm g, const Sched& S, const Epi& E, int tid, unsigned long long& pacc) {
    asm volatile("" : "+v"(tid));
    const int wid = __builtin_amdgcn_readfirstlane(tid >> 6), lane = tid & 63, wr = wid >> 2, wc = wid & 3, fr = lane & 15, fq = lane >> 4;
    const int K = g.K, nt = K / BK;
    unsigned voffA[2], voffB[2];
#pragma unroll
    for (int i = 0; i < 2; ++i) { int R, C; stage_rc(tid * 16 + i * 8192, R, C); const int Rb = Epi::PERM ? ((R & ~31) + perm32(R & 31)) : R;
        voffA[i] = (unsigned)(R * g.lda + C) * 2u; voffB[i] = (unsigned)(Rb * g.ldb + C) * 2u; }
    const size_t kstep = (size_t)(BK * 2);
    const size_t hstepA = (size_t)HALF * g.lda * 2, hstepB = (size_t)HALF * g.ldb * 2;
    const size_t tstepA = 2 * hstepA, tstepB = 2 * hstepB;
    const unsigned ldsw = (unsigned)wid * 1024u;
    const int aoff = lds_byte(wr * 64 + fr, fq * 8), boff = lds_byte(wc * 32 + fr, fq * 8);
#define PG8_SA(b, h) (((b) * 2 + (h)) * HTB)
#define PG8_SB(b, h) ((4 + (b) * 2 + (h)) * HTB)
#define PG8_STAGE(bufoff, gbase, voff) do { _Pragma("unroll") for (int _i = 0; _i < 2; ++_i) \
        __builtin_amdgcn_global_load_lds((const unsigned*)((const char*)(gbase) + (voff)[_i]), (PG8_LAS unsigned*)(lds + (bufoff) + ldsw + _i * 8192), 16, 0, 0); } while (0)
#define PG8_LDA(dst, b, h) do { _Pragma("unroll") for (int m = 0; m < 4; ++m) _Pragma("unroll") for (int k = 0; k < 2; ++k) dst[m][k] = *(const PG8_LAS bf16x8*)(lds + PG8_SA(b, h) + aoff + m * 2048 + k * 1024); } while (0)
#define PG8_LDB(dst, b, h) do { _Pragma("unroll") for (int n = 0; n < 2; ++n) _Pragma("unroll") for (int k = 0; k < 2; ++k) dst[n][k] = *(const PG8_LAS bf16x8*)(lds + PG8_SB(b, h) + boff + n * 2048 + k * 1024); } while (0)
#define PG8_MMA(ai, bj, At, Bt) do { __builtin_amdgcn_s_setprio(1); _Pragma("unroll") for (int m = 0; m < 4; ++m) _Pragma("unroll") for (int n = 0; n < 2; ++n) _Pragma("unroll") for (int k = 0; k < 2; ++k) \
        acc[ai][bj][m][n] = __builtin_amdgcn_mfma_f32_16x16x32_bf16(Bt[n][k], At[m][k], acc[ai][bj][m][n], 0, 0, 0); __builtin_amdgcn_s_setprio(0); } while (0)
#define PG8_WAIT_V(n) asm volatile("s_waitcnt vmcnt(" #n ")" ::: "memory")
#define PG8_WAIT_L(n) asm volatile("s_waitcnt lgkmcnt(" #n ")" ::: "memory")
#define PG8_BAR __builtin_amdgcn_s_barrier()
#define PG8_SCHED __builtin_amdgcn_sched_barrier(0)
#define PG8_ABASE(u) ((const char*)(((u).pn >= g.pn_split) ? g.A2 : g.A) + (size_t)(u).pm * tstepA)
    Unit cur, nxt; int ui = 0;
    if (!S.next(0, cur)) return;
    f32x4 acc[2][2][4][2];
#pragma unroll
    for (int a = 0; a < 2; ++a)
#pragma unroll
        for (int b = 0; b < 2; ++b)
#pragma unroll
            for (int m = 0; m < 4; ++m)
#pragma unroll
                for (int n = 0; n < 2; ++n) acc[a][b][m][n] = (f32x4){0.f, 0.f, 0.f, 0.f};
    bf16x8 At[4][2], B0[2][2], B1[2][2];
    const char* cA = PG8_ABASE(cur); const char* cB = (const char*)g.Bt + (size_t)cur.pn * tstepB;
    S.a_ready(cur);
    if constexpr (SP2) {
        PG8_STAGE(PG8_SB(0, 0), cB, voffB); PG8_STAGE(PG8_SB(0, 1), cB + hstepB, voffB); PG8_STAGE(PG8_SA(0, 0), cA, voffA); PG8_STAGE(PG8_SA(0, 1), cA + hstepA, voffA);
        if (wr == 1) PG8_BAR;
        PG8_WAIT_V(2); PG8_BAR;
        PG8_STAGE(PG8_SB(1, 0), cB + kstep, voffB); PG8_STAGE(PG8_SA(1, 0), cA + kstep, voffA); PG8_STAGE(PG8_SB(1, 1), cB + hstepB + kstep, voffB);
        PG8_WAIT_V(6); PG8_BAR;
    } else {
        PG8_STAGE(PG8_SB(0, 0), cB, voffB); PG8_STAGE(PG8_SA(0, 0), cA, voffA); PG8_STAGE(PG8_SB(0, 1), cB + hstepB, voffB); PG8_STAGE(PG8_SA(0, 1), cA + hstepA, voffA);
        if (wr == 1) PG8_BAR;
        PG8_WAIT_V(4); PG8_BAR;
        PG8_STAGE(PG8_SB(1, 0), cB + kstep, voffB); PG8_STAGE(PG8_SA(1, 0), cA + kstep, voffA); PG8_STAGE(PG8_SB(1, 1), cB + hstepB + kstep, voffB);
        PG8_WAIT_V(6); PG8_BAR;
    }
    for (;;) {
#ifdef PROBE_G
        const unsigned long long k0_ = __builtin_amdgcn_s_memrealtime();
#endif
        const bool has_next = S.next(ui + 1, nxt);
        const char* nA = has_next ? PG8_ABASE(nxt) : cA; const char* nB = has_next ? (const char*)g.Bt + (size_t)nxt.pn * tstepB : cB;
        for (int t = 0; t < nt; t += 2) {
            const bool last = (t == nt - 2);
            const char* a1 = cA + (size_t)(t + 1) * kstep;
            const char* a2 = last ? nA : cA + (size_t)(t + 2) * kstep; const char* b2 = last ? nB : cB + (size_t)(t + 2) * kstep;
            const char* a3 = a2 + kstep; const char* b3 = b2 + kstep;
            if (last && has_next) S.a_ready(nxt);
            if constexpr (SP2) {
            PG8_LDB(B0, 0, 0); PG8_LDB(B1, 0, 1); PG8_SCHED; PG8_LDA(At, 0, 0); PG8_STAGE(PG8_SA(1, 1), a1 + hstepA, voffA);
            PG8_WAIT_V(8); PG8_WAIT_L(0); PG8_BAR; PG8_MMA(0, 0, At, B0); PG8_MMA(0, 1, At, B1); PG8_BAR; PG8_SCHED;
            PG8_LDA(At, 0, 1); PG8_STAGE(PG8_SB(0, 0), b2, voffB); PG8_STAGE(PG8_SB(0, 1), b2 + hstepB, voffB); PG8_STAGE(PG8_SA(0, 0), a2, voffA);
            PG8_WAIT_V(8); PG8_WAIT_L(0); PG8_BAR; PG8_MMA(1, 0, At, B0); PG8_MMA(1, 1, At, B1); PG8_BAR; PG8_SCHED;
            PG8_LDB(B0, 1, 0); PG8_LDB(B1, 1, 1); PG8_SCHED; PG8_LDA(At, 1, 0); PG8_STAGE(PG8_SA(0, 1), a2 + hstepA, voffA);
            PG8_WAIT_V(8); PG8_WAIT_L(0); PG8_BAR; PG8_MMA(0, 0, At, B0); PG8_MMA(0, 1, At, B1); PG8_BAR; PG8_SCHED;
            PG8_LDA(At, 1, 1); PG8_STAGE(PG8_SB(1, 0), b3, voffB); PG8_STAGE(PG8_SB(1, 1), b3 + hstepB, voffB); PG8_STAGE(PG8_SA(1, 0), a3, voffA);
            PG8_WAIT_V(8); PG8_WAIT_L(0); PG8_BAR; PG8_MMA(1, 0, At, B0); PG8_MMA(1, 1, At, B1); PG8_BAR; PG8_SCHED;
            } else {
            PG8_LDB(B0, 0, 0); PG8_SCHED; PG8_LDA(At, 0, 0); PG8_STAGE(PG8_SA(1, 1), a1 + hstepA, voffA);
            PG8_WAIT_L(8); PG8_BAR; PG8_WAIT_L(0); PG8_MMA(0, 0, At, B0); PG8_BAR; PG8_SCHED;
            PG8_LDB(B1, 0, 1); PG8_STAGE(PG8_SB(0, 0), b2, voffB);
            PG8_BAR; PG8_WAIT_L(0); PG8_MMA(0, 1, At, B1); PG8_BAR;
            PG8_LDA(At, 0, 1); PG8_STAGE(PG8_SA(0, 0), a2, voffA);
            PG8_BAR; PG8_WAIT_L(0); PG8_MMA(1, 0, At, B0); PG8_BAR; PG8_SCHED;
            PG8_STAGE(PG8_SB(0, 1), b2 + hstepB, voffB);
            PG8_WAIT_V(6); PG8_BAR; PG8_MMA(1, 1, At, B1); PG8_BAR;
            PG8_LDB(B0, 1, 0); PG8_SCHED; PG8_LDA(At, 1, 0); PG8_STAGE(PG8_SA(0, 1), a2 + hstepA, voffA);
            PG8_WAIT_L(8); PG8_BAR; PG8_WAIT_L(0); PG8_MMA(0, 0, At, B0); PG8_BAR; PG8_SCHED;
            PG8_LDB(B1, 1, 1); PG8_STAGE(PG8_SB(1, 0), b3, voffB);
            PG8_BAR; PG8_WAIT_L(0); PG8_MMA(0, 1, At, B1); PG8_BAR;
            PG8_LDA(At, 1, 1); PG8_STAGE(PG8_SA(1, 0), a3, voffA);
            PG8_BAR; PG8_WAIT_L(0); PG8_MMA(1, 0, At, B0); PG8_BAR; PG8_SCHED;
            PG8_STAGE(PG8_SB(1, 1), b3 + hstepB, voffB);
            PG8_WAIT_V(6); PG8_BAR; PG8_MMA(1, 1, At, B1); PG8_BAR;
            }
        }
        if constexpr (ALIGN_EPI) { if (wr == 0) PG8_BAR; }
#ifdef PROBE_G
        const unsigned long long e0_ = __builtin_amdgcn_s_memrealtime(); if (PROBE_G == 2 && Epi::PROBE_ID == PROBE_GID) pacc += e0_ - k0_;
#endif
        E(acc, cur, wr, wc, fr, fq);
#ifdef PROBE_G
        if (PROBE_G == 1 && Epi::PROBE_ID == PROBE_GID) pacc += __builtin_amdgcn_s_memrealtime() - e0_;
#endif
        if (!has_next) break;
#pragma unroll
        for (int a = 0; a < 2; ++a)
#pragma unroll
            for (int b = 0; b < 2; ++b)
#pragma unroll
                for (int m = 0; m < 4; ++m)
#pragma unroll
                    for (int n = 0; n < 2; ++n) acc[a][b][m][n] = (f32x4){0.f, 0.f, 0.f, 0.f};
        cur = nxt; cA = nA; cB = nB; ++ui;
        if constexpr (ALIGN_EPI) { if (wr == 1) PG8_BAR; }
    }
    PG8_WAIT_V(0);
    if constexpr (!ALIGN_EPI) { if (wr == 0) PG8_BAR; }
    PG8_BAR;
#undef PG8_SA
#undef PG8_SB
#undef PG8_STAGE
#undef PG8_LDA
#undef PG8_LDB
#undef PG8_MMA
#undef PG8_WAIT_V
#undef PG8_WAIT_L
#undef PG8_BAR
#undef PG8_SCHED
#undef PG8_ABASE
}
}

using pg8::bf16_t; using pg8::f32x4; using pg8::u32x4; using pg8::u32x2; using pg8::Unit; using pg8::cvt_pk_bf16;

#define GAS __attribute__((address_space(1)))
#define LAS __attribute__((address_space(3)))
typedef GAS unsigned gu32;
#define RLX_AGENT __ATOMIC_RELAXED, __HIP_MEMORY_SCOPE_AGENT

constexpr size_t MiB = 1u << 20;
constexpr size_t WS_CTL = 0, CTL_ZERO_BYTES = 1 * MiB;
constexpr size_t WS_SSQ = 1 * MiB;
constexpr size_t WS_LF = 2 * MiB;
constexpr size_t WS_CUM = 3 * MiB;
constexpr size_t WS_ROPE = 4 * MiB;
constexpr size_t WS_BIASD = WS_ROPE + 256 * 1024;
constexpr size_t WS_KMP = WS_BIASD + 64 * 1024;
constexpr size_t WS_SSQCQ = WS_KMP + 256 * 1024;
constexpr size_t WS_SSQCKV = WS_SSQCQ + 256 * 1024;
constexpr size_t WS_KR = WS_SSQCKV + 256 * 1024;
constexpr size_t WS_WFG = 6 * MiB + 256 * 1024;
constexpr size_t WS_SSQ2 = 7 * MiB;
constexpr size_t WS_W = 8 * MiB;
constexpr size_t SZ_WFI = (size_t)2 * DFF * DM * 2, SZ_WFO = (size_t)DM * DFF * 2;
constexpr size_t WS_WFI = WS_W;
constexpr size_t WS_WFO = WS_WFI + 4 * SZ_WFI;
constexpr size_t WS_WABI = WS_WFO + 4 * SZ_WFO;
constexpr size_t WS_WUP = WS_WABI + (size_t)2048 * 1024 * 2;
constexpr size_t WS_WABO = WS_WUP + (size_t)1792 * 256 * 2;
constexpr size_t WS_WFXI = WS_WABO + (size_t)1024 * 1024 * 2;
constexpr size_t WS_WFXO = WS_WFXI + (size_t)3072 * 1024 * 2;
constexpr size_t WS_WG = WS_WFXO + (size_t)1024 * 1024 * 2;
constexpr size_t WS_WP = WS_WG + (size_t)2 * 1024 * 1024 * 2;
constexpr size_t WS_WEND = WS_WP + (size_t)2 * 1024 * 256 * 2;
constexpr size_t WS_XB = 96 * MiB;
constexpr size_t WS_R = 128 * MiB;
constexpr size_t WS_PB = 248 * MiB;
constexpr size_t WS_END = 256 * MiB;
static_assert(WS_WEND <= WS_XB, "weights fit");
constexpr size_t R_H = 0;
constexpr size_t R_ZZ = 0;
constexpr size_t R_QMLA = 64 * MiB;
constexpr size_t R_KVMLA = 88 * MiB;
constexpr size_t R_QKV = 0;
constexpr size_t R_PP = 88 * MiB;

constexpr int CW_BAR = 4096;
constexpr int CW_FIN = 8192;

constexpr int RING_BYTES = 131072;
constexpr int LDSCTL_OFF = 135168, MISC_OFF = LDSCTL_OFF + 320;
constexpr int RTAB_OFF = LDSCTL_OFF + 1024;
constexpr int LDS_BYTES = 147456;
static_assert(RTAB_OFF + 8192 <= LDS_BYTES, "rstd table");

#define XB_TMO      128
#define XB_XCNT(j)  (256  + 64 * (j))
#define XB_XSUB(j)  (1280 + 64 * (j))
#define XB_XGEN(j)  (2304 + 64 * (j))
#define XB_TOP      3328
#define XB_TOPGEN   3392
#define XCD_BAR_WORDS 3456
#define XB_SPIN_CAP (1u << 22)
__device__ __forceinline__ unsigned xb_ld(unsigned* p)              { return __hip_atomic_load(p, __ATOMIC_RELAXED, __HIP_MEMORY_SCOPE_AGENT); }
__device__ __forceinline__ unsigned xb_add(unsigned* p, unsigned v) { return __hip_atomic_fetch_add(p, v, __ATOMIC_RELAXED, __HIP_MEMORY_SCOPE_AGENT); }
__device__ __forceinline__ unsigned xb_xcc_id() { return (unsigned)__builtin_amdgcn_s_getreg((3 << 11) | 20) & 0xFu; }
#define XB_SPIN(cond, bar) do { unsigned _sp = 0; while (cond) { __builtin_amdgcn_s_sleep(1); \
    if ((++_sp & 255u) == 0u) { if (xb_ld(&(bar)[XB_TMO])) break; if (_sp > XB_SPIN_CAP) { atomicAdd(&(bar)[XB_TMO], 1u); break; } } } } while (0)
struct XcdBarrier { unsigned* bar; unsigned x; volatile LAS unsigned* st; };
__device__ __forceinline__ XcdBarrier xcd_barrier_post(unsigned* bar, volatile LAS unsigned* st) {
    XcdBarrier b; b.bar = bar; b.x = xb_xcc_id(); b.st = st;
    if (threadIdx.x == 0) (void)xb_add(&bar[XB_XCNT(b.x)], 1u);
    return b;
}
__device__ __forceinline__ void xcd_barrier_complete(unsigned* bar, unsigned x, unsigned& nloc, unsigned& nx) {
    const unsigned G = gridDim.x * gridDim.y * gridDim.z;
    unsigned sum, cnt, mine, sp = 0u;
    for (;;) {
        sum = 0u; cnt = 0u; mine = 0u;
#pragma unroll
        for (unsigned j = 0; j < 16; ++j) { const unsigned c = xb_ld(&bar[XB_XCNT(j)]); sum += c; cnt += (c > 0u) ? 1u : 0u; mine = (j == x) ? c : mine; }
        if (sum == G) break;
        __builtin_amdgcn_s_sleep(1);
        if ((++sp & 255u) == 0u) { if (xb_ld(&bar[XB_TMO])) break; if (sp > XB_SPIN_CAP) { atomicAdd(&bar[XB_TMO], 1u); break; } }
    }
    nloc = mine > 0u ? mine : 1u; nx = cnt > 0u ? cnt : 1u;
}
__device__ __forceinline__ void xcd_barrier(const XcdBarrier& b) {
    asm volatile("s_waitcnt vmcnt(0)" ::: "memory");
    __syncthreads();
    if (threadIdx.x == 0) {
        unsigned* bar = b.bar;
        __builtin_amdgcn_s_waitcnt(0);
        unsigned nloc = b.st[0], nx = b.st[1];
        if (nloc == 0u) { xcd_barrier_complete(bar, b.x, nloc, nx); b.st[0] = nloc; b.st[1] = nx; }
        const unsigned old = xb_add(&bar[XB_XSUB(b.x)], 1u);
        const unsigned gen = old / nloc;
        if (old + 1u == (gen + 1u) * nloc) {
            __builtin_amdgcn_fence(__ATOMIC_RELEASE, "agent");
            asm volatile("s_waitcnt vmcnt(0)" ::: "memory");
            const unsigned og = xb_add(&bar[XB_TOP], 1u);
            const unsigned tg = og / nx;
            if (og + 1u == (tg + 1u) * nx) xb_add(&bar[XB_TOPGEN], 1u);
            else XB_SPIN(xb_ld(&bar[XB_TOPGEN]) == tg, bar);
            __builtin_amdgcn_fence(__ATOMIC_ACQUIRE, "agent");
            xb_add(&bar[XB_XGEN(b.x)], 1u);
            asm volatile("s_waitcnt vmcnt(0)" ::: "memory");
        } else {
            XB_SPIN(xb_ld(&bar[XB_XGEN(b.x)]) == gen, bar);
            __builtin_amdgcn_fence(__ATOMIC_ACQUIRE, "agent");
            asm volatile("s_waitcnt vmcnt(0)" ::: "memory");
        }
    }
    __syncthreads();
}

__device__ __forceinline__ unsigned f2bf(float f) { unsigned u = __builtin_bit_cast(unsigned, f); return (u + 0x7fffu + ((u >> 16) & 1u)) >> 16; }
__device__ __forceinline__ unsigned pk2(float lo, float hi) { return f2bf(lo) | (f2bf(hi) << 16); }
__device__ __forceinline__ float bf2f(unsigned short b) { return __builtin_bit_cast(float, (unsigned)b << 16); }
__device__ __forceinline__ float wave_sum(float v) {
#pragma unroll
    for (int o = 1; o < 64; o <<= 1) v += __shfl_xor(v, o);
    return v;
}
__device__ __forceinline__ float sum4(f32x4 a) { return (a.x + a.y) + (a.z + a.w); }
__device__ __forceinline__ float rstd_from16(const float* ssq, int row) {
    const f32x4* p = (const f32x4*)(ssq + (size_t)row * 16);
    const float s = (sum4(p[0]) + sum4(p[1])) + (sum4(p[2]) + sum4(p[3]));
    return rsqrtf(s * (1.f / 1024.f) + EPS);
}
__device__ __forceinline__ float rstd_from4(const float* ssq, int row, float invn) {
    const f32x4 a = *(const f32x4*)(ssq + (size_t)row * 4);
    return rsqrtf(sum4(a) * invn + EPS);
}
__device__ __forceinline__ float sigmoidf_(float a) { return __builtin_amdgcn_rcpf(1.f + __expf(-a)); }

struct EpiSwiglu { static constexpr int PROBE_ID = 0;
    static constexpr bool PERM = true;
    bf16_t* H; const LAS float* rtab;
    __device__ __forceinline__ void operator()(const f32x4 (&acc)[2][2][4][2], const Unit& u, int wr, int wc, int fr, int fq) const {
        const int row0 = u.pm * 256 + wr * 64 + fr, col0 = u.pn * 128 + wc * 32 + 8 * fq;
#pragma unroll
        for (int ai = 0; ai < 2; ++ai)
#pragma unroll
            for (int m = 0; m < 4; ++m) {
                const int row = row0 + ai * 128 + m * 16; const float rs = rtab[row & 2047]; const float c1 = -rs * LOG2E, rs2 = rs * rs;
                f32x4 h[2];
#pragma unroll
                for (int n = 0; n < 2; ++n) { const f32x4 a = acc[ai][0][m][n]; const f32x4 t = a * c1; f32x4 e;
                    e.x = __builtin_amdgcn_exp2f(t.x); e.y = __builtin_amdgcn_exp2f(t.y); e.z = __builtin_amdgcn_exp2f(t.z); e.w = __builtin_amdgcn_exp2f(t.w);
                    const f32x4 d = e + 1.0f; f32x4 r; r.x = __builtin_amdgcn_rcpf(d.x); r.y = __builtin_amdgcn_rcpf(d.y); r.z = __builtin_amdgcn_rcpf(d.z); r.w = __builtin_amdgcn_rcpf(d.w);
                    h[n] = (a * r) * (acc[ai][1][m][n] * rs2); }
                u32x4 w; w.x = cvt_pk_bf16(h[0].x, h[0].y); w.y = cvt_pk_bf16(h[0].z, h[0].w); w.z = cvt_pk_bf16(h[1].x, h[1].y); w.w = cvt_pk_bf16(h[1].z, h[1].w);
                *(u32x4*)(H + (size_t)row * DFF + col0) = w;
            }
    }
};

struct EpiRes { static constexpr int PROBE_ID = 1;
    static constexpr bool PERM = false;
    const bf16_t* xin; bf16_t* xb; float* ssq_out; const LAS float* rtab; const bf16_t* pp; float alpha; int mode; int fin; float* out; const float* gfin; unsigned* fincnt;
    __device__ __forceinline__ void operator()(f32x4 (&acc)[2][2][4][2], const Unit& u, int wr, int wc, int fr, int fq) const {
        const int row0 = u.pm * 256 + wr * 64 + fr, col0 = u.pn * 256 + wc * 32 + 4 * fq;
#pragma unroll
        for (int aim = 0; aim < 4; ++aim) { const int ai = aim >> 1, mb = (aim & 1) * 2;
            u32x2 xo[4][2][2], pw[4][2][2]; float rs[4];
#pragma unroll
            for (int m = mb; m < mb + 2; ++m) { const int row = row0 + ai * 128 + m * 16;
#pragma unroll
                for (int bj = 0; bj < 2; ++bj)
#pragma unroll
                    for (int n = 0; n < 2; ++n) { const size_t off = (size_t)row * DM + col0 + bj * 128 + n * 16; xo[m][bj][n] = *(const u32x2*)(xin + off); if (mode == 1) pw[m][bj][n] = *(const u32x2*)(pp + off); }
                rs[m] = 1.f; if (mode == 1) rs[m] = rtab[row & 2047]; }
#pragma unroll
            for (int m = mb; m < mb + 2; ++m) { const int row = row0 + ai * 128 + m * 16; float q = 0.f;
#pragma unroll
                for (int bj = 0; bj < 2; ++bj)
#pragma unroll
                    for (int n = 0; n < 2; ++n) {
                        const size_t off = (size_t)row * DM + col0 + bj * 128 + n * 16; const u32x2 xw = xo[m][bj][n];
                        const f32x4 o_ = (f32x4){__builtin_bit_cast(float, xw.x << 16), __builtin_bit_cast(float, xw.x & 0xffff0000u), __builtin_bit_cast(float, xw.y << 16), __builtin_bit_cast(float, xw.y & 0xffff0000u)};
                        f32x4 xn;
                        if (mode == 1) { const u32x2 w_ = pw[m][bj][n];
                            const float p0 = __builtin_bit_cast(float, w_.x << 16), p1 = __builtin_bit_cast(float, w_.x & 0xffff0000u), p2 = __builtin_bit_cast(float, w_.y << 16), p3 = __builtin_bit_cast(float, w_.y & 0xffff0000u);
                            const f32x4 a = acc[ai][bj][m][n] * rs[m];
                            xn.x = o_.x + sigmoidf_(a.x) * p0; xn.y = o_.y + sigmoidf_(a.y) * p1; xn.z = o_.z + sigmoidf_(a.z) * p2; xn.w = o_.w + sigmoidf_(a.w) * p3;
                        } else xn = o_ + acc[ai][bj][m][n] * alpha;
                        if (fin) { acc[ai][bj][m][n] = xn; q += (xn.x * xn.x + xn.y * xn.y) + (xn.z * xn.z + xn.w * xn.w); }
                        else {
                            u32x2 w; w.x = cvt_pk_bf16(xn.x, xn.y); w.y = cvt_pk_bf16(xn.z, xn.w); *(u32x2*)(xb + off) = w;
                            const float r0 = __builtin_bit_cast(float, w.x << 16), r1 = __builtin_bit_cast(float, w.x & 0xffff0000u), r2 = __builtin_bit_cast(float, w.y << 16), r3 = __builtin_bit_cast(float, w.y & 0xffff0000u);
                            q += (r0 * r0 + r1 * r1) + (r2 * r2 + r3 * r3); }
                    }
                q += __shfl_xor(q, 16); q += __shfl_xor(q, 32);
                if (fq == 0) ssq_out[(size_t)row * 16 + u.pn * 4 + wc] = q; }
        }
        if (fin) {
            asm volatile("s_waitcnt vmcnt(0)" ::: "memory"); __syncthreads();
            if (wr == 0 && wc == 0 && fr == 0 && fq == 0) {
                __builtin_amdgcn_fence(__ATOMIC_RELEASE, "agent"); asm volatile("s_waitcnt vmcnt(0)" ::: "memory");
                unsigned* c_ = fincnt + 64 * u.pm; __hip_atomic_fetch_add(c_, 1u, __ATOMIC_RELAXED, __HIP_MEMORY_SCOPE_AGENT);
                unsigned sp_ = 0; while (__hip_atomic_load(c_, __ATOMIC_RELAXED, __HIP_MEMORY_SCOPE_AGENT) < 4u) { __builtin_amdgcn_s_sleep(1); if (++sp_ > (1u << 22)) break; }
                __builtin_amdgcn_fence(__ATOMIC_ACQUIRE, "agent"); asm volatile("s_waitcnt vmcnt(0)" ::: "memory");
            }
            __syncthreads();
            f32x4 gv[2][2];
#pragma unroll
            for (int bj = 0; bj < 2; ++bj)
#pragma unroll
                for (int n = 0; n < 2; ++n) gv[bj][n] = *(const f32x4*)(gfin + col0 + bj * 128 + n * 16);
#pragma unroll
            for (int ai = 0; ai < 2; ++ai)
#pragma unroll
                for (int m = 0; m < 4; ++m) { const int row = row0 + ai * 128 + m * 16; const float rsf = rstd_from16(ssq_out, row);
#pragma unroll
                    for (int bj = 0; bj < 2; ++bj)
#pragma unroll
                        for (int n = 0; n < 2; ++n) __builtin_nontemporal_store(acc[ai][bj][m][n] * rsf * gv[bj][n], (f32x4*)(out + (size_t)row * DM + col0 + bj * 128 + n * 16)); }
        }
    }
};

struct EpiStoreT { static constexpr int PROBE_ID = 2;
    static constexpr bool PERM = true;
    bf16_t* O; int ldo; const LAS float* rtab; int qtiles; float qscale;
    __device__ __forceinline__ void operator()(const f32x4 (&acc)[2][2][4][2], const Unit& u, int wr, int wc, int fr, int fq) const {
        const int row0 = u.pm * 256 + wr * 64 + fr, col0 = u.pn * 256 + wc * 32 + 8 * fq; const float qs = (u.pn < qtiles) ? qscale : 1.f;
#pragma unroll
        for (int ai = 0; ai < 2; ++ai)
#pragma unroll
            for (int m = 0; m < 4; ++m) {
                const int row = row0 + ai * 128 + m * 16; const float rs = rtab[row & 2047] * qs;
#pragma unroll
                for (int bj = 0; bj < 2; ++bj) { const f32x4 v0 = acc[ai][bj][m][0] * rs, v1 = acc[ai][bj][m][1] * rs;
                    u32x4 w; w.x = cvt_pk_bf16(v0.x, v0.y); w.y = cvt_pk_bf16(v0.z, v0.w); w.z = cvt_pk_bf16(v1.x, v1.y); w.w = cvt_pk_bf16(v1.z, v1.w);
                    *(u32x4*)(O + (size_t)row * ldo + col0 + bj * 128) = w; }
            }
    }
};

struct EpiStoreF { static constexpr int PROBE_ID = 3;
    static constexpr bool PERM = false;
    int mode; bf16_t* O; bf16_t* O2; const LAS float* rtab; float* ssq_cq; float* ssq_ckv; bf16_t* kr; float* kmp; const float* rope; float qscale;
    __device__ __forceinline__ void operator()(const f32x4 (&acc)[2][2][4][2], const Unit& u, int wr, int wc, int fr, int fq) const {
        const int row0 = u.pm * 256 + wr * 64 + fr;
        float colsum[2][2][4];
#pragma unroll
        for (int bj = 0; bj < 2; ++bj)
#pragma unroll
            for (int n = 0; n < 2; ++n)
#pragma unroll
                for (int j = 0; j < 4; ++j) colsum[bj][n][j] = 0.f;
#pragma unroll
        for (int ai = 0; ai < 2; ++ai)
#pragma unroll
            for (int m = 0; m < 4; ++m) {
                const int row = row0 + ai * 128 + m * 16;
                float rs = 1.f;
                if (mode == 0) { rs = rtab[row & 2047]; if (u.pn < 2) rs *= qscale; }
                else if (mode == 1) rs = (u.pn < 3) ? rstd_from4(ssq_cq, row, 1.f / 256.f) * qscale : rstd_from4(ssq_ckv, row, 1.f / 128.f);
                f32x4 v[2][2];
#pragma unroll
                for (int bj = 0; bj < 2; ++bj)
#pragma unroll
                    for (int n = 0; n < 2; ++n) v[bj][n] = acc[ai][bj][m][n] * rs;
                bf16_t* orow; int ocol;
                if (mode == 0) { orow = O + (size_t)row * 2048; ocol = u.pn * 256 + wc * 32 + 4 * fq; }
                else if (mode == 1) { if (u.pn < 3) { orow = O + (size_t)row * 768; ocol = u.pn * 256 + wc * 32 + 4 * fq; } else { orow = O2 + (size_t)row * 1024; ocol = (u.pn - 3) * 256 + wc * 32 + 4 * fq; } }
                else { orow = O + (size_t)row * 1024; ocol = u.pn * 256 + wc * 32 + 4 * fq; }
                if (mode == 0) {
                    if (u.pn == 2) { float q = 0.f;
#pragma unroll
                        for (int bj = 0; bj < 2; ++bj)
#pragma unroll
                            for (int n = 0; n < 2; ++n) q += (v[bj][n].x * v[bj][n].x + v[bj][n].y * v[bj][n].y) + (v[bj][n].z * v[bj][n].z + v[bj][n].w * v[bj][n].w);
                        q += __shfl_xor(q, 16); q += __shfl_xor(q, 32); if (fq == 0) ssq_cq[(size_t)row * 4 + wc] = q; }
                    if (u.pn == 3) { float q = 0.f;
#pragma unroll
                        for (int n = 0; n < 2; ++n) q += (v[0][n].x * v[0][n].x + v[0][n].y * v[0][n].y) + (v[0][n].z * v[0][n].z + v[0][n].w * v[0][n].w);
                        q += __shfl_xor(q, 16); q += __shfl_xor(q, 32); if (fq == 0) ssq_ckv[(size_t)row * 4 + wc] = q;
                        if (wc == 0) {
                            const int pos = row & (SEQ - 1);
                            const f32x4 cs = *(const f32x4*)(rope + (size_t)pos * 16 + 4 * fq), sn = *(const f32x4*)(rope + (size_t)SEQ * 16 + (size_t)pos * 16 + 4 * fq);
                            const f32x4 x1 = v[1][0], x2 = v[1][1];
                            const f32x4 y1 = x1 * cs - x2 * sn, y2 = x1 * sn + x2 * cs;
                            u32x2 w1, w2; w1.x = cvt_pk_bf16(y1.x, y1.y); w1.y = cvt_pk_bf16(y1.z, y1.w); w2.x = cvt_pk_bf16(y2.x, y2.y); w2.y = cvt_pk_bf16(y2.z, y2.w);
                            *(u32x2*)(kr + (size_t)row * 32 + 4 * fq) = w1; *(u32x2*)(kr + (size_t)row * 32 + 16 + 4 * fq) = w2;
                        } }
                    if (u.pn == 4 || u.pn == 5) {
#pragma unroll
                        for (int bj = 0; bj < 2; ++bj)
#pragma unroll
                            for (int n = 0; n < 2; ++n) { colsum[bj][n][0] += v[bj][n].x; colsum[bj][n][1] += v[bj][n].y; colsum[bj][n][2] += v[bj][n].z; colsum[bj][n][3] += v[bj][n].w; }
                    }
                }
                if (mode == 1 && u.pn < 3) {
#pragma unroll
                    for (int bj = 0; bj < 2; ++bj) {
                        const int g32 = u.pn * 8 + bj * 4 + wc;
                        if (g32 % 3 == 2) {
                            const int pos = row & (SEQ - 1);
                            const f32x4 cs = *(const f32x4*)(rope + (size_t)pos * 16 + 4 * fq), sn = *(const f32x4*)(rope + (size_t)SEQ * 16 + (size_t)pos * 16 + 4 * fq);
                            const f32x4 x1 = v[bj][0], x2 = v[bj][1];
                            v[bj][0] = x1 * cs - x2 * sn; v[bj][1] = x1 * sn + x2 * cs;
                        }
                    }
                }
#pragma unroll
                for (int bj = 0; bj < 2; ++bj)
#pragma unroll
                    for (int n = 0; n < 2; ++n) { u32x2 w; w.x = cvt_pk_bf16(v[bj][n].x, v[bj][n].y); w.y = cvt_pk_bf16(v[bj][n].z, v[bj][n].w);
                        *(u32x2*)(orow + ocol + bj * 128 + n * 16) = w; }
            }
        if (mode == 0 && (u.pn == 4 || u.pn == 5)) {
#pragma unroll
            for (int bj = 0; bj < 2; ++bj)
#pragma unroll
                for (int n = 0; n < 2; ++n)
#pragma unroll
                    for (int j = 0; j < 4; ++j) { float s = colsum[bj][n][j];
                        s += __shfl_xor(s, 1); s += __shfl_xor(s, 2); s += __shfl_xor(s, 4); s += __shfl_xor(s, 8);
                        if (fr == 0) kmp[((size_t)u.pm * 2 + wr) * 512 + (u.pn - 4) * 256 + bj * 128 + wc * 32 + n * 16 + 4 * fq + j] = s; }
        }
    }
};

struct Args {
    const float* in[23]; float* out; unsigned char* ws; int ph_lo, ph_hi;
};
struct Frame {
    LAS unsigned char* lds; unsigned char* ldsg; volatile LAS unsigned* MISC; gu32* ctl;
    int tid, lane, wave, vcu, G;
    unsigned char* ws; float* x;
    unsigned long long wacc;
};

__device__ __forceinline__ int fresh_tid_(const Frame& F) { int t_ = F.tid; asm volatile("" : "+v"(t_)); return t_; }
__device__ __forceinline__ void conv_item(const float* W, int ldw, int sc0, const float* gain, bf16_t* WT, int ldt, int n0, int k0, LAS float* scr, int lane, int nvalid, bool ntst) {
    const int lr = lane >> 4, lc = (lane & 15) * 4;
    f32x4 v[16];
#pragma unroll
    for (int i = 0; i < 16; ++i) { const int kk = 4 * i + lr; v[i] = (f32x4){0.f, 0.f, 0.f, 0.f};
        if (sc0 >= 0 && lc < nvalid) v[i] = __builtin_nontemporal_load((const f32x4*)(W + (size_t)(k0 + kk) * ldw + sc0 + lc)); }
#pragma unroll
    for (int i = 0; i < 16; ++i) { const int kk = 4 * i + lr; f32x4 x = v[i]; if (gain) x = x * gain[k0 + kk];
        LAS float* d = scr + kk * 65 + lc; d[0] = x.x; d[1] = x.y; d[2] = x.z; d[3] = x.w; }
    asm volatile("s_waitcnt lgkmcnt(0)" ::: "memory");
    const int c = lane & 7;
#pragma unroll
    for (int j = 0; j < 8; ++j) { const int n = (lane >> 3) + 8 * j; const LAS float* s_ = scr + (8 * c) * 65 + n;
        u32x4 o; o.x = cvt_pk_bf16(s_[0 * 65], s_[1 * 65]); o.y = cvt_pk_bf16(s_[2 * 65], s_[3 * 65]); o.z = cvt_pk_bf16(s_[4 * 65], s_[5 * 65]); o.w = cvt_pk_bf16(s_[6 * 65], s_[7 * 65]);
        if (ntst) __builtin_nontemporal_store(o, (u32x4*)(WT + (size_t)(n0 + n) * ldt + k0 + 8 * c)); else *(u32x4*)(WT + (size_t)(n0 + n) * ldt + k0 + 8 * c) = o; }
    asm volatile("s_waitcnt lgkmcnt(0)" ::: "memory");
}

struct ConvJob { const float* W; int ldw; const float* gain; bf16_t* WT; int K, N, kind; };
__device__ __forceinline__ ConvJob get_job(int j, const Args& a, unsigned char* ws) {
    ConvJob r;
    if (j < 12) { const int l = j / 6, t = j % 6;
        switch (t) {
        case 0: r = ConvJob{a.in[4] + (size_t)l * DM * 2 * DFF, 2 * DFF, a.in[3] + l * DM, (bf16_t*)(ws + WS_WFI + (size_t)(l * 2 + 0) * SZ_WFI), DM, 2 * DFF, 1}; break;
        case 1: r = ConvJob{a.in[8] + (size_t)l * DM * 2 * DFF, 2 * DFF, a.in[7] + l * DM, (bf16_t*)(ws + WS_WFI + (size_t)(l * 2 + 1) * SZ_WFI), DM, 2 * DFF, 1}; break;
        case 2: r = ConvJob{a.in[5] + (size_t)l * DFF * DM, DM, nullptr, (bf16_t*)(ws + WS_WFO + (size_t)(l * 2 + 0) * SZ_WFO), DFF, DM, 0}; break;
        case 3: r = ConvJob{a.in[9] + (size_t)l * DFF * DM, DM, nullptr, (bf16_t*)(ws + WS_WFO + (size_t)(l * 2 + 1) * SZ_WFO), DFF, DM, 0}; break;
        case 4: r = ConvJob{a.in[11] + (size_t)l * DM * DM, DM, a.in[10] + l * DM, (bf16_t*)(ws + WS_WG + (size_t)l * DM * DM * 2), DM, DM, 0}; break;
        default: r = ConvJob{a.in[12] + (size_t)l * PLED * DM, DM, nullptr, (bf16_t*)(ws + WS_WP + (size_t)l * DM * PLED * 2), PLED, DM, 0}; break;
        }
    } else {
        switch (j) {
        case 12: r = ConvJob{a.in[13], 1952, a.in[6], (bf16_t*)(ws + WS_WABI), DM, 2048, 2}; break;
        case 13: r = ConvJob{a.in[15], 768, a.in[14], (bf16_t*)(ws + WS_WUP), 256, 768, 0}; break;
        case 14: r = ConvJob{a.in[17], 1024, a.in[16], (bf16_t*)(ws + WS_WUP + (size_t)768 * 256 * 2), 256, 1024, 5}; break;
        case 15: r = ConvJob{a.in[18], DM, nullptr, (bf16_t*)(ws + WS_WABO), DM, DM, 0}; break;
        case 16: r = ConvJob{a.in[19], 3088, a.in[6] + DM, (bf16_t*)(ws + WS_WFXI), DM, 3072, 0}; break;
        case 17: r = ConvJob{a.in[21], DM, nullptr, (bf16_t*)(ws + WS_WFXO), DM, DM, 0}; break;
        default: r = ConvJob{a.in[19], 3088, a.in[6] + DM, (bf16_t*)(ws + WS_WFG), DM, 64, 6}; break;
        }
    }
    return r;
}
__device__ __forceinline__ int conv_srccol(int kind, int n0) {
    if (kind == 1) { const int pn = n0 >> 8, j = n0 & 255; return j < 128 ? pn * 128 + j : DFF + pn * 128 + (j - 128); }
    if (kind == 2) { if (n0 < 512) return n0; if (n0 < 1024) { const int o = n0 - 512; return o < 416 ? 1536 + o : -1; } if (n0 < 1536) return 512 + (n0 - 1024); return 1024 + (n0 - 1536); }
    return n0;
}

__device__ __forceinline__ void conv_p_rows(Frame& F, const float* p, bf16_t* pb) {
    const int gw = F.vcu * 8 + F.wave, NGW = F.G * 8;
    for (int m0 = gw; m0 < M; m0 += 8 * NGW) { f32x4 v[8];
#pragma unroll
        for (int k = 0; k < 8; ++k) v[k] = __builtin_nontemporal_load((const f32x4*)(p + (size_t)(m0 + k * NGW) * PLED) + F.lane);
#pragma unroll
        for (int k = 0; k < 8; ++k) { u32x2 w; w.x = cvt_pk_bf16(v[k].x, v[k].y); w.y = cvt_pk_bf16(v[k].z, v[k].w); *((u32x2*)(pb + (size_t)(m0 + k * NGW) * PLED) + F.lane) = w; } }
}

__device__ __forceinline__ void prologue(Frame& F, const Args& a) {
    LAS float* scr = (LAS float*)(F.lds + F.wave * 16640);
    const int gw = F.vcu * 8 + F.wave, NGW = F.G * 8;
    unsigned char* ws = F.ws;
    constexpr int nj = 19;
#ifdef PROBE_PRO
    unsigned long long pp0_ = __builtin_amdgcn_s_memrealtime();
#endif
    int base = 0;
    for (int j = 0; j < nj; ++j) {
        const ConvJob jb = get_job(j, a, ws); const int nblk = jb.N / 64, nit = (jb.K / 64) * nblk;
        int first = (gw - base) % NGW; if (first < 0) first += NGW;
        for (int it = first; it < nit; it += NGW) {
            const int kb = it / nblk, nb = it % nblk, k0 = 64 * kb, n0 = 64 * nb;
            int sc0 = conv_srccol(jb.kind, n0);
            if (jb.kind == 5 && k0 >= 128) sc0 = -1;
            if (jb.kind == 6) sc0 = 3072;
            int nvalid = 64; if (jb.kind == 6) nvalid = 16; if (jb.kind == 2 && n0 == 896) nvalid = 32; if (jb.kind == 2 && n0 > 896 && n0 < 1024) sc0 = -1;
            conv_item(jb.W, jb.ldw, sc0, jb.gain, jb.WT, jb.K, n0, k0, scr, F.lane, nvalid, j != 0);
        }
        base = (base + nit) % NGW;
    }
#ifdef PROBE_PRO
    { asm volatile("s_waitcnt vmcnt(0)" ::: "memory"); const unsigned long long t_ = __builtin_amdgcn_s_memrealtime(); if (PROBE_PRO == 1) F.wacc += t_ - pp0_; pp0_ = t_; }
#endif
    {
        const float* xin = a.in[0]; bf16_t* xb = (bf16_t*)(ws + WS_R + R_PP); float* ssq = (float*)(ws + WS_SSQ2);
        for (int m0 = gw; m0 < M; m0 += 4 * NGW) {
            f32x4 v[4][4];
#pragma unroll
            for (int k = 0; k < 4; ++k)
#pragma unroll
                for (int j = 0; j < 4; ++j) v[k][j] = __builtin_nontemporal_load((const f32x4*)(xin + (size_t)(m0 + k * NGW) * DM) + F.lane + 64 * j);
#pragma unroll
            for (int k = 0; k < 4; ++k) { const int m = m0 + k * NGW; float s = 0.f;
#pragma unroll
                for (int j = 0; j < 4; ++j) { u32x2 w; w.x = cvt_pk_bf16(v[k][j].x, v[k][j].y); w.y = cvt_pk_bf16(v[k][j].z, v[k][j].w); *((u32x2*)(xb + (size_t)m * DM) + F.lane + 64 * j) = w;
                    const float r0 = __builtin_bit_cast(float, w.x << 16), r1 = __builtin_bit_cast(float, w.x & 0xffff0000u), r2 = __builtin_bit_cast(float, w.y << 16), r3 = __builtin_bit_cast(float, w.y & 0xffff0000u);
                    s += (r0 * r0 + r1 * r1) + (r2 * r2 + r3 * r3); }
                s = wave_sum(s);
                if (F.lane < 16) ssq[(size_t)m * 16 + F.lane] = (F.lane == 0) ? s : 0.f; }
        }
    }
#ifdef PROBE_PRO
    { asm volatile("s_waitcnt vmcnt(0)" ::: "memory"); const unsigned long long t_ = __builtin_amdgcn_s_memrealtime(); if (PROBE_PRO == 2) F.wacc += t_ - pp0_; pp0_ = t_; }
#endif
    conv_p_rows(F, a.in[1], (bf16_t*)(ws + WS_PB));
    {
        float* rope = (float*)(ws + WS_ROPE); const int gt = F.vcu * 512 + F.tid, NGT = F.G * 512;
        for (int e = gt; e < SEQ * 16; e += NGT) { const int pos = e >> 4, i = e & 15;
            const float inv = powf(10000.f, -(float)i / 16.f); const float ang = (float)pos * inv;
            rope[e] = (float)cos((double)ang); rope[SEQ * 16 + e] = (float)sin((double)ang); }
        float* biasd = (float*)(ws + WS_BIASD); const float* t5 = a.in[2];
        for (int e = gt; e < 8 * 128; e += NGT) { const int h = e >> 7, d = e & 127; int bk;
            if (d < 16) bk = d; else { bk = 16 + (int)(logf((float)d / 16.f) / 2.0794415416798357f * 16.f); if (bk > 31) bk = 31; }
            biasd[e] = t5[bk * 8 + h]; }
    }
#ifdef PROBE_PRO
    { asm volatile("s_waitcnt vmcnt(0)" ::: "memory"); const unsigned long long t_ = __builtin_amdgcn_s_memrealtime(); if (PROBE_PRO == 3) F.wacc += t_ - pp0_; }
#endif
}

constexpr int SA_HALF_FLOATS = 64 * 96 + 64 * 64 + 64 + 128;
template <int MODE> __device__ __forceinline__ void sattn_unit(Frame& F, const Args& a, int b, int h, int qb) {
    constexpr int DQ = (MODE == 1) ? 96 : 64;
    const int half = F.tid >> 8, t = F.tid & 255;
    float* ldsf = (float*)F.ldsg + half * SA_HALF_FLOATS;
    float* Ks = ldsf; float* Vs = Ks + 64 * DQ; float* Cs = Vs + 64 * 64; float* Bs = Cs + 64;
    unsigned char* ws = F.ws;
    const bf16_t *Qp, *K1, *K2 = nullptr, *Vp; bf16_t* Op; int ldq, ldk1, ldv, ldo; float scale;
    if (MODE == 0) { const bf16_t* ZZ = (const bf16_t*)(ws + WS_R + R_ZZ); Qp = ZZ + h * 64; ldq = 2048; K1 = ZZ + 1024 + h * 64; ldk1 = 2048; Vp = ZZ + 1536 + h * 64; ldv = 2048; Op = (bf16_t*)ZZ + h * 64; ldo = 2048; scale = LN2; }
    else if (MODE == 1) { const bf16_t* QM = (const bf16_t*)(ws + WS_R + R_QMLA); const bf16_t* KV = (const bf16_t*)(ws + WS_R + R_KVMLA);
        Qp = QM + h * 96; ldq = 768; K1 = KV + h * 128; ldk1 = 1024; K2 = (const bf16_t*)(ws + WS_KR); Vp = KV + h * 128 + 64; ldv = 1024; Op = (bf16_t*)(ws + WS_R + R_ZZ) + 512 + h * 64; ldo = 2048; scale = LN2; }
    else { const bf16_t* QKV = (const bf16_t*)(ws + WS_R + R_QKV); Qp = QKV + h * 64; ldq = 3072; K1 = QKV + 1024 + h * 64; ldk1 = 3072; Vp = QKV + 2048 + h * 64; ldv = 3072; Op = (bf16_t*)QKV + h * 64; ldo = 3072; scale = LN2; }
    const int qpos = qb * 256 + t; const size_t row = (size_t)b * SEQ + qpos;
    float q[DQ];
#pragma unroll
    for (int c = 0; c < DQ / 8; ++c) { const u32x4 w = *(const u32x4*)(Qp + row * ldq + c * 8);
        q[c * 8 + 0] = __builtin_bit_cast(float, w.x << 16); q[c * 8 + 1] = __builtin_bit_cast(float, w.x & 0xffff0000u);
        q[c * 8 + 2] = __builtin_bit_cast(float, w.y << 16); q[c * 8 + 3] = __builtin_bit_cast(float, w.y & 0xffff0000u);
        q[c * 8 + 4] = __builtin_bit_cast(float, w.z << 16); q[c * 8 + 5] = __builtin_bit_cast(float, w.z & 0xffff0000u);
        q[c * 8 + 6] = __builtin_bit_cast(float, w.w << 16); q[c * 8 + 7] = __builtin_bit_cast(float, w.w & 0xffff0000u); }
    unsigned sel = 0xffu; float b31 = 0.f;
    if (MODE == 0) {
        const float* kmp = (const float*)(ws + WS_KMP);
        float gsc[8];
#pragma unroll
        for (int n = 0; n < 8; ++n) { gsc[n] = -INFINITY;
            if (n < qb) { const float* k0 = kmp + ((size_t)(b * 8 + n) * 2 + 0) * 512 + h * 64; const float* k1 = k0 + 512; float s = 0.f;
#pragma unroll
                for (int d = 0; d < 64; ++d) s += q[d] * (k0[d] + k1[d]);
                gsc[n] = s; } }
        sel = 0u; const int nsel = qb < 3 ? qb : 3;
        for (int r = 0; r < nsel; ++r) { int best = -1; float bv = -INFINITY;
#pragma unroll
            for (int n = 0; n < 8; ++n) { if (n < qb && !((sel >> n) & 1u) && (best < 0 || gsc[n] > bv)) { best = n; bv = gsc[n]; } }
            sel |= 1u << best; }
        const float* biasd = (const float*)(ws + WS_BIASD) + h * 128;
        if (t < 128) Bs[t] = biasd[t];
        b31 = biasd[127];
    }
#pragma unroll
    for (int d = 0; d < DQ; ++d) q[d] *= scale;
    float cq = 0.f; const float* cum = (const float*)(ws + WS_CUM) + (size_t)(b * 16 + h) * SEQ;
    if (MODE == 2) cq = cum[qpos];
    float o[64];
#pragma unroll
    for (int d = 0; d < 64; ++d) o[d] = 0.f;
    float mrun = -INFINITY, l = 0.f;
    const int ntiles = (qb + 1) * 4;
    for (int kt = 0; kt < ntiles; ++kt) {
        __syncthreads();
        for (int ch = t; ch < 64 * DQ / 8; ch += 256) { const int key = ch / (DQ / 8), c8 = ch % (DQ / 8), d0 = c8 * 8; const size_t kr = (size_t)b * SEQ + kt * 64 + key;
            const bf16_t* src = (d0 < 64) ? (K1 + kr * ldk1 + d0) : (K2 + kr * 32 + (d0 - 64));
            const u32x4 w = *(const u32x4*)src; float* dst = Ks + key * DQ + d0;
            dst[0] = __builtin_bit_cast(float, w.x << 16); dst[1] = __builtin_bit_cast(float, w.x & 0xffff0000u); dst[2] = __builtin_bit_cast(float, w.y << 16); dst[3] = __builtin_bit_cast(float, w.y & 0xffff0000u);
            dst[4] = __builtin_bit_cast(float, w.z << 16); dst[5] = __builtin_bit_cast(float, w.z & 0xffff0000u); dst[6] = __builtin_bit_cast(float, w.w << 16); dst[7] = __builtin_bit_cast(float, w.w & 0xffff0000u); }
        for (int ch = t; ch < 64 * 64 / 8; ch += 256) { const int key = ch / 8, d0 = (ch % 8) * 8; const size_t kr = (size_t)b * SEQ + kt * 64 + key;
            const u32x4 w = *(const u32x4*)(Vp + kr * ldv + d0); float* dst = Vs + key * 64 + d0;
            dst[0] = __builtin_bit_cast(float, w.x << 16); dst[1] = __builtin_bit_cast(float, w.x & 0xffff0000u); dst[2] = __builtin_bit_cast(float, w.y << 16); dst[3] = __builtin_bit_cast(float, w.y & 0xffff0000u);
            dst[4] = __builtin_bit_cast(float, w.z << 16); dst[5] = __builtin_bit_cast(float, w.z & 0xffff0000u); dst[6] = __builtin_bit_cast(float, w.w << 16); dst[7] = __builtin_bit_cast(float, w.w & 0xffff0000u); }
        if (MODE == 2) { if (t < 64) Cs[t] = cum[kt * 64 + t]; }
        __syncthreads();
        bool active = true;
        if (MODE == 0) { const int blk = kt >> 2; active = (blk == qb) || ((sel >> blk) & 1u); }
        if (active) {
#pragma unroll 1
            for (int j = 0; j < 64; ++j) {
                const int kp = kt * 64 + j;
                if (kp <= qpos) {
                    const float* kr = Ks + j * DQ; float acc = 0.f;
#pragma unroll
                    for (int d = 0; d < DQ; d += 4) { const f32x4 kv = *(const f32x4*)(kr + d); acc += q[d] * kv.x + q[d + 1] * kv.y + q[d + 2] * kv.z + q[d + 3] * kv.w; }
                    if (MODE == 0) { const int dist = qpos - kp; acc += (dist >= 128) ? b31 : Bs[dist]; }
                    if (MODE == 2) acc += cq - Cs[j];
                    if (acc > mrun) { const float corr = __expf(mrun - acc); l *= corr;
#pragma unroll
                        for (int d = 0; d < 64; ++d) o[d] *= corr;
                        mrun = acc; }
                    const float p = __expf(acc - mrun); l += p; const float* vr = Vs + j * 64;
#pragma unroll
                    for (int d = 0; d < 64; d += 4) { const f32x4 vv = *(const f32x4*)(vr + d); o[d] += p * vv.x; o[d + 1] += p * vv.y; o[d + 2] += p * vv.z; o[d + 3] += p * vv.w; }
                }
            }
        }
    }
    const float inv = 1.f / l;
#pragma unroll
    for (int c = 0; c < 8; ++c) { u32x4 w; w.x = pk2(o[c * 8] * inv, o[c * 8 + 1] * inv); w.y = pk2(o[c * 8 + 2] * inv, o[c * 8 + 3] * inv); w.z = pk2(o[c * 8 + 4] * inv, o[c * 8 + 5] * inv); w.w = pk2(o[c * 8 + 6] * inv, o[c * 8 + 7] * inv);
        *(u32x4*)(Op + row * ldo + c * 8) = w; }
    __syncthreads();
}
template <int MODE> __device__ __forceinline__ void sattn_phase(Frame& F, const Args& a, int flip) {
    constexpr int NH = (MODE == 2) ? 16 : 8;
    const int npairs = BATCH * (NH / 2) * 8, half = F.tid >> 8;
    for (int u = blockIdx.x, r = 0; u < npairs; u += F.G, ++r) {
        const int j = u & 7, bh2 = u >> 3; const int qb = ((r + flip) & 1) ? 7 - j : j;
        const int b = bh2 / (NH / 2), hp = bh2 % (NH / 2);
        sattn_unit<MODE>(F, a, b, hp * 2 + half, qb);
    }
}


typedef short bf16x8_t __attribute__((ext_vector_type(8)));
typedef short s16x4 __attribute__((ext_vector_type(4)));
typedef float f32x16 __attribute__((ext_vector_type(16)));
typedef short v4i16_t __attribute__((ext_vector_type(4)));
typedef float f32x2_t __attribute__((ext_vector_type(2))); typedef __bf16 bf16x2_t __attribute__((ext_vector_type(2)));
constexpr int MA_NSLOT = 4, MA_K = 0, MA_KSLOT = 12288, MA_V = 49152, MA_VSLOT = 8192, MA_WS = 81920, MA_OST = 83968, MA_C2 = 116736, MA_BT = 124928, MA_KM = 125952, MA_END = 130048;
static_assert(MA_END <= RING_BYTES, "attention LDS map");
constexpr float MA_THR = 6.0f;
__device__ __forceinline__ int crow(int r, int hi) { return (r & 3) + 8 * (r >> 2) + 4 * hi; }
__device__ __forceinline__ s16x4 vtr(const LAS unsigned char* p) { return __builtin_bit_cast(s16x4, __builtin_amdgcn_ds_read_tr16_b64_v4i16((LAS v4i16_t*)p)); }
__device__ __forceinline__ unsigned cvtpk_s(float lo, float hi) { f32x2_t v = {lo, hi}; bf16x2_t b = __builtin_convertvector(v, bf16x2_t); return __builtin_bit_cast(unsigned, b); }
__device__ __forceinline__ float swapmax(float m) { auto rr = __builtin_amdgcn_permlane32_swap(__float_as_uint(m), __float_as_uint(m), false, false); return fmaxf(__uint_as_float(rr[0]), __uint_as_float(rr[1])); }

template <int MODE> __device__ __forceinline__ void mattn_unit(Frame& F, int b, int h, int qb) {
    constexpr int DQ = (MODE == 1) ? 96 : 64, NKS = DQ / 16;
    int tid = F.tid; asm volatile("" : "+v"(tid));
    const int lane = tid & 63, wid = __builtin_amdgcn_readfirstlane(tid >> 6), r32 = lane & 31, hi = lane >> 5;
    LAS unsigned char* L = F.lds; unsigned char* ws = F.ws;
    const bf16_t *Qp, *K1, *K2 = nullptr, *Vp; bf16_t* Op; int ldq, ldk, ldv, ldo;
    if (MODE == 0) { const bf16_t* ZZ = (const bf16_t*)(ws + WS_R + R_ZZ); Qp = ZZ + h * 64; ldq = 2048; K1 = ZZ + 1024 + h * 64; ldk = 2048; Vp = ZZ + 1536 + h * 64; ldv = 2048; Op = (bf16_t*)ZZ + h * 64; ldo = 2048; }
    else if (MODE == 1) { const bf16_t* QM = (const bf16_t*)(ws + WS_R + R_QMLA); const bf16_t* KV = (const bf16_t*)(ws + WS_R + R_KVMLA);
        Qp = QM + h * 96; ldq = 768; K1 = KV + h * 128; ldk = 1024; K2 = (const bf16_t*)(ws + WS_KR); Vp = KV + h * 128 + 64; ldv = 1024; Op = (bf16_t*)(ws + WS_R + R_ZZ) + 512 + h * 64; ldo = 2048; }
    else { const bf16_t* QKV = (const bf16_t*)(ws + WS_R + R_QKV); Qp = QKV + h * 64; ldq = 3072; K1 = QKV + 1024 + h * 64; ldk = 3072; Vp = QKV + 2048 + h * 64; ldv = 3072; Op = (bf16_t*)QKV + h * 64; ldo = 3072; }
    const size_t rowb = (size_t)b * SEQ; const int q0 = qb * 256 + wid * 32;
    bf16x8_t qr[NKS];
#pragma unroll
    for (int d0 = 0; d0 < NKS; ++d0) qr[d0] = *(const bf16x8_t*)(Qp + (rowb + q0 + r32) * ldq + d0 * 16 + hi * 8);
    const int NT = 4 * qb + 4, tlast = 4 * qb + (wid >> 1);
    LAS float* wsf = (LAS float*)(L + MA_WS) + wid * 64;
    LAS float* C2 = (LAS float*)(L + MA_C2); LAS float* BT = (LAS float*)(L + MA_BT);
#define MA_DMA(t, slot) do { \
    { const bf16_t* s_ = K1 + (rowb + (size_t)(t) * 64 + lane) * ldk + wid * 8; \
      __builtin_amdgcn_global_load_lds((const unsigned*)s_, (LAS unsigned*)(L + MA_K + (slot) * MA_KSLOT + wid * 1024), 16, 0, 0); } \
    if (MODE == 1) { const bf16_t* s_ = K2 + (rowb + (size_t)(t) * 64 + lane) * 32 + (wid & 3) * 8; \
      __builtin_amdgcn_global_load_lds((const unsigned*)s_, (LAS unsigned*)(L + MA_K + (slot) * MA_KSLOT + (8 + (wid & 3)) * 1024), 16, 0, 0); } \
    { const bf16_t* s_ = Vp + (rowb + (size_t)(t) * 64 + 16 * (wid & 3) + (lane >> 2)) * ldv + (wid >> 2) * 32 + (lane & 3) * 8; \
      __builtin_amdgcn_global_load_lds((const unsigned*)s_, (LAS unsigned*)(L + MA_V + (slot) * MA_VSLOT + wid * 1024), 16, 0, 0); } } while (0)
    if (MODE == 2) {
        const float* lft = (const float*)(ws + WS_CUM) + (size_t)(b * 16 + h) * SEQ; LAS float* wtot = (LAS float*)(L + MA_WS);
        f32x4 v = (f32x4){0.f, 0.f, 0.f, 0.f}; if (4 * tid < NT * 64) v = *(const f32x4*)(lft + 4 * tid);
        v.y += v.x; v.z += v.y; v.w += v.z; float incl = v.w;
#pragma unroll
        for (int o_ = 1; o_ < 64; o_ <<= 1) { const float tt = __shfl_up(incl, o_); if (lane >= o_) incl += tt; }
        if (lane == 63) wtot[wid] = incl;
        __syncthreads();
        float woff = 0.f;
#pragma unroll
        for (int w_ = 0; w_ < 8; ++w_) { const float tw = wtot[w_]; if (w_ < wid) woff += tw; }
        const float ex = incl - v.w + woff;
        if (4 * tid < NT * 64) *(LAS f32x4*)(C2 + 4 * tid) = (f32x4){v.x + ex, v.y + ex, v.z + ex, v.w + ex};
        __syncthreads();
    }
    if (MODE == 0) {
        const float* biasd = (const float*)(ws + WS_BIASD) + h * 128;
        if (tid < 256) BT[tid] = tid < 128 ? (biasd[tid] - biasd[127]) * LOG2E : 0.f;
        if (tid < 256) {
            const int c = tid >> 5, row = tid & 31, n = row & 7, part = row >> 3; u32x4 w = (u32x4){0u, 0u, 0u, 0u};
            if (part < 2) { const float* k0 = (const float*)(ws + WS_KMP) + ((size_t)(b * 8 + n) * 2) * 512 + h * 64 + c * 8; const float* k1 = k0 + 512; unsigned e[8];
#pragma unroll
                for (int j = 0; j < 8; ++j) { const float v = (k0[j] + k1[j]) * (1.f / 256.f); const unsigned hb = f2bf(v); const unsigned lb = f2bf(v - __builtin_bit_cast(float, hb << 16)); e[j] = part == 0 ? hb : lb; }
                w.x = e[0] | (e[1] << 16); w.y = e[2] | (e[3] << 16); w.z = e[4] | (e[5] << 16); w.w = e[6] | (e[7] << 16); }
            *(LAS u32x4*)(L + MA_KM + c * 512 + row * 16) = w; }
    }
    MA_DMA(0, 0); MA_DMA(1, 1); MA_DMA(2, 2);
    if (MODE == 1) asm volatile("s_waitcnt vmcnt(6)" ::: "memory"); else asm volatile("s_waitcnt vmcnt(4)" ::: "memory");
    asm volatile("s_waitcnt lgkmcnt(0)" ::: "memory"); __builtin_amdgcn_s_barrier(); asm volatile("" ::: "memory");
    unsigned sel = 0u;
    if (MODE == 0) {
        f32x16 g;
#pragma unroll
        for (int r = 0; r < 16; ++r) g[r] = 0.f;
#pragma unroll
        for (int d0 = 0; d0 < 4; ++d0) { const bf16x8_t kf = *(const LAS bf16x8_t*)(L + MA_KM + (2 * d0 + hi) * 512 + r32 * 16); g = __builtin_amdgcn_mfma_f32_32x32x16_bf16(kf, qr[d0], g, 0, 0, 0); }
        float gate[8];
#pragma unroll
        for (int j = 0; j < 4; ++j) { const float gv = g[j] + g[4 + j]; auto rr = __builtin_amdgcn_permlane32_swap(__float_as_uint(gv), __float_as_uint(gv), false, false); gate[j] = __uint_as_float(rr[0]); gate[4 + j] = __uint_as_float(rr[1]); }
        const int nsel = qb < 3 ? qb : 3;
        for (int r = 0; r < nsel; ++r) { int best = -1; float bv = -INFINITY;
#pragma unroll
            for (int n = 0; n < 8; ++n) { if (n < qb && !((sel >> n) & 1u) && (best < 0 || gate[n] > bv)) { best = n; bv = gate[n]; } }
            sel |= 1u << (best & 7); }
    }
    float mhat = -1000.f, l_reg = 0.f; f32x16 o[2];
#pragma unroll
    for (int r = 0; r < 16; ++r) { o[0][r] = 0.f; o[1][r] = 0.f; }
    f32x16 cvec; int cvblk = -1;
#pragma unroll
    for (int r = 0; r < 16; ++r) cvec[r] = -mhat;
    for (int t = 0; t < NT; ++t) {
        const int slot = t & 3;
        if (t <= tlast) {
            if (MODE == 0) { const int n = t >> 2; if (n != cvblk) { cvblk = n; const bool valid = (n == qb) || ((sel >> n) & 1u); const float ci = valid ? -mhat : -1e30f;
#pragma unroll
                for (int r = 0; r < 16; ++r) cvec[r] = ci; } }
            f32x16 p0, p1;
            const LAS unsigned char* kb = L + MA_K + slot * MA_KSLOT + hi * 1024 + r32 * 16;
            bf16x8_t kf[2 * NKS];
#pragma unroll
            for (int d0 = 0; d0 < NKS; ++d0) { kf[2 * d0] = *(const LAS bf16x8_t*)(kb + d0 * 2048); kf[2 * d0 + 1] = *(const LAS bf16x8_t*)(kb + d0 * 2048 + 512); }
            f32x4 cb0[4], cb1[4];
            if (MODE == 2) {
#pragma unroll
                for (int g = 0; g < 4; ++g) { cb0[g] = *(const LAS f32x4*)(C2 + t * 64 + 4 * hi + 8 * g); cb1[g] = *(const LAS f32x4*)(C2 + t * 64 + 32 + 4 * hi + 8 * g); }
            }
            __builtin_amdgcn_sched_barrier(0);
#pragma unroll
            for (int d0 = 0; d0 < NKS; ++d0) {
                if (d0 == 0) { p0 = __builtin_amdgcn_mfma_f32_32x32x16_bf16(kf[0], qr[0], cvec, 0, 0, 0); p1 = __builtin_amdgcn_mfma_f32_32x32x16_bf16(kf[1], qr[0], cvec, 0, 0, 0); }
                else { p0 = __builtin_amdgcn_mfma_f32_32x32x16_bf16(kf[2 * d0], qr[d0], p0, 0, 0, 0); p1 = __builtin_amdgcn_mfma_f32_32x32x16_bf16(kf[2 * d0 + 1], qr[d0], p1, 0, 0, 0); } }
            const LAS unsigned char* vp = L + MA_V + slot * MA_VSLOT + ((lane >> 4) & 1) * 32 + (lane & 3) * 8 + (4 * hi + ((lane & 15) >> 2)) * 64;
            s16x4 vlo[8], vhh[8];
#pragma unroll
            for (int i = 0; i < 8; ++i) { vlo[i] = vtr(vp + (i >> 2) * 4096 + (i & 3) * 1024); vhh[i] = vtr(vp + (i >> 2) * 4096 + (i & 3) * 1024 + 512); }
            __builtin_amdgcn_sched_barrier(0);
            if (MODE == 2) {
#pragma unroll
                for (int g = 0; g < 4; ++g) {
#pragma unroll
                    for (int j = 0; j < 4; ++j) { p0[4 * g + j] -= cb0[g][j]; p1[4 * g + j] -= cb1[g][j]; } }
            }
            const int dl = q0 - 64 * t + r32 - 4 * hi;
            if (MODE == 0) {
                if (t + 3 >= tlast) {
#pragma unroll
                    for (int r = 0; r < 16; ++r) { const int i0 = dl - ((r & 3) + 8 * (r >> 2)), i1 = i0 - 32;
                        const float b0 = BT[min(max(i0, 0), 128)], b1 = BT[min(max(i1, 0), 128)];
                        p0[r] = i0 < 0 ? -1e30f : p0[r] + b0; p1[r] = i1 < 0 ? -1e30f : p1[r] + b1; }
                }
            } else if (t == tlast) {
#pragma unroll
                for (int r = 0; r < 16; ++r) { const int i0 = dl - ((r & 3) + 8 * (r >> 2)), i1 = i0 - 32; if (i0 < 0) p0[r] = -1e30f; if (i1 < 0) p1[r] = -1e30f; }
            }
#define MX3(a_, b_, c_) __builtin_fmaxf(__builtin_fmaxf((a_), (b_)), (c_))
            float rm; { float a_ = MX3(p0[0], p0[1], p1[0]), b_ = MX3(p0[2], p0[3], p1[1]); a_ = MX3(a_, p1[2], p1[3]);
#pragma unroll
                for (int r = 4; r < 16; r += 4) { a_ = MX3(a_, p0[r], p0[r + 1]); b_ = MX3(b_, p0[r + 2], p0[r + 3]); a_ = MX3(a_, p1[r], p1[r + 1]); b_ = MX3(b_, p1[r + 2], p1[r + 3]); }
                rm = __builtin_fmaxf(a_, b_); }
#undef MX3
            rm = swapmax(rm);
            if (__any(rm > MA_THR)) {
                const float dlt = fmaxf(rm, 0.f); mhat += dlt;
#pragma unroll
                for (int r = 0; r < 16; ++r) { p0[r] -= dlt; p1[r] -= dlt; }
                { bool valid_ = true; if (MODE == 0) { const int n = t >> 2; valid_ = (n == qb) || ((sel >> n) & 1u); } const float ci = valid_ ? -mhat : -1e30f;
#pragma unroll
                  for (int r = 0; r < 16; ++r) cvec[r] = ci; }
                const float f = __builtin_amdgcn_exp2f(-dlt); l_reg *= f; if (hi == 0) wsf[r32] = f;
#pragma unroll
                for (int r = 0; r < 16; ++r) { const float fr_ = wsf[crow(r, hi)]; o[0][r] *= fr_; o[1][r] *= fr_; }
            }
            float sacc = 0.f;
#pragma unroll
            for (int r = 0; r < 16; ++r) { p0[r] = __builtin_amdgcn_exp2f(p0[r]); p1[r] = __builtin_amdgcn_exp2f(p1[r]); sacc += p0[r] + p1[r]; }
            l_reg += sacc;
            u32x4 pw[4];
            pw[0] = (u32x4){cvtpk_s(p0[0], p0[1]), cvtpk_s(p0[2], p0[3]), cvtpk_s(p0[4], p0[5]), cvtpk_s(p0[6], p0[7])};
            pw[1] = (u32x4){cvtpk_s(p0[8], p0[9]), cvtpk_s(p0[10], p0[11]), cvtpk_s(p0[12], p0[13]), cvtpk_s(p0[14], p0[15])};
            pw[2] = (u32x4){cvtpk_s(p1[0], p1[1]), cvtpk_s(p1[2], p1[3]), cvtpk_s(p1[4], p1[5]), cvtpk_s(p1[6], p1[7])};
            pw[3] = (u32x4){cvtpk_s(p1[8], p1[9]), cvtpk_s(p1[10], p1[11]), cvtpk_s(p1[12], p1[13]), cvtpk_s(p1[14], p1[15])};
#pragma unroll
            for (int dh = 0; dh < 2; ++dh)
#pragma unroll
                for (int ks = 0; ks < 4; ++ks) { const s16x4 lo = vlo[dh * 4 + ks], hh = vhh[dh * 4 + ks];
                    const bf16x8_t vf = (bf16x8_t){lo[0], lo[1], lo[2], lo[3], hh[0], hh[1], hh[2], hh[3]};
                    o[dh] = __builtin_amdgcn_mfma_f32_32x32x16_bf16(__builtin_bit_cast(bf16x8_t, pw[ks]), vf, o[dh], 0, 0, 0); }
        }
        if (t + 3 < NT) MA_DMA(t + 3, (t + 3) & 3);
        if (MODE == 1) { if (t + 3 < NT) asm volatile("s_waitcnt vmcnt(6)" ::: "memory"); else if (t + 2 < NT) asm volatile("s_waitcnt vmcnt(3)" ::: "memory"); else asm volatile("s_waitcnt vmcnt(0)" ::: "memory"); }
        else { if (t + 3 < NT) asm volatile("s_waitcnt vmcnt(4)" ::: "memory"); else if (t + 2 < NT) asm volatile("s_waitcnt vmcnt(2)" ::: "memory"); else asm volatile("s_waitcnt vmcnt(0)" ::: "memory"); }
        asm volatile("s_waitcnt lgkmcnt(0)" ::: "memory"); __builtin_amdgcn_s_barrier(); asm volatile("" ::: "memory");
    }
#undef MA_DMA
    { auto rr = __builtin_amdgcn_permlane32_swap(__float_as_uint(l_reg), __float_as_uint(l_reg), false, false); l_reg = __uint_as_float(rr[0]) + __uint_as_float(rr[1]); }
    if (hi == 0) wsf[32 + r32] = l_reg;
    LAS bf16_t* stg = (LAS bf16_t*)(L + MA_OST) + wid * 2048;
#pragma unroll
    for (int r = 0; r < 16; ++r) { const int orow = crow(r, hi); const float rli = __builtin_amdgcn_rcpf(wsf[32 + orow]);
        stg[orow * 64 + r32] = (bf16_t)f2bf(o[0][r] * rli); stg[orow * 64 + 32 + r32] = (bf16_t)f2bf(o[1][r] * rli); }
    bf16_t* Ow = Op + (rowb + q0) * ldo;
#pragma unroll
    for (int i = 0; i < 4; ++i) { const int row = i * 8 + (lane >> 3), ch = lane & 7; const u32x4 v = *(const LAS u32x4*)(stg + row * 64 + ch * 8); *(u32x4*)(Ow + (size_t)row * ldo + ch * 8) = v; }
    __syncthreads();
}
template <int MODE> __device__ __forceinline__ void mattn_phase(Frame& F) {
    constexpr int NH = (MODE == 2) ? 16 : 8;
    if (F.G == 256) {
        const int x = (int)blockIdx.x & 7, j = (int)blockIdx.x >> 3, jj = j & 7;
        for (int r = 0; r < NH / 4; ++r) { const int h = (j >> 3) + 4 * r; const int qb = (r & 1) ? 7 - jj : jj; mattn_unit<MODE>(F, x, h, qb); }
    } else {
        const int nunits = BATCH * NH * 8;
        for (int u = F.vcu, r = 0; u < nunits; u += F.G, ++r) {
            const int jj = u & 7, bh = u >> 3; const int qb = (r & 1) ? 7 - jj : jj;
            mattn_unit<MODE>(F, bh / NH, bh % NH, qb);
        }
    }
}

__device__ __forceinline__ void fox_gate_rows(Frame& F, const Args& a) {
    { int t_ = F.tid; asm volatile("" : "+v"(t_)); F.tid = t_; F.lane = t_ & 63; F.wave = __builtin_amdgcn_readfirstlane(t_ >> 6); }
    const int gw = F.vcu * 8 + F.wave, NGW = F.G * 8; const float* bfp = a.in[20];
    const float* ssq = (const float*)(F.ws + WS_SSQ); float* LF = (float*)(F.ws + WS_CUM);
    const bf16_t* XBp = (const bf16_t*)(F.ws + WS_XB); const bf16_t* Wg = (const bf16_t*)(F.ws + WS_WFG);
    const int fr = F.lane & 15, fq = F.lane >> 4;
    for (int g = gw; g < M / 16; g += NGW) {
        const bf16_t* ap = XBp + (size_t)(g * 16 + fr) * DM + fq * 8; const bf16_t* bp = Wg + (size_t)fr * DM + fq * 8;
        f32x4 acc = (f32x4){0.f, 0.f, 0.f, 0.f};
#pragma unroll 8
        for (int k = 0; k < DM / 32; ++k) { const pg8::bf16x8 av = *(const pg8::bf16x8*)(ap + k * 32), bv = *(const pg8::bf16x8*)(bp + k * 32);
            acc = __builtin_amdgcn_mfma_f32_16x16x32_bf16(av, bv, acc, 0, 0, 0); }
        const float bb = bfp[fr];
#pragma unroll
        for (int r = 0; r < 4; ++r) { const int row = g * 16 + fq * 4 + r; const float z = acc[r] * rstd_from16(ssq, row) + bb;
            LF[((size_t)(row >> 11) * 16 + fr) * SEQ + (row & (SEQ - 1))] = (fminf(z, 0.f) - log1pf(__expf(-fabsf(z)))) * LOG2E; }
    }
}
__device__ __forceinline__ void fox_scan(Frame& F) {
    { int t_ = F.tid; asm volatile("" : "+v"(t_)); F.tid = t_; F.lane = t_ & 63; F.wave = __builtin_amdgcn_readfirstlane(t_ >> 6); }
    const int gw = F.vcu * 8 + F.wave, NGW = F.G * 8; const float* LF = (const float*)(F.ws + WS_LF); float* cum = (float*)(F.ws + WS_CUM);
    for (int sc = gw; sc < BATCH * 16; sc += NGW) { const int b = sc >> 4, hh = sc & 15;
        float v[32]; float run = 0.f;
#pragma unroll
        for (int i = 0; i < 32; ++i) { run += LF[((size_t)b * SEQ + F.lane * 32 + i) * 16 + hh]; v[i] = run; }
        float incl = run;
#pragma unroll
        for (int o = 1; o < 64; o <<= 1) { const float tt = __shfl_up(incl, o); if (F.lane >= o) incl += tt; }
        const float excl = incl - run;
#pragma unroll
        for (int i = 0; i < 32; ++i) cum[(size_t)sc * SEQ + F.lane * 32 + i] = v[i] + excl;
    }
}
__device__ __forceinline__ void final_norm(Frame& F, const Args& a) {
    { int t_ = F.tid; asm volatile("" : "+v"(t_)); F.tid = t_; F.lane = t_ & 63; F.wave = __builtin_amdgcn_readfirstlane(t_ >> 6); }
    const int gw = F.vcu * 8 + F.wave, NGW = F.G * 8; const float* ssq = (const float*)(F.ws + WS_SSQ2); const float* g = a.in[22]; const bf16_t* xs = (const bf16_t*)(F.ws + WS_R + R_PP);
    for (int m = gw; m < M; m += NGW) { const float rs = rstd_from16(ssq, m);
#pragma unroll
        for (int j = 0; j < 4; ++j) { const u32x2 xw = *((const u32x2*)(xs + (size_t)m * DM) + F.lane + 64 * j); const f32x4 gg = *((const f32x4*)g + F.lane + 64 * j);
            f32x4 v = (f32x4){__builtin_bit_cast(float, xw.x << 16), __builtin_bit_cast(float, xw.x & 0xffff0000u), __builtin_bit_cast(float, xw.y << 16), __builtin_bit_cast(float, xw.y & 0xffff0000u)};
            v = v * rs * gg; *((f32x4*)(F.x + (size_t)m * DM) + F.lane + 64 * j) = v; } }
}

constexpr int NPHASE = 20;
__global__ void __launch_bounds__(512, 2) mk_fwd(Args args) {
    extern __shared__ __attribute__((aligned(16))) unsigned char lds[];
    Frame F;
    F.lds = (LAS unsigned char*)lds; F.ldsg = lds;
    F.MISC = (volatile LAS unsigned*)(F.lds + MISC_OFF);
    F.tid = threadIdx.x; F.lane = F.tid & 63; F.wave = __builtin_amdgcn_readfirstlane(F.tid >> 6);
    F.G = gridDim.x; { const int bx = blockIdx.x; F.vcu = (F.G % 8 == 0) ? (bx % 8) * (F.G / 8) + bx / 8 : bx; }
    F.ws = args.ws; F.x = args.out; F.ctl = (gu32*)(args.ws + WS_CTL); F.wacc = 0ull;
    for (int u = F.tid; u < (LDS_BYTES - LDSCTL_OFF) / 4; u += 512) ((LAS unsigned*)(F.lds + LDSCTL_OFF))[u] = 0u;
    __syncthreads();
    XcdBarrier bar; bar.bar = (unsigned*)(F.ctl + CW_BAR); bar.x = 0; bar.st = nullptr;
    const bool multi = (args.ph_hi - args.ph_lo) > 1;
    if (multi) bar = xcd_barrier_post((unsigned*)(F.ctl + CW_BAR), F.MISC + 8);
    unsigned char* ws = args.ws;
    bf16_t* XB = (bf16_t*)(ws + WS_XB); float* SSQ = (float*)(ws + WS_SSQ);
#ifdef PROBE_MASK
    unsigned long long pr_acc = 0ull, pr_t0 = __builtin_amdgcn_s_memrealtime();
#define PROBE_MARK(ph_) do { const unsigned long long t_ = __builtin_amdgcn_s_memrealtime(); if ((PROBE_MASK >> (ph_)) & 1u) pr_acc += t_ - pr_t0; pr_t0 = t_; } while (0)
#else
#define PROBE_MARK(ph_) do {} while (0)
#endif
    if (args.ph_lo == 0) { prologue(F, args); if (1 < args.ph_hi) xcd_barrier(bar); PROBE_MARK(0); }
    for (int ph = (args.ph_lo == 0 ? 1 : args.ph_lo); ph < args.ph_hi; ++ph) {
        { unsigned char* w_ = args.ws; asm volatile("" : "+s"(w_)); ws = w_; F.ws = w_; float* x_ = args.out; asm volatile("" : "+s"(x_)); F.x = x_;
          int t_ = threadIdx.x; asm volatile("" : "+v"(t_)); F.tid = t_; F.lane = t_ & 63; F.wave = __builtin_amdgcn_readfirstlane(t_ >> 6);
          XB = (bf16_t*)(ws + WS_XB); SSQ = (float*)(ws + WS_SSQ); }
        const int layer = (ph >= 10) ? 1 : 0; const int lp = (ph == 0 || ph == 19) ? -1 : (ph - 1) - layer * 9;
        if (lp == 3 && layer == 1) continue;
        const bool fuse_fin = (F.G == 256);
        if (ph == 19) { if (fuse_fin) continue; final_norm(F, args); PROBE_MARK(ph); continue; }
        if (lp == 4) {
#if MK_SCALAR_ATTN
            if (layer == 0) { sattn_phase<0>(F, args, 0); sattn_phase<1>(F, args, 1); }
            else sattn_phase<2>(F, args, 0);
#else
            if (layer == 0) { mattn_phase<0>(F); mattn_phase<1>(F); }
            else mattn_phase<2>(F);
#endif
        } else {
            if (lp == 0 && layer == 1) conv_p_rows(F, args.in[1] + (size_t)M * PLED, (bf16_t*)(ws + WS_PB));
            if (lp == 0 || lp == 6 || lp == 2 || lp == 8) {
                const float* sq = (lp == 0) ? (const float*)(ws + WS_SSQ2) : (const float*)SSQ; LAS float* rt = (LAS float*)(F.lds + RTAB_OFF); const int rb = ((int)blockIdx.x & 7) * 2048; const int t0 = fresh_tid_(F);
                for (int r = t0; r < 2048; r += 512) rt[r] = rstd_from16(sq, rb + r);
                __syncthreads(); }
            const int njobs = (lp == 6) ? 2 : 1;
            for (int jb = 0; jb < njobs; ++jb) {
                int et; pg8::Gemm g; int N_;
                bf16_t* XB2 = (bf16_t*)(ws + WS_R + R_PP); float* SSQ2 = (float*)(ws + WS_SSQ2);
                const LAS float* RT = (const LAS float*)(F.lds + RTAB_OFF);
                EpiSwiglu E0{(bf16_t*)(ws + WS_R + R_H), RT};
                EpiRes E1{XB, XB, SSQ, RT, (const bf16_t*)(ws + WS_R + R_PP), 1.0f, 0, 0, F.x, args.in[22], (unsigned*)(F.ctl + CW_FIN)};
                EpiStoreT E2{(bf16_t*)(ws + WS_R + R_QKV), 3072, RT, 4, C2A};
                EpiStoreF E3{0, (bf16_t*)(ws + WS_R + R_ZZ), nullptr, RT, (float*)(ws + WS_SSQCQ), (float*)(ws + WS_SSQCKV), (bf16_t*)(ws + WS_KR), (float*)(ws + WS_KMP), (const float*)(ws + WS_ROPE), C2A};
                int Gs = F.G, cs = (int)blockIdx.x;
                int lcnt = 0, lpm = 0, lpn0 = 0;
                if (jb == 1) { et = 3; N_ = DM; E3.mode = 2; E3.O = (bf16_t*)(ws + WS_R + R_PP);
                    g = pg8::Gemm{(const bf16_t*)(ws + WS_PB), nullptr, (const bf16_t*)(ws + WS_WP + (size_t)layer * DM * PLED * 2), M, DM, PLED, PLED, PLED, 1 << 30};
                    Gs = F.G / 2; cs = (int)blockIdx.x - F.G / 2; if (cs < 0) cs = 1 << 28; }
                else if (lp == 0 || lp == 6) { const int wi = layer * 2 + (lp == 6 ? 1 : 0); et = 0; N_ = 2 * DFF;
                    const bf16_t* A_ = (lp == 0) ? XB2 : XB;
                    g = pg8::Gemm{A_, A_, (const bf16_t*)(ws + WS_WFI + (size_t)wi * SZ_WFI), M, 2 * DFF, DM, DM, DM, 1 << 30}; }
                else if (lp == 1 || lp == 7) { const int wi = layer * 2 + (lp == 7 ? 1 : 0); et = 1; N_ = DM; E1.alpha = 0.5f; if (lp == 1) E1.xin = XB2;
                    g = pg8::Gemm{(const bf16_t*)(ws + WS_R + R_H), nullptr, (const bf16_t*)(ws + WS_WFO + (size_t)wi * SZ_WFO), M, DM, DFF, DFF, DFF, 1 << 30}; }
                else if (lp == 5) { et = 1; N_ = DM; E1.alpha = 1.0f;
                    if (layer == 0) g = pg8::Gemm{(const bf16_t*)(ws + WS_R + R_ZZ), nullptr, (const bf16_t*)(ws + WS_WABO), M, DM, DM, 2048, DM, 1 << 30};
                    else g = pg8::Gemm{(const bf16_t*)(ws + WS_R + R_QKV), nullptr, (const bf16_t*)(ws + WS_WFXO), M, DM, DM, 3072, DM, 1 << 30}; }
                else if (lp == 2 && layer == 0) { et = 3; N_ = 2048; g = pg8::Gemm{XB, XB, (const bf16_t*)(ws + WS_WABI), M, 2048, DM, DM, DM, 1 << 30}; }
                else if (lp == 2) { et = 2; N_ = 3072; g = pg8::Gemm{XB, XB, (const bf16_t*)(ws + WS_WFXI), M, 3072, DM, DM, DM, 1 << 30}; }
                else if (lp == 3) { et = 3; N_ = 1792; const bf16_t* ZZ = (const bf16_t*)(ws + WS_R + R_ZZ);
                    g = pg8::Gemm{ZZ + 512, ZZ + 768, (const bf16_t*)(ws + WS_WUP), M, 1792, 256, 2048, 256, 3};
                    E3.mode = 1; E3.qscale = C2M; E3.O = (bf16_t*)(ws + WS_R + R_QMLA); E3.O2 = (bf16_t*)(ws + WS_R + R_KVMLA); }
                else { et = 1; N_ = DM; E1.mode = 1; E1.xb = XB2; E1.ssq_out = SSQ2; E1.fin = (layer == 1 && fuse_fin) ? 1 : 0;
                    g = pg8::Gemm{XB, nullptr, (const bf16_t*)(ws + WS_WG + (size_t)layer * DM * DM * 2), M, DM, DM, DM, DM, 1 << 30}; }
                pg8::StaticOrder S; S.init(M, N_, Gs, cs); S.lcnt = lcnt; S.lpm = lpm; S.lpn0 = lpn0;
#ifndef NO_GEMM
                if (et == 0) pg8::gemm_phase<EpiSwiglu, pg8::StaticOrder, true, true>(F.lds, g, S, E0, F.tid, F.wacc);
                else if (et == 1) pg8::gemm_phase<EpiRes, pg8::StaticOrder, true, true>(F.lds, g, S, E1, F.tid, F.wacc);
                else if (et == 2) pg8::gemm_phase<EpiStoreT, pg8::StaticOrder, true, true>(F.lds, g, S, E2, F.tid, F.wacc);
                else pg8::gemm_phase<EpiStoreF, pg8::StaticOrder, true, true>(F.lds, g, S, E3, F.tid, F.wacc);
#endif
            }
            if (lp == 2 && layer == 1) fox_gate_rows(F, args);
        }
        if (ph + 1 < args.ph_hi && !(ph == 18 && fuse_fin)) xcd_barrier(bar);
#ifdef PROBE_XBAR
        if (ph == 4) { for (int i_ = 0; i_ < 16; ++i_) xcd_barrier(bar); }
#endif
        PROBE_MARK(ph);
    }
#if defined(PROBE_PRO) || defined(PROBE_G)
    if (blockIdx.x == 0 && threadIdx.x == 0) { const unsigned long long t_ = __builtin_amdgcn_s_memrealtime(); while (__builtin_amdgcn_s_memrealtime() - t_ < 4ull * F.wacc) __builtin_amdgcn_s_sleep(8); }
#endif
#ifdef PROBE_MASK
    if (blockIdx.x == 0 && threadIdx.x == 0) { const unsigned long long t_ = __builtin_amdgcn_s_memrealtime(); while (__builtin_amdgcn_s_memrealtime() - t_ < 4ull * pr_acc) __builtin_amdgcn_s_sleep(8); }
#endif
}

extern "C" void kernel_launch(void* const* d_in, const int* in_sizes, int n_in, void* d_out, int out_size, void* d_ws, size_t ws_size, hipStream_t stream) {
    static int grid = 0;
    if (grid == 0) {
        if (n_in != 23 || out_size != M * DM || ws_size < WS_END) { fprintf(stderr, "kernel_launch: unexpected shapes (n_in %d out %d ws %zu)\n", n_in, out_size, ws_size); grid = -1; return; }
        int dev = 0, cus = 0, per_cu = 0;
        if (hipGetDevice(&dev) != hipSuccess || hipDeviceGetAttribute(&cus, hipDeviceAttributeMultiprocessorCount, dev) != hipSuccess) { grid = -1; return; }
        if (hipFuncSetAttribute((const void*)mk_fwd, hipFuncAttributeMaxDynamicSharedMemorySize, LDS_BYTES) != hipSuccess) { fprintf(stderr, "kernel_launch: hipFuncSetAttribute failed\n"); grid = -1; return; }
        if (hipOccupancyMaxActiveBlocksPerMultiprocessor(&per_cu, (const void*)mk_fwd, 512, LDS_BYTES) != hipSuccess || per_cu < 1) { fprintf(stderr, "kernel_launch: occupancy query says %d\n", per_cu); per_cu = 1; }
        (void)hipGetLastError();
        grid = cus;
        if (grid > 256) grid = 256;
        grid -= grid % 8;
    }
    if (grid < 0) return;
    (void)hipMemsetAsync((char*)d_ws + WS_CTL, 0, CTL_ZERO_BYTES, stream);
    Args a{};
    for (int i = 0; i < 23; ++i) a.in[i] = (const float*)d_in[i];
    a.out = (float*)d_out; a.ws = (unsigned char*)d_ws;
#if MK_ONE_LAUNCH
    a.ph_lo = 0; a.ph_hi = NPHASE;
    hipLaunchKernelGGL(mk_fwd, dim3(grid), dim3(512), LDS_BYTES, stream, a);
#else
    for (int ph = 0; ph < NPHASE; ++ph) { a.ph_lo = ph; a.ph_hi = ph + 1; hipLaunchKernelGGL(mk_fwd, dim3(grid), dim3(512), LDS_BYTES, stream, a); }
#endif
}
```

```cpp
#include <hip/hip_runtime.h>
#include <hip/hip_bf16.h>
#include <cstdio>
#include <cstdint>
#include <cmath>

#ifndef MK_SCALAR_ATTN
#define MK_SCALAR_ATTN 0
#endif
#ifndef MK_ONE_LAUNCH
#define MK_ONE_LAUNCH 1
#endif

constexpr int BATCH = 8, SEQ = 2048, DM = 1024, M = BATCH * SEQ, DFF = 2816, PLED = 256;
constexpr float EPS = 1e-6f;
constexpr float LOG2E = 1.4426950408889634f, LN2 = 0.6931471805599453f;
constexpr float C2A = 0.125f * LOG2E, C2M = 0.10206207261596577f * LOG2E;

namespace pg8 {
#define PG8_LAS __attribute__((address_space(3)))
typedef unsigned short bf16_t;
typedef short bf16x8 __attribute__((ext_vector_type(8)));
typedef float f32x4 __attribute__((ext_vector_type(4)));
typedef unsigned u32x4 __attribute__((ext_vector_type(4)));
typedef unsigned u32x2 __attribute__((ext_vector_type(2)));
constexpr int BM = 256, BK = 64, HALF = 128, HTB = HALF * BK * 2, STAGE_BYTES = 8 * HTB, NXCD = 8, WGM = 8;

__host__ __device__ __forceinline__ int lds_byte(int r, int c) { const int st = (r >> 4) * 2 + (c >> 5), rr = r & 15, cc = c & 31, ob = rr * 64 + cc * 2; return st * 1024 + (ob ^ (((ob >> 9) & 1) << 5)); }
__host__ __device__ __forceinline__ void stage_rc(int b, int& R, int& C) { const int st = b / 1024, sb = b % 1024, swz = sb ^ (((sb >> 9) & 1) << 5); R = (st >> 1) * 16 + swz / 64; C = (st & 1) * 32 + (swz % 64) / 2; }
__host__ __device__ __forceinline__ int perm32(int rho) { const int n = rho >> 4, i = rho & 15; return 8 * (i >> 2) + 4 * n + (i & 3); }

struct Unit { int pm, pn; };
struct Gemm { const bf16_t* A; const bf16_t* A2; const bf16_t* Bt; int M, N, K, lda, ldb, pn_split; size_t slabA; };

struct StaticOrder {
    int nM, nN, nwg, G, c; int lcnt, lpm, lpn0;
    __host__ __device__ void init(int M_, int N_, int G_, int c_) { nM = M_ / BM; nN = N_ / BM; nwg = nM * nN; G = G_; c = c_; lcnt = 0; lpm = 0; lpn0 = 0; }
    __host__ __device__ bool next(int i, Unit& u) const {
        if (lcnt > 0) { if (i >= lcnt) return false; u.pm = lpm; u.pn = lpn0 + i; return true; }
        const long L = (long)i * G + c; if (L >= nwg) return false;
        int wgid = (int)L; { const int q = nwg / NXCD, r = nwg % NXCD, xcd = wgid % NXCD, off = wgid / NXCD; wgid = (xcd < r ? xcd * (q + 1) : r * (q + 1) + (xcd - r) * q) + off; }
        const int nig = WGM * nN, gid = wgid / nig, fm = gid * WGM, gsz = (nM - fm) < WGM ? (nM - fm) : WGM;
        u.pm = fm + ((wgid % nig) % gsz); u.pn = (wgid % nig) / gsz; return true;
    }
    __device__ __forceinline__ void a_ready(const Unit&) const {}
    __device__ __forceinline__ void done(const Unit&) const {}
};

__device__ __forceinline__ unsigned cvt_pk_bf16(float lo, float hi) { unsigned r; asm volatile("v_cvt_pk_bf16_f32 %0, %1, %2" : "=v"(r) : "v"(lo), "v"(hi)); return r; }

template <class Epi, class Sched, bool ALIGN_EPI = false, bool SP2 = false>
__device__ __forceinline__ void gemm_phase(PG8_LAS unsigned char* lds, const Gemm g, const Sched& S, const Epi& E, int tid, unsigned long long& pacc) {
    asm volatile("" : "+v"(tid));
    const int wid = __builtin_amdgcn_readfirstlane(tid >> 6), lane = tid & 63, wr = wid >> 2, wc = wid & 3, fr = lane & 15, fq = lane >> 4;
    const int K = g.K, nt = K / BK;
    unsigned voffA[2], voffB[2];
#pragma unroll
    for (int i = 0; i < 2; ++i) { int R, C; stage_rc(tid * 16 + i * 8192, R, C); const int Rb = Epi::PERM ? ((R & ~31) + perm32(R & 31)) : R;
        voffA[i] = (unsigned)(R * g.lda + C) * 2u; voffB[i] = (unsigned)(Rb * g.ldb + C) * 2u; }
    const size_t kstep = (size_t)(BK * 2);
    const size_t hstepA = (size_t)HALF * g.lda * 2, hstepB = (size_t)HALF * g.ldb * 2;
    const size_t tstepA = 2 * hstepA, tstepB = 2 * hstepB;
    const unsigned ldsw = (unsigned)wid * 1024u;
    const int aoff = lds_byte(wr * 64 + fr, fq * 8), boff = lds_byte(wc * 32 + fr, fq * 8);
#define PG8_SA(b, h) (((b) * 2 + (h)) * HTB)
#define PG8_SB(b, h) ((4 + (b) * 2 + (h)) * HTB)
#define PG8_STAGE(bufoff, gbase, voff) do { _Pragma("unroll") for (int _i = 0; _i < 2; ++_i) \
        __builtin_amdgcn_global_load_lds((const unsigned*)((const char*)(gbase) + (voff)[_i]), (PG8_LAS unsigned*)(lds + (bufoff) + ldsw + _i * 8192), 16, 0, 0); } while (0)
#define PG8_LDA(dst, b, h) do { _Pragma("unroll") for (int m = 0; m < 4; ++m) _Pragma("unroll") for (int k = 0; k < 2; ++k) dst[m][k] = *(const PG8_LAS bf16x8*)(lds + PG8_SA(b, h) + aoff + m * 2048 + k * 1024); } while (0)
#define PG8_LDB(dst, b, h) do { _Pragma("unroll") for (int n = 0; n < 2; ++n) _Pragma("unroll") for (int k = 0; k < 2; ++k) dst[n][k] = *(const PG8_LAS bf16x8*)(lds + PG8_SB(b, h) + boff + n * 2048 + k * 1024); } while (0)
#define PG8_MMA(ai, bj, At, Bt) do { __builtin_amdgcn_s_setprio(1); _Pragma("unroll") for (int m = 0; m < 4; ++m) _Pragma("unroll") for (int n = 0; n < 2; ++n) _Pragma("unroll") for (int k = 0; k < 2; ++k) \
        acc[ai][bj][m][n] = __builtin_amdgcn_mfma_f32_16x16x32_bf16(Bt[n][k], At[m][k], acc[ai][bj][m][n], 0, 0, 0); __builtin_amdgcn_s_setprio(0); } while (0)
#define PG8_WAIT_V(n) asm volatile("s_waitcnt vmcnt(" #n ")" ::: "memory")
#define PG8_WAIT_L(n) asm volatile("s_waitcnt lgkmcnt(" #n ")" ::: "memory")
#define PG8_BAR __builtin_amdgcn_s_barrier()
#define PG8_SCHED __builtin_amdgcn_sched_barrier(0)
#define PG8_ABASE(u) ((const char*)(((u).pn >= g.pn_split) ? g.A2 : g.A) + (size_t)((u).pm >> 3) * g.slabA + (size_t)((u).pm & 7) * tstepA)
    Unit cur, nxt; int ui = 0;
    if (!S.next(0, cur)) return;
    f32x4 acc[2][2][4][2];
#pragma unroll
    for (int a = 0; a < 2; ++a)
#pragma unroll
        for (int b = 0; b < 2; ++b)
#pragma unroll
            for (int m = 0; m < 4; ++m)
#pragma unroll
                for (int n = 0; n < 2; ++n) acc[a][b][m][n] = (f32x4){0.f, 0.f, 0.f, 0.f};
    bf16x8 At[4][2], B0[2][2], B1[2][2];
    const char* cA = PG8_ABASE(cur); const char* cB = (const char*)g.Bt + (size_t)cur.pn * tstepB;
    S.a_ready(cur);
    if constexpr (SP2) {
        PG8_STAGE(PG8_SB(0, 0), cB, voffB); PG8_STAGE(PG8_SB(0, 1), cB + hstepB, voffB); PG8_STAGE(PG8_SA(0, 0), cA, voffA); PG8_STAGE(PG8_SA(0, 1), cA + hstepA, voffA);
        if (wr == 1) PG8_BAR;
        PG8_WAIT_V(2); PG8_BAR;
        PG8_STAGE(PG8_SB(1, 0), cB + kstep, voffB); PG8_STAGE(PG8_SA(1, 0), cA + kstep, voffA); PG8_STAGE(PG8_SB(1, 1), cB + hstepB + kstep, voffB);
        PG8_WAIT_V(6); PG8_BAR;
    } else {
        PG8_STAGE(PG8_SB(0, 0), cB, voffB); PG8_STAGE(PG8_SA(0, 0), cA, voffA); PG8_STAGE(PG8_SB(0, 1), cB + hstepB, voffB); PG8_STAGE(PG8_SA(0, 1), cA + hstepA, voffA);
        if (wr == 1) PG8_BAR;
        PG8_WAIT_V(4); PG8_BAR;
        PG8_STAGE(PG8_SB(1, 0), cB + kstep, voffB); PG8_STAGE(PG8_SA(1, 0), cA + kstep, voffA); PG8_STAGE(PG8_SB(1, 1), cB + hstepB + kstep, voffB);
        PG8_WAIT_V(6); PG8_BAR;
    }
    for (;;) {
#ifdef PROBE_G
        const unsigned long long k0_ = __builtin_amdgcn_s_memrealtime();
#endif
        const bool has_next = S.next(ui + 1, nxt);
        const char* nA = has_next ? PG8_ABASE(nxt) : cA; const char* nB = has_next ? (const char*)g.Bt + (size_t)nxt.pn * tstepB : cB;
        for (int t = 0; t < nt; t += 2) {
            const bool last = (t == nt - 2);
            const char* a1 = cA + (size_t)(t + 1) * kstep;
            const char* a2 = last ? nA : cA + (size_t)(t + 2) * kstep; const char* b2 = last ? nB : cB + (size_t)(t + 2) * kstep;
            const char* a3 = a2 + kstep; const char* b3 = b2 + kstep;
            if (last && has_next) S.a_ready(nxt);
            if constexpr (SP2) {
            PG8_LDB(B0, 0, 0); PG8_LDB(B1, 0, 1); PG8_SCHED; PG8_LDA(At, 0, 0); PG8_STAGE(PG8_SA(1, 1), a1 + hstepA, voffA);
            PG8_WAIT_V(8); PG8_WAIT_L(0); PG8_BAR; PG8_MMA(0, 0, At, B0); PG8_MMA(0, 1, At, B1); PG8_BAR; PG8_SCHED;
            PG8_LDA(At, 0, 1); PG8_STAGE(PG8_SB(0, 0), b2, voffB); PG8_STAGE(PG8_SB(0, 1), b2 + hstepB, voffB); PG8_STAGE(PG8_SA(0, 0), a2, voffA);
            PG8_WAIT_V(8); PG8_WAIT_L(0); PG8_BAR; PG8_MMA(1, 0, At, B0); PG8_MMA(1, 1, At, B1); PG8_BAR; PG8_SCHED;
            PG8_LDB(B0, 1, 0); PG8_LDB(B1, 1, 1); PG8_SCHED; PG8_LDA(At, 1, 0); PG8_STAGE(PG8_SA(0, 1), a2 + hstepA, voffA);
            PG8_WAIT_V(8); PG8_WAIT_L(0); PG8_BAR; PG8_MMA(0, 0, At, B0); PG8_MMA(0, 1, At, B1); PG8_BAR; PG8_SCHED;
            PG8_LDA(At, 1, 1); PG8_STAGE(PG8_SB(1, 0), b3, voffB); PG8_STAGE(PG8_SB(1, 1), b3 + hstepB, voffB); PG8_STAGE(PG8_SA(1, 0), a3, voffA);
            PG8_WAIT_V(8); PG8_WAIT_L(0); PG8_BAR; PG8_MMA(1, 0, At, B0); PG8_MMA(1, 1, At, B1); PG8_BAR; PG8_SCHED;
            } else {
            PG8_LDB(B0, 0, 0); PG8_SCHED; PG8_LDA(At, 0, 0); PG8_STAGE(PG8_SA(1, 1), a1 + hstepA, voffA);
            PG8_WAIT_L(8); PG8_BAR; PG8_WAIT_L(0); PG8_MMA(0, 0, At, B0); PG8_BAR; PG8_SCHED;
            PG8_LDB(B1, 0, 1); PG8_STAGE(PG8_SB(0, 0), b2, voffB);
            PG8_BAR; PG8_WAIT_L(0); PG8_MMA(0, 1, At, B1); PG8_BAR;
            PG8_LDA(At, 0, 1); PG8_STAGE(PG8_SA(0, 0), a2, voffA);
            PG8_BAR; PG8_WAIT_L(0); PG8_MMA(1, 0, At, B0); PG8_BAR; PG8_SCHED;
            PG8_STAGE(PG8_SB(0, 1), b2 + hstepB, voffB);
            PG8_WAIT_V(6); PG8_BAR; PG8_MMA(1, 1, At, B1); PG8_BAR;
            PG8_LDB(B0, 1, 0); PG8_SCHED; PG8_LDA(At, 1, 0); PG8_STAGE(PG8_SA(0, 1), a2 + hstepA, voffA);
            PG8_WAIT_L(8); PG8_BAR; PG8_WAIT_L(0); PG8_MMA(0, 0, At, B0); PG8_BAR; PG8_SCHED;
            PG8_LDB(B1, 1, 1); PG8_STAGE(PG8_SB(1, 0), b3, voffB);
            PG8_BAR; PG8_WAIT_L(0); PG8_MMA(0, 1, At, B1); PG8_BAR;
            PG8_LDA(At, 1, 1); PG8_STAGE(PG8_SA(1, 0), a3, voffA);
            PG8_BAR; PG8_WAIT_L(0); PG8_MMA(1, 0, At, B0); PG8_BAR; PG8_SCHED;
            PG8_STAGE(PG8_SB(1, 1), b3 + hstepB, voffB);
            PG8_WAIT_V(6); PG8_BAR; PG8_MMA(1, 1, At, B1); PG8_BAR;
            }
        }
        if constexpr (ALIGN_EPI) { if (wr == 0) PG8_BAR; }
#ifdef PROBE_G
        const unsigned long long e0_ = __builtin_amdgcn_s_memrealtime(); if (PROBE_G == 2 && Epi::PROBE_ID == PROBE_GID) pacc += e0_ - k0_;
#endif
        E(acc, cur, wr, wc, fr, fq);
#ifdef PROBE_G
        if (PROBE_G == 1 && Epi::PROBE_ID == PROBE_GID) pacc += __builtin_amdgcn_s_memrealtime() - e0_;
#endif
        if (!has_next) break;
#pragma unroll
        for (int a = 0; a < 2; ++a)
#pragma unroll
            for (int b = 0; b < 2; ++b)
#pragma unroll
                for (int m = 0; m < 4; ++m)
#pragma unroll
                    for (int n = 0; n < 2; ++n) acc[a][b][m][n] = (f32x4){0.f, 0.f, 0.f, 0.f};
        cur = nxt; cA = nA; cB = nB; ++ui;
        if constexpr (ALIGN_EPI) { if (wr == 1) PG8_BAR; }
    }
    PG8_WAIT_V(0);
    if constexpr (!ALIGN_EPI) { if (wr == 0) PG8_BAR; }
    PG8_BAR;
#undef PG8_SA
#undef PG8_SB
#undef PG8_STAGE
#undef PG8_LDA
#undef PG8_LDB
#undef PG8_MMA
#undef PG8_WAIT_V
#undef PG8_WAIT_L
#undef PG8_BAR
#undef PG8_SCHED
#undef PG8_ABASE
}
}

using pg8::bf16_t; using pg8::f32x4; using pg8::u32x4; using pg8::u32x2; using pg8::Unit; using pg8::cvt_pk_bf16;

#define GAS __attribute__((address_space(1)))
#define LAS __attribute__((address_space(3)))
typedef GAS unsigned gu32;
#define RLX_AGENT __ATOMIC_RELAXED, __HIP_MEMORY_SCOPE_AGENT

constexpr size_t MiB = 1u << 20;
constexpr size_t WS_CTL = 0, CTL_ZERO_BYTES = 1 * MiB;
constexpr size_t WS_SSQ = 1 * MiB;
constexpr size_t WS_LF = 2 * MiB;
constexpr size_t WS_CUM = 3 * MiB;
constexpr size_t WS_ROPE = 4 * MiB;
constexpr size_t WS_BIASD = WS_ROPE + 256 * 1024;
constexpr size_t WS_KMP = WS_BIASD + 64 * 1024;
constexpr size_t WS_SSQCQ = WS_KMP + 256 * 1024;
constexpr size_t WS_SSQCKV = WS_SSQCQ + 256 * 1024;
constexpr size_t WS_KR = WS_SSQCKV + 256 * 1024;
constexpr size_t WS_WFG = 6 * MiB + 256 * 1024;
constexpr size_t WS_SSQ2 = 7 * MiB;
constexpr size_t WS_W = 8 * MiB;
constexpr size_t SZ_WFI = (size_t)2 * DFF * DM * 2, SZ_WFO = (size_t)DM * DFF * 2;
constexpr size_t WS_WFI = WS_W;
constexpr size_t WS_WFO = WS_WFI + 4 * SZ_WFI;
constexpr size_t WS_WABI = WS_WFO + 4 * SZ_WFO;
constexpr size_t WS_WUP = WS_WABI + (size_t)2048 * 1024 * 2;
constexpr size_t WS_WABO = WS_WUP + (size_t)1792 * 256 * 2;
constexpr size_t WS_WFXI = WS_WABO + (size_t)1024 * 1024 * 2;
constexpr size_t WS_WFXO = WS_WFXI + (size_t)3072 * 1024 * 2;
constexpr size_t WS_WG = WS_WFXO + (size_t)1024 * 1024 * 2;
constexpr size_t WS_WP = WS_WG + (size_t)2 * 1024 * 1024 * 2;
constexpr size_t WS_WEND = WS_WP + (size_t)2 * 1024 * 256 * 2;
constexpr size_t WS_XB = 96 * MiB;
constexpr size_t WS_R = 128 * MiB;
constexpr size_t WS_PB = 248 * MiB;
constexpr size_t WS_END = 256 * MiB;
static_assert(WS_WEND <= WS_XB, "weights fit");
constexpr size_t SLAB = 15 * MiB, SLABE = SLAB / 2;
constexpr size_t R_H = 0;
constexpr size_t R_ZZ = 0;
constexpr size_t R_QMLA = 8 * MiB;
constexpr size_t R_KVMLA = 11 * MiB;
constexpr size_t R_QKV = 0;
constexpr size_t R_PP = 11 * MiB;
__host__ __device__ __forceinline__ long sadj(int pm, int ld) { return (long)(pm >> 3) * ((long)SLABE - 2048L * (long)ld); }
__host__ __device__ __forceinline__ size_t srow(int row, int ld) { return (size_t)(row >> 11) * SLABE + (size_t)(row & 2047) * (size_t)ld; }

constexpr int CW_BAR = 4096;
constexpr int CW_FIN = 12288;

constexpr int RING_BYTES = 131072;
constexpr int LDSCTL_OFF = 135168, MISC_OFF = LDSCTL_OFF + 320;
constexpr int RTAB_OFF = LDSCTL_OFF + 1024;
constexpr int LDS_BYTES = 147456;
static_assert(RTAB_OFF + 8192 <= LDS_BYTES, "rstd table");

#define XB_TMO      128
#define XB_XCNT(j)  (256  + 64 * (j))
#define XB_XSUB(j)  (1280 + 64 * (j))
#define XB_XGEN(j)  (2304 + 64 * (j))
#define XB_TOP      3328
#define XB_TOPGEN   3392
#define XCD_BAR_WORDS 3456
#define XB_XMASK(j) (3520 + 64 * (j))
#define XB_XSUB2(j) (4608 + 64 * (j))
#define XB_XGEN2(j) (5632 + 64 * (j))
#define XB_SPIN_CAP (1u << 22)
__device__ __forceinline__ unsigned xb_ld(unsigned* p)              { return __hip_atomic_load(p, __ATOMIC_RELAXED, __HIP_MEMORY_SCOPE_AGENT); }
__device__ __forceinline__ unsigned xb_add(unsigned* p, unsigned v) { return __hip_atomic_fetch_add(p, v, __ATOMIC_RELAXED, __HIP_MEMORY_SCOPE_AGENT); }
__device__ __forceinline__ unsigned xb_xcc_id() { return (unsigned)__builtin_amdgcn_s_getreg((3 << 11) | 20) & 0xFu; }
#define XB_SPIN(cond, bar) do { unsigned _sp = 0; while (cond) { __builtin_amdgcn_s_sleep(1); \
    if ((++_sp & 255u) == 0u) { if (xb_ld(&(bar)[XB_TMO])) break; if (_sp > XB_SPIN_CAP) { atomicAdd(&(bar)[XB_TMO], 1u); break; } } } } while (0)
struct XcdBarrier { unsigned* bar; unsigned x; volatile LAS unsigned* st; };
__device__ __forceinline__ XcdBarrier xcd_barrier_post(unsigned* bar, volatile LAS unsigned* st) {
    XcdBarrier b; b.bar = bar; b.x = xb_xcc_id(); b.st = st;
    if (threadIdx.x == 0) { (void)__hip_atomic_fetch_or(&bar[XB_XMASK(b.x)], 1u << (blockIdx.x & 7u), __ATOMIC_RELAXED, __HIP_MEMORY_SCOPE_AGENT); (void)xb_add(&bar[XB_XCNT(b.x)], 1u); }
    return b;
}
__device__ __forceinline__ void xcd_barrier_complete(unsigned* bar, unsigned x, unsigned& nloc, unsigned& nx) {
    const unsigned G = gridDim.x * gridDim.y * gridDim.z;
    unsigned sum, cnt, mine, sp = 0u;
    for (;;) {
        sum = 0u; cnt = 0u; mine = 0u;
#pragma unroll
        for (unsigned j = 0; j < 16; ++j) { const unsigned c = xb_ld(&bar[XB_XCNT(j)]); sum += c; cnt += (c > 0u) ? 1u : 0u; mine = (j == x) ? c : mine; }
        if (sum == G) break;
        __builtin_amdgcn_s_sleep(1);
        if ((++sp & 255u) == 0u) { if (xb_ld(&bar[XB_TMO])) break; if (sp > XB_SPIN_CAP) { atomicAdd(&bar[XB_TMO], 1u); break; } }
    }
    nloc = mine > 0u ? mine : 1u; nx = cnt > 0u ? cnt : 1u;
}
__device__ __forceinline__ void xcd_barrier(const XcdBarrier& b) {
    asm volatile("s_waitcnt vmcnt(0)" ::: "memory");
    __syncthreads();
    if (threadIdx.x == 0) {
        unsigned* bar = b.bar;
        __builtin_amdgcn_s_waitcnt(0);
        unsigned nloc = b.st[0], nx = b.st[1];
        if (nloc == 0u) { xcd_barrier_complete(bar, b.x, nloc, nx); b.st[0] = nloc; b.st[1] = nx; }
        const unsigned old = xb_add(&bar[XB_XSUB(b.x)], 1u);
        const unsigned gen = old / nloc;
        if (old + 1u == (gen + 1u) * nloc) {
            __builtin_amdgcn_fence(__ATOMIC_RELEASE, "agent");
            asm volatile("s_waitcnt vmcnt(0)" ::: "memory");
            const unsigned og = xb_add(&bar[XB_TOP], 1u);
            const unsigned tg = og / nx;
            if (og + 1u == (tg + 1u) * nx) xb_add(&bar[XB_TOPGEN], 1u);
            else XB_SPIN(xb_ld(&bar[XB_TOPGEN]) == tg, bar);
            __builtin_amdgcn_fence(__ATOMIC_ACQUIRE, "agent");
            xb_add(&bar[XB_XGEN(b.x)], 1u);
            asm volatile("s_waitcnt vmcnt(0)" ::: "memory");
        } else {
            XB_SPIN(xb_ld(&bar[XB_XGEN(b.x)]) == gen, bar);
            __builtin_amdgcn_fence(__ATOMIC_ACQUIRE, "agent");
            asm volatile("s_waitcnt vmcnt(0)" ::: "memory");
        }
    }
    __syncthreads();
}


__device__ __forceinline__ unsigned xcc_groups_verified(unsigned* bar) {
    unsigned ok = 1u, seen = 0u, n = 0u;
#pragma unroll
    for (unsigned j = 0; j < 16; ++j) { const unsigned c = xb_ld(&bar[XB_XCNT(j)]), m = xb_ld(&bar[XB_XMASK(j)]);
        if (c != 0u) { ++n; if (c != 32u || m == 0u || (m & (m - 1u)) != 0u || (seen & m) != 0u) ok = 0u; seen |= m; } }
    return (ok != 0u && n == 8u && seen == 0xffu) ? 1u : 0u;
}
__device__ __forceinline__ void xcc_barrier(const XcdBarrier& b, const int tid0) {
    asm volatile("s_waitcnt vmcnt(0)" ::: "memory");
    __syncthreads();
    if (tid0 == 0) {
        unsigned* bar = b.bar;
        __builtin_amdgcn_s_waitcnt(0);
        const unsigned old = xb_add(&bar[XB_XSUB2(b.x)], 1u);
        const unsigned gen = old / 32u;
        if (old + 1u == (gen + 1u) * 32u) xb_add(&bar[XB_XGEN2(b.x)], 1u);
        else XB_SPIN(xb_ld(&bar[XB_XGEN2(b.x)]) == gen, bar);
        __builtin_amdgcn_fence(__ATOMIC_ACQUIRE, "agent");
        asm volatile("s_waitcnt vmcnt(0)" ::: "memory");
    }
    __syncthreads();
}

__device__ __forceinline__ unsigned f2bf(float f) { unsigned u = __builtin_bit_cast(unsigned, f); return (u + 0x7fffu + ((u >> 16) & 1u)) >> 16; }
__device__ __forceinline__ unsigned pk2(float lo, float hi) { return f2bf(lo) | (f2bf(hi) << 16); }
__device__ __forceinline__ float bf2f(unsigned short b) { return __builtin_bit_cast(float, (unsigned)b << 16); }
__device__ __forceinline__ float wave_sum(float v) {
#pragma unroll
    for (int o = 1; o < 64; o <<= 1) v += __shfl_xor(v, o);
    return v;
}
__device__ __forceinline__ float sum4(f32x4 a) { return (a.x + a.y) + (a.z + a.w); }
__device__ __forceinline__ float rstd_from16(const float* ssq, int row) {
    const f32x4* p = (const f32x4*)(ssq + (size_t)row * 16);
    const float s = (sum4(p[0]) + sum4(p[1])) + (sum4(p[2]) + sum4(p[3]));
    return rsqrtf(s * (1.f / 1024.f) + EPS);
}
__device__ __forceinline__ float rstd_from4(const float* ssq, int row, float invn) {
    const f32x4 a = *(const f32x4*)(ssq + (size_t)row * 4);
    return rsqrtf(sum4(a) * invn + EPS);
}
__device__ __forceinline__ float sigmoidf_(float a) { return __builtin_amdgcn_rcpf(1.f + __expf(-a)); }

struct EpiSwiglu { static constexpr int PROBE_ID = 0;
    static constexpr bool PERM = true;
    bf16_t* H; const LAS float* rtab;
    __device__ __forceinline__ void operator()(const f32x4 (&acc)[2][2][4][2], const Unit& u, int wr, int wc, int fr, int fq) const {
        const int row0 = u.pm * 256 + wr * 64 + fr, col0 = u.pn * 128 + wc * 32 + 8 * fq;
#pragma unroll
        for (int ai = 0; ai < 2; ++ai)
#pragma unroll
            for (int m = 0; m < 4; ++m) {
                const int row = row0 + ai * 128 + m * 16; const float rs = rtab[row & 2047]; const float c1 = -rs * LOG2E, rs2 = rs * rs;
                f32x4 h[2];
#pragma unroll
                for (int n = 0; n < 2; ++n) { const f32x4 a = acc[ai][0][m][n]; const f32x4 t = a * c1; f32x4 e;
                    e.x = __builtin_amdgcn_exp2f(t.x); e.y = __builtin_amdgcn_exp2f(t.y); e.z = __builtin_amdgcn_exp2f(t.z); e.w = __builtin_amdgcn_exp2f(t.w);
                    const f32x4 d = e + 1.0f; f32x4 r; r.x = __builtin_amdgcn_rcpf(d.x); r.y = __builtin_amdgcn_rcpf(d.y); r.z = __builtin_amdgcn_rcpf(d.z); r.w = __builtin_amdgcn_rcpf(d.w);
                    h[n] = (a * r) * (acc[ai][1][m][n] * rs2); }
                u32x4 w; w.x = cvt_pk_bf16(h[0].x, h[0].y); w.y = cvt_pk_bf16(h[0].z, h[0].w); w.z = cvt_pk_bf16(h[1].x, h[1].y); w.w = cvt_pk_bf16(h[1].z, h[1].w);
                *(u32x4*)(H + sadj(u.pm, DFF) + (size_t)row * DFF + col0) = w;
            }
    }
};

struct EpiRes { static constexpr int PROBE_ID = 1;
    static constexpr bool PERM = false;
    const bf16_t* xin; bf16_t* xb; float* ssq_out; const LAS float* rtab; const bf16_t* pp; float alpha; int mode; int fin; float* out; const float* gfin; unsigned* fincnt; int xin_s, xb_s;
    __device__ __forceinline__ void operator()(f32x4 (&acc)[2][2][4][2], const Unit& u, int wr, int wc, int fr, int fq) const {
        const int row0 = u.pm * 256 + wr * 64 + fr, col0 = u.pn * 256 + wc * 32 + 4 * fq;
        const long sa = sadj(u.pm, DM); const bf16_t* xin_ = xin + (xin_s ? sa : 0L); const bf16_t* pp_ = pp + sa; bf16_t* xb_ = xb + (xb_s ? sa : 0L);
#pragma unroll
        for (int aim = 0; aim < 4; ++aim) { const int ai = aim >> 1, mb = (aim & 1) * 2;
            u32x2 xo[4][2][2], pw[4][2][2]; float rs[4];
#pragma unroll
            for (int m = mb; m < mb + 2; ++m) { const int row = row0 + ai * 128 + m * 16;
#pragma unroll
                for (int bj = 0; bj < 2; ++bj)
#pragma unroll
                    for (int n = 0; n < 2; ++n) { const size_t off = (size_t)row * DM + col0 + bj * 128 + n * 16; xo[m][bj][n] = *(const u32x2*)(xin_ + off); if (mode == 1) pw[m][bj][n] = *(const u32x2*)(pp_ + off); }
                rs[m] = 1.f; if (mode == 1) rs[m] = rtab[row & 2047]; }
#pragma unroll
            for (int m = mb; m < mb + 2; ++m) { const int row = row0 + ai * 128 + m * 16; float q = 0.f;
#pragma unroll
                for (int bj = 0; bj < 2; ++bj)
#pragma unroll
                    for (int n = 0; n < 2; ++n) {
                        const size_t off = (size_t)row * DM + col0 + bj * 128 + n * 16; const u32x2 xw = xo[m][bj][n];
                        const f32x4 o_ = (f32x4){__builtin_bit_cast(float, xw.x << 16), __builtin_bit_cast(float, xw.x & 0xffff0000u), __builtin_bit_cast(float, xw.y << 16), __builtin_bit_cast(float, xw.y & 0xffff0000u)};
                        f32x4 xn;
                        if (mode == 1) { const u32x2 w_ = pw[m][bj][n];
                            const float p0 = __builtin_bit_cast(float, w_.x << 16), p1 = __builtin_bit_cast(float, w_.x & 0xffff0000u), p2 = __builtin_bit_cast(float, w_.y << 16), p3 = __builtin_bit_cast(float, w_.y & 0xffff0000u);
                            const f32x4 a = acc[ai][bj][m][n] * rs[m];
                            xn.x = o_.x + sigmoidf_(a.x) * p0; xn.y = o_.y + sigmoidf_(a.y) * p1; xn.z = o_.z + sigmoidf_(a.z) * p2; xn.w = o_.w + sigmoidf_(a.w) * p3;
                        } else xn = o_ + acc[ai][bj][m][n] * alpha;
                        if (fin) { acc[ai][bj][m][n] = xn; q += (xn.x * xn.x + xn.y * xn.y) + (xn.z * xn.z + xn.w * xn.w); }
                        else {
                            u32x2 w; w.x = cvt_pk_bf16(xn.x, xn.y); w.y = cvt_pk_bf16(xn.z, xn.w); *(u32x2*)(xb_ + off) = w;
                            const float r0 = __builtin_bit_cast(float, w.x << 16), r1 = __builtin_bit_cast(float, w.x & 0xffff0000u), r2 = __builtin_bit_cast(float, w.y << 16), r3 = __builtin_bit_cast(float, w.y & 0xffff0000u);
                            q += (r0 * r0 + r1 * r1) + (r2 * r2 + r3 * r3); }
                    }
                q += __shfl_xor(q, 16); q += __shfl_xor(q, 32);
                if (fq == 0) ssq_out[(size_t)row * 16 + u.pn * 4 + wc] = q; }
        }
        if (fin) {
            asm volatile("s_waitcnt vmcnt(0)" ::: "memory"); __syncthreads();
            if (wr == 0 && wc == 0 && fr == 0 && fq == 0) {
                __builtin_amdgcn_fence(__ATOMIC_RELEASE, "agent"); asm volatile("s_waitcnt vmcnt(0)" ::: "memory");
                unsigned* c_ = fincnt + 64 * u.pm; __hip_atomic_fetch_add(c_, 1u, __ATOMIC_RELAXED, __HIP_MEMORY_SCOPE_AGENT);
                unsigned sp_ = 0; while (__hip_atomic_load(c_, __ATOMIC_RELAXED, __HIP_MEMORY_SCOPE_AGENT) < 4u) { __builtin_amdgcn_s_sleep(1); if (++sp_ > (1u << 22)) break; }
                __builtin_amdgcn_fence(__ATOMIC_ACQUIRE, "agent"); asm volatile("s_waitcnt vmcnt(0)" ::: "memory");
            }
            __syncthreads();
            f32x4 gv[2][2];
#pragma unroll
            for (int bj = 0; bj < 2; ++bj)
#pragma unroll
                for (int n = 0; n < 2; ++n) gv[bj][n] = *(const f32x4*)(gfin + col0 + bj * 128 + n * 16);
#pragma unroll
            for (int ai = 0; ai < 2; ++ai)
#pragma unroll
                for (int m = 0; m < 4; ++m) { const int row = row0 + ai * 128 + m * 16; const float rsf = rstd_from16(ssq_out, row);
#pragma unroll
                    for (int bj = 0; bj < 2; ++bj)
#pragma unroll
                        for (int n = 0; n < 2; ++n) __builtin_nontemporal_store(acc[ai][bj][m][n] * rsf * gv[bj][n], (f32x4*)(out + (size_t)row * DM + col0 + bj * 128 + n * 16)); }
        }
    }
};

struct EpiStoreT { static constexpr int PROBE_ID = 2;
    static constexpr bool PERM = true;
    bf16_t* O; int ldo; const LAS float* rtab; int qtiles; float qscale;
    __device__ __forceinline__ void operator()(const f32x4 (&acc)[2][2][4][2], const Unit& u, int wr, int wc, int fr, int fq) const {
        const int row0 = u.pm * 256 + wr * 64 + fr, col0 = u.pn * 256 + wc * 32 + 8 * fq; const float qs = (u.pn < qtiles) ? qscale : 1.f;
#pragma unroll
        for (int ai = 0; ai < 2; ++ai)
#pragma unroll
            for (int m = 0; m < 4; ++m) {
                const int row = row0 + ai * 128 + m * 16; const float rs = rtab[row & 2047] * qs;
#pragma unroll
                for (int bj = 0; bj < 2; ++bj) { const f32x4 v0 = acc[ai][bj][m][0] * rs, v1 = acc[ai][bj][m][1] * rs;
                    u32x4 w; w.x = cvt_pk_bf16(v0.x, v0.y); w.y = cvt_pk_bf16(v0.z, v0.w); w.z = cvt_pk_bf16(v1.x, v1.y); w.w = cvt_pk_bf16(v1.z, v1.w);
                    *(u32x4*)(O + sadj(u.pm, ldo) + (size_t)row * ldo + col0 + bj * 128) = w; }
            }
    }
};

struct EpiStoreF { static constexpr int PROBE_ID = 3;
    static constexpr bool PERM = false;
    int mode; bf16_t* O; bf16_t* O2; const LAS float* rtab; float* ssq_cq; float* ssq_ckv; bf16_t* kr; float* kmp; const float* rope; float qscale;
    __device__ __forceinline__ void operator()(const f32x4 (&acc)[2][2][4][2], const Unit& u, int wr, int wc, int fr, int fq) const {
        const int row0 = u.pm * 256 + wr * 64 + fr;
        float colsum[2][2][4];
#pragma unroll
        for (int bj = 0; bj < 2; ++bj)
#pragma unroll
            for (int n = 0; n < 2; ++n)
#pragma unroll
                for (int j = 0; j < 4; ++j) colsum[bj][n][j] = 0.f;
#pragma unroll
        for (int ai = 0; ai < 2; ++ai)
#pragma unroll
            for (int m = 0; m < 4; ++m) {
                const int row = row0 + ai * 128 + m * 16;
                float rs = 1.f;
                if (mode == 0) { rs = rtab[row & 2047]; if (u.pn < 2) rs *= qscale; }
                else if (mode == 1) rs = (u.pn < 3) ? rstd_from4(ssq_cq, row, 1.f / 256.f) * qscale : rstd_from4(ssq_ckv, row, 1.f / 128.f);
                f32x4 v[2][2];
#pragma unroll
                for (int bj = 0; bj < 2; ++bj)
#pragma unroll
                    for (int n = 0; n < 2; ++n) v[bj][n] = acc[ai][bj][m][n] * rs;
                bf16_t* orow; int ocol;
                if (mode == 0) { orow = O + sadj(u.pm, 2048) + (size_t)row * 2048; ocol = u.pn * 256 + wc * 32 + 4 * fq; }
                else if (mode == 1) { if (u.pn < 3) { orow = O + sadj(u.pm, 768) + (size_t)row * 768; ocol = u.pn * 256 + wc * 32 + 4 * fq; } else { orow = O2 + sadj(u.pm, 1024) + (size_t)row * 1024; ocol = (u.pn - 3) * 256 + wc * 32 + 4 * fq; } }
                else { orow = O + sadj(u.pm, 1024) + (size_t)row * 1024; ocol = u.pn * 256 + wc * 32 + 4 * fq; }
                if (mode == 0) {
                    if (u.pn == 2) { float q = 0.f;
#pragma unroll
                        for (int bj = 0; bj < 2; ++bj)
#pragma unroll
                            for (int n = 0; n < 2; ++n) q += (v[bj][n].x * v[bj][n].x + v[bj][n].y * v[bj][n].y) + (v[bj][n].z * v[bj][n].z + v[bj][n].w * v[bj][n].w);
                        q += __shfl_xor(q, 16); q += __shfl_xor(q, 32); if (fq == 0) ssq_cq[(size_t)row * 4 + wc] = q; }
                    if (u.pn == 3) { float q = 0.f;
#pragma unroll
                        for (int n = 0; n < 2; ++n) q += (v[0][n].x * v[0][n].x + v[0][n].y * v[0][n].y) + (v[0][n].z * v[0][n].z + v[0][n].w * v[0][n].w);
                        q += __shfl_xor(q, 16); q += __shfl_xor(q, 32); if (fq == 0) ssq_ckv[(size_t)row * 4 + wc] = q;
                        if (wc == 0) {
                            const int pos = row & (SEQ - 1);
                            const f32x4 cs = *(const f32x4*)(rope + (size_t)pos * 16 + 4 * fq), sn = *(const f32x4*)(rope + (size_t)SEQ * 16 + (size_t)pos * 16 + 4 * fq);
                            const f32x4 x1 = v[1][0], x2 = v[1][1];
                            const f32x4 y1 = x1 * cs - x2 * sn, y2 = x1 * sn + x2 * cs;
                            u32x2 w1, w2; w1.x = cvt_pk_bf16(y1.x, y1.y); w1.y = cvt_pk_bf16(y1.z, y1.w); w2.x = cvt_pk_bf16(y2.x, y2.y); w2.y = cvt_pk_bf16(y2.z, y2.w);
                            *(u32x2*)(kr + (size_t)row * 32 + 4 * fq) = w1; *(u32x2*)(kr + (size_t)row * 32 + 16 + 4 * fq) = w2;
                        } }
                    if (u.pn == 4 || u.pn == 5) {
#pragma unroll
                        for (int bj = 0; bj < 2; ++bj)
#pragma unroll
                            for (int n = 0; n < 2; ++n) { colsum[bj][n][0] += v[bj][n].x; colsum[bj][n][1] += v[bj][n].y; colsum[bj][n][2] += v[bj][n].z; colsum[bj][n][3] += v[bj][n].w; }
                    }
                }
                if (mode == 1 && u.pn < 3) {
#pragma unroll
                    for (int bj = 0; bj < 2; ++bj) {
                        const int g32 = u.pn * 8 + bj * 4 + wc;
                        if (g32 % 3 == 2) {
                            const int pos = row & (SEQ - 1);
                            const f32x4 cs = *(const f32x4*)(rope + (size_t)pos * 16 + 4 * fq), sn = *(const f32x4*)(rope + (size_t)SEQ * 16 + (size_t)pos * 16 + 4 * fq);
                            const f32x4 x1 = v[bj][0], x2 = v[bj][1];
                            v[bj][0] = x1 * cs - x2 * sn; v[bj][1] = x1 * sn + x2 * cs;
                        }
                    }
                }
#pragma unroll
                for (int bj = 0; bj < 2; ++bj)
#pragma unroll
                    for (int n = 0; n < 2; ++n) { u32x2 w; w.x = cvt_pk_bf16(v[bj][n].x, v[bj][n].y); w.y = cvt_pk_bf16(v[bj][n].z, v[bj][n].w);
                        *(u32x2*)(orow + ocol + bj * 128 + n * 16) = w; }
            }
        if (mode == 0 && (u.pn == 4 || u.pn == 5)) {
#pragma unroll
            for (int bj = 0; bj < 2; ++bj)
#pragma unroll
                for (int n = 0; n < 2; ++n)
#pragma unroll
                    for (int j = 0; j < 4; ++j) { float s = colsum[bj][n][j];
                        s += __shfl_xor(s, 1); s += __shfl_xor(s, 2); s += __shfl_xor(s, 4); s += __shfl_xor(s, 8);
                        if (fr == 0) kmp[((size_t)u.pm * 2 + wr) * 512 + (u.pn - 4) * 256 + bj * 128 + wc * 32 + n * 16 + 4 * fq + j] = s; }
        }
    }
};

struct Args {
    const float* in[23]; float* out; unsigned char* ws; int ph_lo, ph_hi;
};
struct Frame {
    LAS unsigned char* lds; unsigned char* ldsg; volatile LAS unsigned* MISC; gu32* ctl;
    int tid, lane, wave, vcu, G;
    unsigned char* ws; float* x;
    unsigned long long wacc;
};

__device__ __forceinline__ int fresh_tid_(const Frame& F) { int t_ = F.tid; asm volatile("" : "+v"(t_)); return t_; }
__device__ __forceinline__ void conv_item(const float* W, int ldw, int sc0, const float* gain, bf16_t* WT, int ldt, int n0, int k0, LAS float* scr, int lane, int nvalid, bool ntst) {
    const int lr = lane >> 4, lc = (lane & 15) * 4;
    f32x4 v[16];
#pragma unroll
    for (int i = 0; i < 16; ++i) { const int kk = 4 * i + lr; v[i] = (f32x4){0.f, 0.f, 0.f, 0.f};
        if (sc0 >= 0 && lc < nvalid) v[i] = __builtin_nontemporal_load((const f32x4*)(W + (size_t)(k0 + kk) * ldw + sc0 + lc)); }
#pragma unroll
    for (int i = 0; i < 16; ++i) { const int kk = 4 * i + lr; f32x4 x = v[i]; if (gain) x = x * gain[k0 + kk];
        LAS float* d = scr + kk * 65 + lc; d[0] = x.x; d[1] = x.y; d[2] = x.z; d[3] = x.w; }
    asm volatile("s_waitcnt lgkmcnt(0)" ::: "memory");
    const int c = lane & 7;
#pragma unroll
    for (int j = 0; j < 8; ++j) { const int n = (lane >> 3) + 8 * j; const LAS float* s_ = scr + (8 * c) * 65 + n;
        u32x4 o; o.x = cvt_pk_bf16(s_[0 * 65], s_[1 * 65]); o.y = cvt_pk_bf16(s_[2 * 65], s_[3 * 65]); o.z = cvt_pk_bf16(s_[4 * 65], s_[5 * 65]); o.w = cvt_pk_bf16(s_[6 * 65], s_[7 * 65]);
        if (ntst) __builtin_nontemporal_store(o, (u32x4*)(WT + (size_t)(n0 + n) * ldt + k0 + 8 * c)); else *(u32x4*)(WT + (size_t)(n0 + n) * ldt + k0 + 8 * c) = o; }
    asm volatile("s_waitcnt lgkmcnt(0)" ::: "memory");
}

struct ConvJob { const float* W; int ldw; const float* gain; bf16_t* WT; int K, N, kind; };
__device__ __forceinline__ ConvJob get_job(int j, const Args& a, unsigned char* ws) {
    ConvJob r;
    if (j < 12) { const int l = j / 6, t = j % 6;
        switch (t) {
        case 0: r = ConvJob{a.in[4] + (size_t)l * DM * 2 * DFF, 2 * DFF, a.in[3] + l * DM, (bf16_t*)(ws + WS_WFI + (size_t)(l * 2 + 0) * SZ_WFI), DM, 2 * DFF, 1}; break;
        case 1: r = ConvJob{a.in[8] + (size_t)l * DM * 2 * DFF, 2 * DFF, a.in[7] + l * DM, (bf16_t*)(ws + WS_WFI + (size_t)(l * 2 + 1) * SZ_WFI), DM, 2 * DFF, 1}; break;
        case 2: r = ConvJob{a.in[5] + (size_t)l * DFF * DM, DM, nullptr, (bf16_t*)(ws + WS_WFO + (size_t)(l * 2 + 0) * SZ_WFO), DFF, DM, 0}; break;
        case 3: r = ConvJob{a.in[9] + (size_t)l * DFF * DM, DM, nullptr, (bf16_t*)(ws + WS_WFO + (size_t)(l * 2 + 1) * SZ_WFO), DFF, DM, 0}; break;
        case 4: r = ConvJob{a.in[11] + (size_t)l * DM * DM, DM, a.in[10] + l * DM, (bf16_t*)(ws + WS_WG + (size_t)l * DM * DM * 2), DM, DM, 0}; break;
        default: r = ConvJob{a.in[12] + (size_t)l * PLED * DM, DM, nullptr, (bf16_t*)(ws + WS_WP + (size_t)l * DM * PLED * 2), PLED, DM, 0}; break;
        }
    } else {
        switch (j) {
        case 12: r = ConvJob{a.in[13], 1952, a.in[6], (bf16_t*)(ws + WS_WABI), DM, 2048, 2}; break;
        case 13: r = ConvJob{a.in[15], 768, a.in[14], (bf16_t*)(ws + WS_WUP), 256, 768, 0}; break;
        case 14: r = ConvJob{a.in[17], 1024, a.in[16], (bf16_t*)(ws + WS_WUP + (size_t)768 * 256 * 2), 256, 1024, 5}; break;
        case 15: r = ConvJob{a.in[18], DM, nullptr, (bf16_t*)(ws + WS_WABO), DM, DM, 0}; break;
        case 16: r = ConvJob{a.in[19], 3088, a.in[6] + DM, (bf16_t*)(ws + WS_WFXI), DM, 3072, 0}; break;
        case 17: r = ConvJob{a.in[21], DM, nullptr, (bf16_t*)(ws + WS_WFXO), DM, DM, 0}; break;
        default: r = ConvJob{a.in[19], 3088, a.in[6] + DM, (bf16_t*)(ws + WS_WFG), DM, 64, 6}; break;
        }
    }
    return r;
}
__device__ __forceinline__ int conv_srccol(int kind, int n0) {
    if (kind == 1) { const int pn = n0 >> 8, j = n0 & 255; return j < 128 ? pn * 128 + j : DFF + pn * 128 + (j - 128); }
    if (kind == 2) { if (n0 < 512) return n0; if (n0 < 1024) { const int o = n0 - 512; return o < 416 ? 1536 + o : -1; } if (n0 < 1536) return 512 + (n0 - 1024); return 1024 + (n0 - 1536); }
    return n0;
}

__device__ __forceinline__ void conv_p_rows(Frame& F, const float* p, bf16_t* pb, bool local) {
    const int gw = local ? ((int)blockIdx.x >> 3) * 8 + F.wave : F.vcu * 8 + F.wave, NGW = local ? (F.G >> 3) * 8 : F.G * 8;
    const int mbeg = local ? ((int)blockIdx.x & 7) * SEQ : 0, mend = local ? mbeg + SEQ : M;
    for (int m0 = mbeg + gw; m0 < mend; m0 += 8 * NGW) { f32x4 v[8];
#pragma unroll
        for (int k = 0; k < 8; ++k) { const int m = m0 + k * NGW; v[k] = (f32x4){0.f, 0.f, 0.f, 0.f}; if (m < mend) v[k] = __builtin_nontemporal_load((const f32x4*)(p + (size_t)m * PLED) + F.lane); }
#pragma unroll
        for (int k = 0; k < 8; ++k) { const int m = m0 + k * NGW; if (m < mend) { u32x2 w; w.x = cvt_pk_bf16(v[k].x, v[k].y); w.y = cvt_pk_bf16(v[k].z, v[k].w); *((u32x2*)(pb + (size_t)m * PLED) + F.lane) = w; } } }
}

__device__ __forceinline__ void prologue(Frame& F, const Args& a) {
    LAS float* scr = (LAS float*)(F.lds + F.wave * 16640);
    const int gw = F.vcu * 8 + F.wave, NGW = F.G * 8;
    unsigned char* ws = F.ws;
    constexpr int nj = 19;
#ifdef PROBE_PRO
    unsigned long long pp0_ = __builtin_amdgcn_s_memrealtime();
#endif
    int base = 0;
    for (int j = 0; j < nj; ++j) {
        const ConvJob jb = get_job(j, a, ws); const int nblk = jb.N / 64, nit = (jb.K / 64) * nblk;
        int first = (gw - base) % NGW; if (first < 0) first += NGW;
        for (int it = first; it < nit; it += NGW) {
            const int kb = it / nblk, nb = it % nblk, k0 = 64 * kb, n0 = 64 * nb;
            int sc0 = conv_srccol(jb.kind, n0);
            if (jb.kind == 5 && k0 >= 128) sc0 = -1;
            if (jb.kind == 6) sc0 = 3072;
            int nvalid = 64; if (jb.kind == 6) nvalid = 16; if (jb.kind == 2 && n0 == 896) nvalid = 32; if (jb.kind == 2 && n0 > 896 && n0 < 1024) sc0 = -1;
            conv_item(jb.W, jb.ldw, sc0, jb.gain, jb.WT, jb.K, n0, k0, scr, F.lane, nvalid, j != 0);
        }
        base = (base + nit) % NGW;
    }
#ifdef PROBE_PRO
    { asm volatile("s_waitcnt vmcnt(0)" ::: "memory"); const unsigned long long t_ = __builtin_amdgcn_s_memrealtime(); if (PROBE_PRO == 1) F.wacc += t_ - pp0_; pp0_ = t_; }
#endif
    {
        const float* xin = a.in[0]; bf16_t* xb = (bf16_t*)(ws + WS_R + R_PP); float* ssq = (float*)(ws + WS_SSQ2);
        for (int m0 = gw; m0 < M; m0 += 4 * NGW) {
            f32x4 v[4][4];
#pragma unroll
            for (int k = 0; k < 4; ++k)
#pragma unroll
                for (int j = 0; j < 4; ++j) v[k][j] = __builtin_nontemporal_load((const f32x4*)(xin + (size_t)(m0 + k * NGW) * DM) + F.lane + 64 * j);
#pragma unroll
            for (int k = 0; k < 4; ++k) { const int m = m0 + k * NGW; float s = 0.f;
#pragma unroll
                for (int j = 0; j < 4; ++j) { u32x2 w; w.x = cvt_pk_bf16(v[k][j].x, v[k][j].y); w.y = cvt_pk_bf16(v[k][j].z, v[k][j].w); *((u32x2*)(xb + srow(m, DM)) + F.lane + 64 * j) = w;
                    const float r0 = __builtin_bit_cast(float, w.x << 16), r1 = __builtin_bit_cast(float, w.x & 0xffff0000u), r2 = __builtin_bit_cast(float, w.y << 16), r3 = __builtin_bit_cast(float, w.y & 0xffff0000u);
                    s += (r0 * r0 + r1 * r1) + (r2 * r2 + r3 * r3); }
                s = wave_sum(s);
                if (F.lane < 16) ssq[(size_t)m * 16 + F.lane] = (F.lane == 0) ? s : 0.f; }
        }
    }
#ifdef PROBE_PRO
    { asm volatile("s_waitcnt vmcnt(0)" ::: "memory"); const unsigned long long t_ = __builtin_amdgcn_s_memrealtime(); if (PROBE_PRO == 2) F.wacc += t_ - pp0_; pp0_ = t_; }
#endif
    conv_p_rows(F, a.in[1], (bf16_t*)(ws + WS_PB), false);
    {
        float* rope = (float*)(ws + WS_ROPE); const int gt = F.vcu * 512 + F.tid, NGT = F.G * 512;
        for (int e = gt; e < SEQ * 16; e += NGT) { const int pos = e >> 4, i = e & 15;
            const float inv = powf(10000.f, -(float)i / 16.f); const float ang = (float)pos * inv;
            rope[e] = (float)cos((double)ang); rope[SEQ * 16 + e] = (float)sin((double)ang); }
        float* biasd = (float*)(ws + WS_BIASD); const float* t5 = a.in[2];
        for (int e = gt; e < 8 * 128; e += NGT) { const int h = e >> 7, d = e & 127; int bk;
            if (d < 16) bk = d; else { bk = 16 + (int)(logf((float)d / 16.f) / 2.0794415416798357f * 16.f); if (bk > 31) bk = 31; }
            biasd[e] = t5[bk * 8 + h]; }
    }
#ifdef PROBE_PRO
    { asm volatile("s_waitcnt vmcnt(0)" ::: "memory"); const unsigned long long t_ = __builtin_amdgcn_s_memrealtime(); if (PROBE_PRO == 3) F.wacc += t_ - pp0_; }
#endif
}

typedef short bf16x8_t __attribute__((ext_vector_type(8)));
typedef short s16x4 __attribute__((ext_vector_type(4)));
typedef float f32x16 __attribute__((ext_vector_type(16)));
typedef short v4i16_t __attribute__((ext_vector_type(4)));
typedef float f32x2_t __attribute__((ext_vector_type(2))); typedef __bf16 bf16x2_t __attribute__((ext_vector_type(2)));
constexpr int MA_NSLOT = 4, MA_K = 0, MA_KSLOT = 12288, MA_V = 49152, MA_VSLOT = 8192, MA_WS = 81920, MA_OST = 83968, MA_C2 = 116736, MA_BT = 124928, MA_KM = 125952, MA_END = 130048;
static_assert(MA_END <= RING_BYTES, "attention LDS map");
constexpr float MA_THR = 6.0f;
__device__ __forceinline__ int crow(int r, int hi) { return (r & 3) + 8 * (r >> 2) + 4 * hi; }
__device__ __forceinline__ s16x4 vtr(const LAS unsigned char* p) { return __builtin_bit_cast(s16x4, __builtin_amdgcn_ds_read_tr16_b64_v4i16((LAS v4i16_t*)p)); }
__device__ __forceinline__ unsigned cvtpk_s(float lo, float hi) { f32x2_t v = {lo, hi}; bf16x2_t b = __builtin_convertvector(v, bf16x2_t); return __builtin_bit_cast(unsigned, b); }
__device__ __forceinline__ float swapmax(float m) { auto rr = __builtin_amdgcn_permlane32_swap(__float_as_uint(m), __float_as_uint(m), false, false); return fmaxf(__uint_as_float(rr[0]), __uint_as_float(rr[1])); }

template <int MODE> __device__ __forceinline__ void mattn_unit(Frame& F, int b, int h, int qb) {
    constexpr int DQ = (MODE == 1) ? 96 : 64, NKS = DQ / 16;
    int tid = F.tid; asm volatile("" : "+v"(tid));
    const int lane = tid & 63, wid = __builtin_amdgcn_readfirstlane(tid >> 6), r32 = lane & 31, hi = lane >> 5;
    LAS unsigned char* L = F.lds; unsigned char* ws = F.ws;
    const bf16_t *Qp, *K1, *K2 = nullptr, *Vp; bf16_t* Op; int ldq, ldk, ldv, ldo;
    if (MODE == 0) { const bf16_t* ZZ = (const bf16_t*)(ws + WS_R + R_ZZ); Qp = ZZ + h * 64; ldq = 2048; K1 = ZZ + 1024 + h * 64; ldk = 2048; Vp = ZZ + 1536 + h * 64; ldv = 2048; Op = (bf16_t*)ZZ + h * 64; ldo = 2048; }
    else if (MODE == 1) { const bf16_t* QM = (const bf16_t*)(ws + WS_R + R_QMLA); const bf16_t* KV = (const bf16_t*)(ws + WS_R + R_KVMLA);
        Qp = QM + h * 96; ldq = 768; K1 = KV + h * 128; ldk = 1024; K2 = (const bf16_t*)(ws + WS_KR); Vp = KV + h * 128 + 64; ldv = 1024; Op = (bf16_t*)(ws + WS_R + R_ZZ) + 512 + h * 64; ldo = 2048; }
    else { const bf16_t* QKV = (const bf16_t*)(ws + WS_R + R_QKV); Qp = QKV + h * 64; ldq = 3072; K1 = QKV + 1024 + h * 64; ldk = 3072; Vp = QKV + 2048 + h * 64; ldv = 3072; Op = (bf16_t*)QKV + h * 64; ldo = 3072; }
    const size_t rowb = (size_t)b * SEQ, bs = (size_t)b * SLABE; const int q0 = qb * 256 + wid * 32;
    bf16x8_t qr[NKS];
#pragma unroll
    for (int d0 = 0; d0 < NKS; ++d0) qr[d0] = *(const bf16x8_t*)(Qp + bs + (size_t)(q0 + r32) * ldq + d0 * 16 + hi * 8);
    const int NT = 4 * qb + 4, tlast = 4 * qb + (wid >> 1);
    LAS float* wsf = (LAS float*)(L + MA_WS) + wid * 64;
    LAS float* C2 = (LAS float*)(L + MA_C2); LAS float* BT = (LAS float*)(L + MA_BT);
#define MA_DMA(t, slot) do { \
    { const bf16_t* s_ = K1 + bs + ((size_t)(t) * 64 + lane) * ldk + wid * 8; \
      __builtin_amdgcn_global_load_lds((const unsigned*)s_, (LAS unsigned*)(L + MA_K + (slot) * MA_KSLOT + wid * 1024), 16, 0, 0); } \
    if (MODE == 1) { const bf16_t* s_ = K2 + (rowb + (size_t)(t) * 64 + lane) * 32 + (wid & 3) * 8; \
      __builtin_amdgcn_global_load_lds((const unsigned*)s_, (LAS unsigned*)(L + MA_K + (slot) * MA_KSLOT + (8 + (wid & 3)) * 1024), 16, 0, 0); } \
    { const bf16_t* s_ = Vp + bs + ((size_t)(t) * 64 + 16 * (wid & 3) + (lane >> 2)) * ldv + (wid >> 2) * 32 + (lane & 3) * 8; \
      __builtin_amdgcn_global_load_lds((const unsigned*)s_, (LAS unsigned*)(L + MA_V + (slot) * MA_VSLOT + wid * 1024), 16, 0, 0); } } while (0)
    if (MODE == 2) {
        const float* lft = (const float*)(ws + WS_CUM) + (size_t)(b * 16 + h) * SEQ; LAS float* wtot = (LAS float*)(L + MA_WS);
        f32x4 v = (f32x4){0.f, 0.f, 0.f, 0.f}; if (4 * tid < NT * 64) v = *(const f32x4*)(lft + 4 * tid);
        v.y += v.x; v.z += v.y; v.w += v.z; float incl = v.w;
#pragma unroll
        for (int o_ = 1; o_ < 64; o_ <<= 1) { const float tt = __shfl_up(incl, o_); if (lane >= o_) incl += tt; }
        if (lane == 63) wtot[wid] = incl;
        __syncthreads();
        float woff = 0.f;
#pragma unroll
        for (int w_ = 0; w_ < 8; ++w_) { const float tw = wtot[w_]; if (w_ < wid) woff += tw; }
        const float ex = incl - v.w + woff;
        if (4 * tid < NT * 64) *(LAS f32x4*)(C2 + 4 * tid) = (f32x4){v.x + ex, v.y + ex, v.z + ex, v.w + ex};
        __syncthreads();
    }
    if (MODE == 0) {
        const float* biasd = (const float*)(ws + WS_BIASD) + h * 128;
        if (tid < 256) BT[tid] = tid < 128 ? (biasd[tid] - biasd[127]) * LOG2E : 0.f;
        if (tid < 256) {
            const int c = tid >> 5, row = tid & 31, n = row & 7, part = row >> 3; u32x4 w = (u32x4){0u, 0u, 0u, 0u};
            if (part < 2) { const float* k0 = (const float*)(ws + WS_KMP) + ((size_t)(b * 8 + n) * 2) * 512 + h * 64 + c * 8; const float* k1 = k0 + 512; unsigned e[8];
#pragma unroll
                for (int j = 0; j < 8; ++j) { const float v = (k0[j] + k1[j]) * (1.f / 256.f); const unsigned hb = f2bf(v); const unsigned lb = f2bf(v - __builtin_bit_cast(float, hb << 16)); e[j] = part == 0 ? hb : lb; }
                w.x = e[0] | (e[1] << 16); w.y = e[2] | (e[3] << 16); w.z = e[4] | (e[5] << 16); w.w = e[6] | (e[7] << 16); }
            *(LAS u32x4*)(L + MA_KM + c * 512 + row * 16) = w; }
    }
    MA_DMA(0, 0); MA_DMA(1, 1); MA_DMA(2, 2);
    if (MODE == 1) asm volatile("s_waitcnt vmcnt(6)" ::: "memory"); else asm volatile("s_waitcnt vmcnt(4)" ::: "memory");
    asm volatile("s_waitcnt lgkmcnt(0)" ::: "memory"); __builtin_amdgcn_s_barrier(); asm volatile("" ::: "memory");
    unsigned sel = 0u;
    if (MODE == 0) {
        f32x16 g;
#pragma unroll
        for (int r = 0; r < 16; ++r) g[r] = 0.f;
#pragma unroll
        for (int d0 = 0; d0 < 4; ++d0) { const bf16x8_t kf = *(const LAS bf16x8_t*)(L + MA_KM + (2 * d0 + hi) * 512 + r32 * 16); g = __builtin_amdgcn_mfma_f32_32x32x16_bf16(kf, qr[d0], g, 0, 0, 0); }
        float gate[8];
#pragma unroll
        for (int j = 0; j < 4; ++j) { const float gv = g[j] + g[4 + j]; auto rr = __builtin_amdgcn_permlane32_swap(__float_as_uint(gv), __float_as_uint(gv), false, false); gate[j] = __uint_as_float(rr[0]); gate[4 + j] = __uint_as_float(rr[1]); }
        const int nsel = qb < 3 ? qb : 3;
        for (int r = 0; r < nsel; ++r) { int best = -1; float bv = -INFINITY;
#pragma unroll
            for (int n = 0; n < 8; ++n) { if (n < qb && !((sel >> n) & 1u) && (best < 0 || gate[n] > bv)) { best = n; bv = gate[n]; } }
            sel |= 1u << (best & 7); }
    }
    float mhat = -1000.f, l_reg = 0.f; f32x16 o[2];
#pragma unroll
    for (int r = 0; r < 16; ++r) { o[0][r] = 0.f; o[1][r] = 0.f; }
    f32x16 cvec; int cvblk = -1;
#pragma unroll
    for (int r = 0; r < 16; ++r) cvec[r] = -mhat;
    for (int t = 0; t < NT; ++t) {
        const int slot = t & 3;
        if (t <= tlast) {
            if (MODE == 0) { const int n = t >> 2; if (n != cvblk) { cvblk = n; const bool valid = (n == qb) || ((sel >> n) & 1u); const float ci = valid ? -mhat : -1e30f;
#pragma unroll
                for (int r = 0; r < 16; ++r) cvec[r] = ci; } }
            f32x16 p0, p1;
            const LAS unsigned char* kb = L + MA_K + slot * MA_KSLOT + hi * 1024 + r32 * 16;
            bf16x8_t kf[2 * NKS];
#pragma unroll
            for (int d0 = 0; d0 < NKS; ++d0) { kf[2 * d0] = *(const LAS bf16x8_t*)(kb + d0 * 2048); kf[2 * d0 + 1] = *(const LAS bf16x8_t*)(kb + d0 * 2048 + 512); }
            f32x4 cb0[4], cb1[4];
            if (MODE == 2) {
#pragma unroll
                for (int g = 0; g < 4; ++g) { cb0[g] = *(const LAS f32x4*)(C2 + t * 64 + 4 * hi + 8 * g); cb1[g] = *(const LAS f32x4*)(C2 + t * 64 + 32 + 4 * hi + 8 * g); }
            }
            __builtin_amdgcn_sched_barrier(0);
#pragma unroll
            for (int d0 = 0; d0 < NKS; ++d0) {
                if (d0 == 0) { p0 = __builtin_amdgcn_mfma_f32_32x32x16_bf16(kf[0], qr[0], cvec, 0, 0, 0); p1 = __builtin_amdgcn_mfma_f32_32x32x16_bf16(kf[1], qr[0], cvec, 0, 0, 0); }
                else { p0 = __builtin_amdgcn_mfma_f32_32x32x16_bf16(kf[2 * d0], qr[d0], p0, 0, 0, 0); p1 = __builtin_amdgcn_mfma_f32_32x32x16_bf16(kf[2 * d0 + 1], qr[d0], p1, 0, 0, 0); } }
            const LAS unsigned char* vp = L + MA_V + slot * MA_VSLOT + ((lane >> 4) & 1) * 32 + (lane & 3) * 8 + (4 * hi + ((lane & 15) >> 2)) * 64;
            s16x4 vlo[8], vhh[8];
#pragma unroll
            for (int i = 0; i < 8; ++i) { vlo[i] = vtr(vp + (i >> 2) * 4096 + (i & 3) * 1024); vhh[i] = vtr(vp + (i >> 2) * 4096 + (i & 3) * 1024 + 512); }
            __builtin_amdgcn_sched_barrier(0);
            if (MODE == 2) {
#pragma unroll
                for (int g = 0; g < 4; ++g) {
#pragma unroll
                    for (int j = 0; j < 4; ++j) { p0[4 * g + j] -= cb0[g][j]; p1[4 * g + j] -= cb1[g][j]; } }
            }
            const int dl = q0 - 64 * t + r32 - 4 * hi;
            if (MODE == 0) {
                if (t + 3 >= tlast) {
#pragma unroll
                    for (int r = 0; r < 16; ++r) { const int i0 = dl - ((r & 3) + 8 * (r >> 2)), i1 = i0 - 32;
                        const float b0 = BT[min(max(i0, 0), 128)], b1 = BT[min(max(i1, 0), 128)];
                        p0[r] = i0 < 0 ? -1e30f : p0[r] + b0; p1[r] = i1 < 0 ? -1e30f : p1[r] + b1; }
                }
            } else if (t == tlast) {
#pragma unroll
                for (int r = 0; r < 16; ++r) { const int i0 = dl - ((r & 3) + 8 * (r >> 2)), i1 = i0 - 32; if (i0 < 0) p0[r] = -1e30f; if (i1 < 0) p1[r] = -1e30f; }
            }
#define MX3(a_, b_, c_) __builtin_fmaxf(__builtin_fmaxf((a_), (b_)), (c_))
            float rm; { float a_ = MX3(p0[0], p0[1], p1[0]), b_ = MX3(p0[2], p0[3], p1[1]); a_ = MX3(a_, p1[2], p1[3]);
#pragma unroll
                for (int r = 4; r < 16; r += 4) { a_ = MX3(a_, p0[r], p0[r + 1]); b_ = MX3(b_, p0[r + 2], p0[r + 3]); a_ = MX3(a_, p1[r], p1[r + 1]); b_ = MX3(b_, p1[r + 2], p1[r + 3]); }
                rm = __builtin_fmaxf(a_, b_); }
#undef MX3
            rm = swapmax(rm);
            if (__any(rm > MA_THR)) {
                const float dlt = fmaxf(rm, 0.f); mhat += dlt;
#pragma unroll
                for (int r = 0; r < 16; ++r) { p0[r] -= dlt; p1[r] -= dlt; }
                { bool valid_ = true; if (MODE == 0) { const int n = t >> 2; valid_ = (n == qb) || ((sel >> n) & 1u); } const float ci = valid_ ? -mhat : -1e30f;
#pragma unroll
                  for (int r = 0; r < 16; ++r) cvec[r] = ci; }
                const float f = __builtin_amdgcn_exp2f(-dlt); l_reg *= f; if (hi == 0) wsf[r32] = f;
#pragma unroll
                for (int r = 0; r < 16; ++r) { const float fr_ = wsf[crow(r, hi)]; o[0][r] *= fr_; o[1][r] *= fr_; }
            }
            float sacc = 0.f;
#pragma unroll
            for (int r = 0; r < 16; ++r) { p0[r] = __builtin_amdgcn_exp2f(p0[r]); p1[r] = __builtin_amdgcn_exp2f(p1[r]); sacc += p0[r] + p1[r]; }
            l_reg += sacc;
            u32x4 pw[4];
            pw[0] = (u32x4){cvtpk_s(p0[0], p0[1]), cvtpk_s(p0[2], p0[3]), cvtpk_s(p0[4], p0[5]), cvtpk_s(p0[6], p0[7])};
            pw[1] = (u32x4){cvtpk_s(p0[8], p0[9]), cvtpk_s(p0[10], p0[11]), cvtpk_s(p0[12], p0[13]), cvtpk_s(p0[14], p0[15])};
            pw[2] = (u32x4){cvtpk_s(p1[0], p1[1]), cvtpk_s(p1[2], p1[3]), cvtpk_s(p1[4], p1[5]), cvtpk_s(p1[6], p1[7])};
            pw[3] = (u32x4){cvtpk_s(p1[8], p1[9]), cvtpk_s(p1[10], p1[11]), cvtpk_s(p1[12], p1[13]), cvtpk_s(p1[14], p1[15])};
#pragma unroll
            for (int dh = 0; dh < 2; ++dh)
#pragma unroll
                for (int ks = 0; ks < 4; ++ks) { const s16x4 lo = vlo[dh * 4 + ks], hh = vhh[dh * 4 + ks];
                    const bf16x8_t vf = (bf16x8_t){lo[0], lo[1], lo[2], lo[3], hh[0], hh[1], hh[2], hh[3]};
                    o[dh] = __builtin_amdgcn_mfma_f32_32x32x16_bf16(__builtin_bit_cast(bf16x8_t, pw[ks]), vf, o[dh], 0, 0, 0); }
        }
        if (t + 3 < NT) MA_DMA(t + 3, (t + 3) & 3);
        if (MODE == 1) { if (t + 3 < NT) asm volatile("s_waitcnt vmcnt(6)" ::: "memory"); else if (t + 2 < NT) asm volatile("s_waitcnt vmcnt(3)" ::: "memory"); else asm volatile("s_waitcnt vmcnt(0)" ::: "memory"); }
        else { if (t + 3 < NT) asm volatile("s_waitcnt vmcnt(4)" ::: "memory"); else if (t + 2 < NT) asm volatile("s_waitcnt vmcnt(2)" ::: "memory"); else asm volatile("s_waitcnt vmcnt(0)" ::: "memory"); }
        asm volatile("s_waitcnt lgkmcnt(0)" ::: "memory"); __builtin_amdgcn_s_barrier(); asm volatile("" ::: "memory");
    }
#undef MA_DMA
    { auto rr = __builtin_amdgcn_permlane32_swap(__float_as_uint(l_reg), __float_as_uint(l_reg), false, false); l_reg = __uint_as_float(rr[0]) + __uint_as_float(rr[1]); }
    if (hi == 0) wsf[32 + r32] = l_reg;
    LAS bf16_t* stg = (LAS bf16_t*)(L + MA_OST) + wid * 2048;
#pragma unroll
    for (int r = 0; r < 16; ++r) { const int orow = crow(r, hi); const float rli = __builtin_amdgcn_rcpf(wsf[32 + orow]);
        stg[orow * 64 + r32] = (bf16_t)f2bf(o[0][r] * rli); stg[orow * 64 + 32 + r32] = (bf16_t)f2bf(o[1][r] * rli); }
    bf16_t* Ow = Op + bs + (size_t)q0 * ldo;
#pragma unroll
    for (int i = 0; i < 4; ++i) { const int row = i * 8 + (lane >> 3), ch = lane & 7; const u32x4 v = *(const LAS u32x4*)(stg + row * 64 + ch * 8); *(u32x4*)(Ow + (size_t)row * ldo + ch * 8) = v; }
    __syncthreads();
}
template <int MODE> __device__ __forceinline__ void mattn_phase(Frame& F) {
    constexpr int NH = (MODE == 2) ? 16 : 8;
    if (F.G == 256) {
        const int x = (int)blockIdx.x & 7, j = (int)blockIdx.x >> 3, jj = j & 7;
        for (int r = 0; r < NH / 4; ++r) { const int h = (j >> 3) + 4 * r; const int qb = (r & 1) ? 7 - jj : jj; mattn_unit<MODE>(F, x, h, qb); }
    } else {
        const int nunits = BATCH * NH * 8;
        for (int u = F.vcu, r = 0; u < nunits; u += F.G, ++r) {
            const int jj = u & 7, bh = u >> 3; const int qb = (r & 1) ? 7 - jj : jj;
            mattn_unit<MODE>(F, bh / NH, bh % NH, qb);
        }
    }
}

__device__ __forceinline__ void fox_gate_rows(Frame& F, const Args& a) {
    { int t_ = F.tid; asm volatile("" : "+v"(t_)); F.tid = t_; F.lane = t_ & 63; F.wave = __builtin_amdgcn_readfirstlane(t_ >> 6); }
    const int gw = ((int)blockIdx.x & 7) * (M / 16 / 8) + ((int)blockIdx.x >> 3) * 8 + F.wave, NGW = 1 << 30; const float* bfp = a.in[20];
    const float* ssq = (const float*)(F.ws + WS_SSQ); float* LF = (float*)(F.ws + WS_CUM);
    const bf16_t* XBp = (const bf16_t*)(F.ws + WS_XB); const bf16_t* Wg = (const bf16_t*)(F.ws + WS_WFG);
    const int fr = F.lane & 15, fq = F.lane >> 4;
    for (int g = gw; g < M / 16 && (((int)blockIdx.x >> 3) * 8 + F.wave) < M / 16 / 8; g += NGW) {
        const bf16_t* ap = XBp + (size_t)(g * 16 + fr) * DM + fq * 8; const bf16_t* bp = Wg + (size_t)fr * DM + fq * 8;
        f32x4 acc = (f32x4){0.f, 0.f, 0.f, 0.f};
#pragma unroll 8
        for (int k = 0; k < DM / 32; ++k) { const pg8::bf16x8 av = *(const pg8::bf16x8*)(ap + k * 32), bv = *(const pg8::bf16x8*)(bp + k * 32);
            acc = __builtin_amdgcn_mfma_f32_16x16x32_bf16(av, bv, acc, 0, 0, 0); }
        const float bb = bfp[fr];
#pragma unroll
        for (int r = 0; r < 4; ++r) { const int row = g * 16 + fq * 4 + r; const float z = acc[r] * rstd_from16(ssq, row) + bb;
            LF[((size_t)(row >> 11) * 16 + fr) * SEQ + (row & (SEQ - 1))] = (fminf(z, 0.f) - log1pf(__expf(-fabsf(z)))) * LOG2E; }
    }
}
__device__ __forceinline__ void fox_scan(Frame& F) {
    { int t_ = F.tid; asm volatile("" : "+v"(t_)); F.tid = t_; F.lane = t_ & 63; F.wave = __builtin_amdgcn_readfirstlane(t_ >> 6); }
    const int gw = F.vcu * 8 + F.wave, NGW = F.G * 8; const float* LF = (const float*)(F.ws + WS_LF); float* cum = (float*)(F.ws + WS_CUM);
    for (int sc = gw; sc < BATCH * 16; sc += NGW) { const int b = sc >> 4, hh = sc & 15;
        float v[32]; float run = 0.f;
#pragma unroll
        for (int i = 0; i < 32; ++i) { run += LF[((size_t)b * SEQ + F.lane * 32 + i) * 16 + hh]; v[i] = run; }
        float incl = run;
#pragma unroll
        for (int o = 1; o < 64; o <<= 1) { const float tt = __shfl_up(incl, o); if (F.lane >= o) incl += tt; }
        const float excl = incl - run;
#pragma unroll
        for (int i = 0; i < 32; ++i) cum[(size_t)sc * SEQ + F.lane * 32 + i] = v[i] + excl;
    }
}
__device__ __forceinline__ void final_norm(Frame& F, const Args& a) {
    { int t_ = F.tid; asm volatile("" : "+v"(t_)); F.tid = t_; F.lane = t_ & 63; F.wave = __builtin_amdgcn_readfirstlane(t_ >> 6); }
    const int gw = F.vcu * 8 + F.wave, NGW = F.G * 8; const float* ssq = (const float*)(F.ws + WS_SSQ2); const float* g = a.in[22]; const bf16_t* xs = (const bf16_t*)(F.ws + WS_R + R_PP);
    for (int m = gw; m < M; m += NGW) { const float rs = rstd_from16(ssq, m);
#pragma unroll
        for (int j = 0; j < 4; ++j) { const u32x2 xw = *((const u32x2*)(xs + srow(m, DM)) + F.lane + 64 * j); const f32x4 gg = *((const f32x4*)g + F.lane + 64 * j);
            f32x4 v = (f32x4){__builtin_bit_cast(float, xw.x << 16), __builtin_bit_cast(float, xw.x & 0xffff0000u), __builtin_bit_cast(float, xw.y << 16), __builtin_bit_cast(float, xw.y & 0xffff0000u)};
            v = v * rs * gg; *((f32x4*)(F.x + (size_t)m * DM) + F.lane + 64 * j) = v; } }
}

constexpr int NPHASE = 20;
__global__ void __launch_bounds__(512, 2) mk_fwd(Args args) {
    extern __shared__ __attribute__((aligned(16))) unsigned char lds[];
    Frame F;
    F.lds = (LAS unsigned char*)lds; F.ldsg = lds;
    F.MISC = (volatile LAS unsigned*)(F.lds + MISC_OFF);
    F.tid = threadIdx.x; F.lane = F.tid & 63; F.wave = __builtin_amdgcn_readfirstlane(F.tid >> 6);
    F.G = gridDim.x; { const int bx = blockIdx.x; F.vcu = (F.G % 8 == 0) ? (bx % 8) * (F.G / 8) + bx / 8 : bx; }
    F.ws = args.ws; F.x = args.out; F.ctl = (gu32*)(args.ws + WS_CTL); F.wacc = 0ull;
    for (int u = F.tid; u < (LDS_BYTES - LDSCTL_OFF) / 4; u += 512) ((LAS unsigned*)(F.lds + LDSCTL_OFF))[u] = 0u;
    __syncthreads();
    XcdBarrier bar; bar.bar = (unsigned*)(F.ctl + CW_BAR); bar.x = 0; bar.st = nullptr;
    const bool multi = (args.ph_hi - args.ph_lo) > 1;
    if (multi) bar = xcd_barrier_post((unsigned*)(F.ctl + CW_BAR), F.MISC + 8);
    unsigned char* ws = args.ws;
    bf16_t* XB = (bf16_t*)(ws + WS_XB); float* SSQ = (float*)(ws + WS_SSQ);
#ifdef PROBE_MASK
    unsigned long long pr_acc = 0ull, pr_t0 = __builtin_amdgcn_s_memrealtime();
#define PROBE_MARK(ph_) do { const unsigned long long t_ = __builtin_amdgcn_s_memrealtime(); if ((PROBE_MASK >> (ph_)) & 1u) pr_acc += t_ - pr_t0; pr_t0 = t_; } while (0)
#else
#define PROBE_MARK(ph_) do {} while (0)
#endif
    if (args.ph_lo == 0) { prologue(F, args); if (1 < args.ph_hi) xcd_barrier(bar); PROBE_MARK(0); }
    if (multi) { if (threadIdx.x == 0) F.MISC[10] = (F.G == 256) ? xcc_groups_verified(bar.bar) : 0u; __syncthreads(); }
    for (int ph = (args.ph_lo == 0 ? 1 : args.ph_lo); ph < args.ph_hi; ++ph) {
        { unsigned char* w_ = args.ws; asm volatile("" : "+s"(w_)); ws = w_; F.ws = w_; float* x_ = args.out; asm volatile("" : "+s"(x_)); F.x = x_;
          int t_ = threadIdx.x; asm volatile("" : "+v"(t_)); F.tid = t_; F.lane = t_ & 63; F.wave = __builtin_amdgcn_readfirstlane(t_ >> 6);
          XB = (bf16_t*)(ws + WS_XB); SSQ = (float*)(ws + WS_SSQ); }
        const int layer = (ph >= 10) ? 1 : 0; const int lp = (ph == 0 || ph == 19) ? -1 : (ph - 1) - layer * 9;
        if (lp == 3 && layer == 1) continue;
        const bool fuse_fin = (F.G == 256);
        if (ph == 19) { if (fuse_fin) continue; final_norm(F, args); PROBE_MARK(ph); continue; }
        if (lp == 4) {
            if (layer == 0) { mattn_phase<0>(F); mattn_phase<1>(F); }
            else mattn_phase<2>(F);
        } else {
            if (lp == 0 && layer == 1) conv_p_rows(F, args.in[1] + (size_t)M * PLED, (bf16_t*)(ws + WS_PB), true);
            if (lp == 0 || lp == 6 || lp == 2 || lp == 8) {
                const float* sq = (lp == 0) ? (const float*)(ws + WS_SSQ2) : (const float*)SSQ; LAS float* rt = (LAS float*)(F.lds + RTAB_OFF); const int rb = ((int)blockIdx.x & 7) * 2048; const int t0 = fresh_tid_(F);
                for (int r = t0; r < 2048; r += 512) rt[r] = rstd_from16(sq, rb + r);
                __syncthreads(); }
            const int njobs = (lp == 6) ? 2 : 1;
            for (int jb = 0; jb < njobs; ++jb) {
                int et; pg8::Gemm g; int N_;
                bf16_t* XB2 = (bf16_t*)(ws + WS_R + R_PP); float* SSQ2 = (float*)(ws + WS_SSQ2);
                const LAS float* RT = (const LAS float*)(F.lds + RTAB_OFF);
                EpiSwiglu E0{(bf16_t*)(ws + WS_R + R_H), RT};
                EpiRes E1{XB, XB, SSQ, RT, (const bf16_t*)(ws + WS_R + R_PP), 1.0f, 0, 0, F.x, args.in[22], (unsigned*)(F.ctl + CW_FIN), 0, 0};
                EpiStoreT E2{(bf16_t*)(ws + WS_R + R_QKV), 3072, RT, 4, C2A};
                EpiStoreF E3{0, (bf16_t*)(ws + WS_R + R_ZZ), nullptr, RT, (float*)(ws + WS_SSQCQ), (float*)(ws + WS_SSQCKV), (bf16_t*)(ws + WS_KR), (float*)(ws + WS_KMP), (const float*)(ws + WS_ROPE), C2A};
                int Gs = F.G, cs = (int)blockIdx.x;
                int lcnt = 0, lpm = 0, lpn0 = 0;
                if (jb == 1) { et = 3; N_ = DM; E3.mode = 2; E3.O = (bf16_t*)(ws + WS_R + R_PP);
                    g = pg8::Gemm{(const bf16_t*)(ws + WS_PB), nullptr, (const bf16_t*)(ws + WS_WP + (size_t)layer * DM * PLED * 2), M, DM, PLED, PLED, PLED, 1 << 30, (size_t)2048 * PLED * 2};
                    Gs = F.G / 2; cs = (int)blockIdx.x - F.G / 2; if (cs < 0) cs = 1 << 28; }
                else if (lp == 0 || lp == 6) { const int wi = layer * 2 + (lp == 6 ? 1 : 0); et = 0; N_ = 2 * DFF;
                    const bf16_t* A_ = (lp == 0) ? XB2 : XB;
                    g = pg8::Gemm{A_, A_, (const bf16_t*)(ws + WS_WFI + (size_t)wi * SZ_WFI), M, 2 * DFF, DM, DM, DM, 1 << 30, (lp == 0) ? SLAB : (size_t)2048 * DM * 2}; }
                else if (lp == 1 || lp == 7) { const int wi = layer * 2 + (lp == 7 ? 1 : 0); et = 1; N_ = DM; E1.alpha = 0.5f; if (lp == 1) { E1.xin = XB2; E1.xin_s = 1; }
                    g = pg8::Gemm{(const bf16_t*)(ws + WS_R + R_H), nullptr, (const bf16_t*)(ws + WS_WFO + (size_t)wi * SZ_WFO), M, DM, DFF, DFF, DFF, 1 << 30, SLAB}; }
                else if (lp == 5) { et = 1; N_ = DM; E1.alpha = 1.0f;
                    if (layer == 0) g = pg8::Gemm{(const bf16_t*)(ws + WS_R + R_ZZ), nullptr, (const bf16_t*)(ws + WS_WABO), M, DM, DM, 2048, DM, 1 << 30, SLAB};
                    else g = pg8::Gemm{(const bf16_t*)(ws + WS_R + R_QKV), nullptr, (const bf16_t*)(ws + WS_WFXO), M, DM, DM, 3072, DM, 1 << 30, SLAB}; }
                else if (lp == 2 && layer == 0) { et = 3; N_ = 2048; g = pg8::Gemm{XB, XB, (const bf16_t*)(ws + WS_WABI), M, 2048, DM, DM, DM, 1 << 30, (size_t)2048 * DM * 2}; }
                else if (lp == 2) { et = 2; N_ = 3072; g = pg8::Gemm{XB, XB, (const bf16_t*)(ws + WS_WFXI), M, 3072, DM, DM, DM, 1 << 30, (size_t)2048 * DM * 2}; }
                else if (lp == 3) { et = 3; N_ = 1792; const bf16_t* ZZ = (const bf16_t*)(ws + WS_R + R_ZZ);
                    g = pg8::Gemm{ZZ + 512, ZZ + 768, (const bf16_t*)(ws + WS_WUP), M, 1792, 256, 2048, 256, 3, SLAB};
                    E3.mode = 1; E3.qscale = C2M; E3.O = (bf16_t*)(ws + WS_R + R_QMLA); E3.O2 = (bf16_t*)(ws + WS_R + R_KVMLA); }
                else { et = 1; N_ = DM; E1.mode = 1; E1.xb = XB2; E1.xb_s = 1; E1.ssq_out = SSQ2; E1.fin = (layer == 1 && fuse_fin) ? 1 : 0;
                    g = pg8::Gemm{XB, nullptr, (const bf16_t*)(ws + WS_WG + (size_t)layer * DM * DM * 2), M, DM, DM, DM, DM, 1 << 30, (size_t)2048 * DM * 2}; }
                pg8::StaticOrder S; S.init(M, N_, Gs, cs); S.lcnt = lcnt; S.lpm = lpm; S.lpn0 = lpn0;
#ifndef NO_GEMM
                if (et == 0) pg8::gemm_phase<EpiSwiglu, pg8::StaticOrder, true, true>(F.lds, g, S, E0, F.tid, F.wacc);
                else if (et == 1) pg8::gemm_phase<EpiRes, pg8::StaticOrder, true, true>(F.lds, g, S, E1, F.tid, F.wacc);
                else if (et == 2) pg8::gemm_phase<EpiStoreT, pg8::StaticOrder, true, true>(F.lds, g, S, E2, F.tid, F.wacc);
                else pg8::gemm_phase<EpiStoreF, pg8::StaticOrder, true, true>(F.lds, g, S, E3, F.tid, F.wacc);
#endif
            }
            if (lp == 2 && layer == 1) fox_gate_rows(F, args);
        }
        if (ph + 1 < args.ph_hi && !(ph == 18 && fuse_fin)) { if (F.MISC[10] != 0u) xcc_barrier(bar, (int)threadIdx.x); else xcd_barrier(bar); }
#ifdef PROBE_XBAR
        if (ph == 4) { for (int i_ = 0; i_ < 16; ++i_) xcd_barrier(bar); }
#endif
        PROBE_MARK(ph);
    }
#if defined(PROBE_PRO) || defined(PROBE_G)
    if (blockIdx.x == 0 && threadIdx.x == 0) { const unsigned long long t_ = __builtin_amdgcn_s_memrealtime(); while (__builtin_amdgcn_s_memrealtime() - t_ < 4ull * F.wacc) __builtin_amdgcn_s_sleep(8); }
#endif
#ifdef PROBE_MASK
    if (blockIdx.x == 0 && threadIdx.x == 0) { const unsigned long long t_ = __builtin_amdgcn_s_memrealtime(); while (__builtin_amdgcn_s_memrealtime() - t_ < 4ull * pr_acc) __builtin_amdgcn_s_sleep(8); }
#endif
}

extern "C" void kernel_launch(void* const* d_in, const int* in_sizes, int n_in, void* d_out, int out_size, void* d_ws, size_t ws_size, hipStream_t stream) {
    static int grid = 0;
    if (grid == 0) {
        if (n_in != 23 || out_size != M * DM || ws_size < WS_END) { fprintf(stderr, "kernel_launch: unexpected shapes (n_in %d out %d ws %zu)\n", n_in, out_size, ws_size); grid = -1; return; }
        int dev = 0, cus = 0, per_cu = 0;
        if (hipGetDevice(&dev) != hipSuccess || hipDeviceGetAttribute(&cus, hipDeviceAttributeMultiprocessorCount, dev) != hipSuccess) { grid = -1; return; }
        if (hipFuncSetAttribute((const void*)mk_fwd, hipFuncAttributeMaxDynamicSharedMemorySize, LDS_BYTES) != hipSuccess) { fprintf(stderr, "kernel_launch: hipFuncSetAttribute failed\n"); grid = -1; return; }
        if (hipOccupancyMaxActiveBlocksPerMultiprocessor(&per_cu, (const void*)mk_fwd, 512, LDS_BYTES) != hipSuccess || per_cu < 1) { fprintf(stderr, "kernel_launch: occupancy query says %d\n", per_cu); per_cu = 1; }
        (void)hipGetLastError();
        grid = cus;
        if (grid > 256) grid = 256;
        grid -= grid % 8;
    }
    if (grid < 0) return;
    (void)hipMemsetAsync((char*)d_ws + WS_CTL, 0, CTL_ZERO_BYTES, stream);
    Args a{};
    for (int i = 0; i < 23; ++i) a.in[i] = (const float*)d_in[i];
    a.out = (float*)d_out; a.ws = (unsigned char*)d_ws;
#if MK_ONE_LAUNCH
    a.ph_lo = 0; a.ph_hi = NPHASE;
    hipLaunchKernelGGL(mk_fwd, dim3(grid), dim3(512), LDS_BYTES, stream, a);
#else
    for (int ph = 0; ph < NPHASE; ++ph) { a.ph_lo = ph; a.ph_hi = ph + 1; hipLaunchKernelGGL(mk_fwd, dim3(grid), dim3(512), LDS_BYTES, stream, a); }
#endif
}
```

```cpp
#include <hip/hip_runtime.h>
#include <hip/hip_bf16.h>
#include <cstdio>
#include <cstdint>
#include <cmath>

#ifndef MK_SCALAR_ATTN
#define MK_SCALAR_ATTN 0
#endif
#ifndef MK_ONE_LAUNCH
#define MK_ONE_LAUNCH 1
#endif

constexpr int BATCH = 8, SEQ = 2048, DM = 1024, M = BATCH * SEQ, DFF = 2816, PLED = 256;
constexpr float EPS = 1e-6f;
constexpr float LOG2E = 1.4426950408889634f, LN2 = 0.6931471805599453f;
constexpr float C2A = 0.125f * LOG2E, C2M = 0.10206207261596577f * LOG2E;

namespace pg8 {
#define PG8_LAS __attribute__((address_space(3)))
typedef unsigned short bf16_t;
typedef short bf16x8 __attribute__((ext_vector_type(8)));
typedef float f32x4 __attribute__((ext_vector_type(4)));
typedef unsigned u32x4 __attribute__((ext_vector_type(4)));
typedef unsigned u32x2 __attribute__((ext_vector_type(2)));
constexpr int BM = 256, BK = 64, HALF = 128, HTB = HALF * BK * 2, STAGE_BYTES = 8 * HTB, NXCD = 8, WGM = 8;

__host__ __device__ __forceinline__ int lds_byte(int r, int c) { const int st = (r >> 4) * 2 + (c >> 5), rr = r & 15, cc = c & 31, ob = rr * 64 + cc * 2; return st * 1024 + (ob ^ (((ob >> 9) & 1) << 5)); }
__host__ __device__ __forceinline__ void stage_rc(int b, int& R, int& C) { const int st = b / 1024, sb = b % 1024, swz = sb ^ (((sb >> 9) & 1) << 5); R = (st >> 1) * 16 + swz / 64; C = (st & 1) * 32 + (swz % 64) / 2; }
__host__ __device__ __forceinline__ int perm32(int rho) { const int n = rho >> 4, i = rho & 15; return 8 * (i >> 2) + 4 * n + (i & 3); }

struct Unit { int pm, pn; };
struct Gemm { const bf16_t* A; const bf16_t* A2; const bf16_t* Bt; int M, N, K, lda, ldb, pn_split; size_t slabA; };

struct StaticOrder {
    int nM, nN, nwg, G, c; int lcnt, lpm, lpn0;
    __host__ __device__ __forceinline__ void init(int M_, int N_, int G_, int c_) { nM = M_ / BM; nN = N_ / BM; nwg = nM * nN; G = G_; c = c_; lcnt = 0; lpm = 0; lpn0 = 0; }
    __host__ __device__ __forceinline__ bool next(int i, Unit& u) const {
        if (lcnt > 0) { if (i >= lcnt) return false; u.pm = lpm; u.pn = lpn0 + i; return true; }
        const long L = (long)i * G + c; if (L >= nwg) return false;
        int wgid = (int)L; { const int q = nwg / NXCD, r = nwg % NXCD, xcd = wgid % NXCD, off = wgid / NXCD; wgid = (xcd < r ? xcd * (q + 1) : r * (q + 1) + (xcd - r) * q) + off; }
        const int nig = WGM * nN, gid = wgid / nig, fm = gid * WGM, gsz = (nM - fm) < WGM ? (nM - fm) : WGM;
        u.pm = fm + ((wgid % nig) % gsz); u.pn = (wgid % nig) / gsz; return true;
    }
    __device__ __forceinline__ void a_ready(const Unit&) const {}
    __device__ __forceinline__ void done(const Unit&) const {}
};

__device__ __forceinline__ unsigned cvt_pk_bf16(float lo, float hi) { unsigned r; asm volatile("v_cvt_pk_bf16_f32 %0, %1, %2" : "=v"(r) : "v"(lo), "v"(hi)); return r; }

__device__ __forceinline__ void prefetch_b0(PG8_LAS unsigned char* lds, const bf16_t* Bt, int ldb, int pn, int tid) {
    asm volatile("" : "+v"(tid));
    const int wid = __builtin_amdgcn_readfirstlane(tid >> 6);
    const size_t hstepB = (size_t)HALF * ldb * 2; const char* cB = (const char*)Bt + (size_t)pn * 2 * hstepB; const unsigned ldsw = (unsigned)wid * 1024u;
#pragma unroll
    for (int i = 0; i < 2; ++i) { int R, C; stage_rc(tid * 16 + i * 8192, R, C); const int Rb = (R & ~31) + perm32(R & 31); const unsigned vo = (unsigned)(Rb * ldb + C) * 2u;
#pragma unroll
        for (int bh = 0; bh < 4; ++bh) __builtin_amdgcn_global_load_lds((const unsigned*)(cB + (bh & 1) * hstepB + (bh >> 1) * (size_t)(BK * 2) + vo), (PG8_LAS unsigned*)(lds + (4 + bh) * HTB + ldsw + i * 8192), 16, 0, 0); }
}
template <class Epi, class Sched, bool ALIGN_EPI = false, bool SP2 = false, class Pre>
__device__ __forceinline__ void gemm_phase(PG8_LAS unsigned char* lds, const Gemm g, const Sched& S, const Epi& E, int tid, unsigned long long& pacc, const Pre& pre, const bool b0_staged = false) {
    asm volatile("" : "+v"(tid));
    const int wid = __builtin_amdgcn_readfirstlane(tid >> 6), lane = tid & 63, wr = wid >> 2, wc = wid & 3, fr = lane & 15, fq = lane >> 4;
    const int K = g.K, nt = K / BK;
    unsigned voffA[2], voffB[2];
#pragma unroll
    for (int i = 0; i < 2; ++i) { int R, C; stage_rc(tid * 16 + i * 8192, R, C); const int Rb = Epi::PERM ? ((R & ~31) + perm32(R & 31)) : R;
        voffA[i] = (unsigned)(R * g.lda + C) * 2u; voffB[i] = (unsigned)(Rb * g.ldb + C) * 2u; }
    const size_t kstep = (size_t)(BK * 2);
    const size_t hstepA = (size_t)HALF * g.lda * 2, hstepB = (size_t)HALF * g.ldb * 2;
    const size_t tstepA = 2 * hstepA, tstepB = 2 * hstepB;
    const unsigned ldsw = (unsigned)wid * 1024u;
    const int aoff = lds_byte(wr * 64 + fr, fq * 8), boff = lds_byte(wc * 32 + fr, fq * 8);
#define PG8_SA(b, h) (((b) * 2 + (h)) * HTB)
#define PG8_SB(b, h) ((4 + (b) * 2 + (h)) * HTB)
#define PG8_STAGE(bufoff, gbase, voff) do { _Pragma("unroll") for (int _i = 0; _i < 2; ++_i) \
        __builtin_amdgcn_global_load_lds((const unsigned*)((const char*)(gbase) + (voff)[_i]), (PG8_LAS unsigned*)(lds + (bufoff) + ldsw + _i * 8192), 16, 0, 0); } while (0)
#define PG8_LDA(dst, b, h) do { _Pragma("unroll") for (int m = 0; m < 4; ++m) _Pragma("unroll") for (int k = 0; k < 2; ++k) dst[m][k] = *(const PG8_LAS bf16x8*)(lds + PG8_SA(b, h) + aoff + m * 2048 + k * 1024); } while (0)
#define PG8_LDB(dst, b, h) do { _Pragma("unroll") for (int n = 0; n < 2; ++n) _Pragma("unroll") for (int k = 0; k < 2; ++k) dst[n][k] = *(const PG8_LAS bf16x8*)(lds + PG8_SB(b, h) + boff + n * 2048 + k * 1024); } while (0)
#define PG8_MMA(ai, bj, At, Bt) do { __builtin_amdgcn_s_setprio(1); _Pragma("unroll") for (int m = 0; m < 4; ++m) _Pragma("unroll") for (int n = 0; n < 2; ++n) _Pragma("unroll") for (int k = 0; k < 2; ++k) \
        acc[ai][bj][m][n] = __builtin_amdgcn_mfma_f32_16x16x32_bf16(Bt[n][k], At[m][k], acc[ai][bj][m][n], 0, 0, 0); __builtin_amdgcn_s_setprio(0); } while (0)
#define PG8_WAIT_V(n) asm volatile("s_waitcnt vmcnt(" #n ")" ::: "memory")
#define PG8_WAIT_L(n) asm volatile("s_waitcnt lgkmcnt(" #n ")" ::: "memory")
#define PG8_BAR __builtin_amdgcn_s_barrier()
#define PG8_SCHED __builtin_amdgcn_sched_barrier(0)
#define PG8_ABASE(u) ((const char*)(((u).pn >= g.pn_split) ? g.A2 : g.A) + (size_t)((u).pm >> 3) * g.slabA + (size_t)((u).pm & 7) * tstepA)
    Unit cur, nxt; int ui = 0;
    if (!S.next(0, cur)) return;
    f32x4 acc[2][2][4][2];
#pragma unroll
    for (int a = 0; a < 2; ++a)
#pragma unroll
        for (int b = 0; b < 2; ++b)
#pragma unroll
            for (int m = 0; m < 4; ++m)
#pragma unroll
                for (int n = 0; n < 2; ++n) acc[a][b][m][n] = (f32x4){0.f, 0.f, 0.f, 0.f};
    bf16x8 At[4][2], B0[2][2], B1[2][2];
    const char* cA = PG8_ABASE(cur); const char* cB = (const char*)g.Bt + (size_t)cur.pn * tstepB;
    S.a_ready(cur);
    if constexpr (SP2) {
        if (!b0_staged) { PG8_STAGE(PG8_SB(0, 0), cB, voffB); PG8_STAGE(PG8_SB(0, 1), cB + hstepB, voffB); }
        PG8_STAGE(PG8_SA(0, 0), cA, voffA); PG8_STAGE(PG8_SA(0, 1), cA + hstepA, voffA);
        pre();
        if (wr == 1) PG8_BAR;
        PG8_WAIT_V(2); PG8_BAR;
        if (b0_staged) { PG8_STAGE(PG8_SA(1, 0), cA + kstep, voffA); PG8_WAIT_V(2); }
        else { PG8_STAGE(PG8_SB(1, 0), cB + kstep, voffB); PG8_STAGE(PG8_SA(1, 0), cA + kstep, voffA); PG8_STAGE(PG8_SB(1, 1), cB + hstepB + kstep, voffB); PG8_WAIT_V(6); }
        PG8_BAR;
    } else {
        PG8_STAGE(PG8_SB(0, 0), cB, voffB); PG8_STAGE(PG8_SA(0, 0), cA, voffA); PG8_STAGE(PG8_SB(0, 1), cB + hstepB, voffB); PG8_STAGE(PG8_SA(0, 1), cA + hstepA, voffA);
        pre();
        if (wr == 1) PG8_BAR;
        PG8_WAIT_V(4); PG8_BAR;
        PG8_STAGE(PG8_SB(1, 0), cB + kstep, voffB); PG8_STAGE(PG8_SA(1, 0), cA + kstep, voffA); PG8_STAGE(PG8_SB(1, 1), cB + hstepB + kstep, voffB);
        PG8_WAIT_V(6); PG8_BAR;
    }
    for (;;) {
#ifdef PROBE_G
        const unsigned long long k0_ = __builtin_amdgcn_s_memrealtime();
#endif
        const bool has_next = S.next(ui + 1, nxt);
        const char* nA = has_next ? PG8_ABASE(nxt) : cA; const char* nB = has_next ? (const char*)g.Bt + (size_t)nxt.pn * tstepB : cB;
        for (int t = 0; t < nt; t += 2) {
            const bool last = (t == nt - 2);
            const char* a1 = cA + (size_t)(t + 1) * kstep;
            const char* a2 = last ? nA : cA + (size_t)(t + 2) * kstep; const char* b2 = last ? nB : cB + (size_t)(t + 2) * kstep;
            const char* a3 = a2 + kstep; const char* b3 = b2 + kstep;
            if (last && has_next) S.a_ready(nxt);
            if constexpr (SP2) {
            PG8_LDB(B0, 0, 0); PG8_LDB(B1, 0, 1); PG8_SCHED; PG8_LDA(At, 0, 0); PG8_STAGE(PG8_SA(1, 1), a1 + hstepA, voffA);
            PG8_WAIT_V(8); PG8_WAIT_L(0); PG8_BAR; PG8_MMA(0, 0, At, B0); PG8_MMA(0, 1, At, B1); PG8_BAR; PG8_SCHED;
            PG8_LDA(At, 0, 1); PG8_STAGE(PG8_SB(0, 0), b2, voffB); PG8_STAGE(PG8_SB(0, 1), b2 + hstepB, voffB); PG8_STAGE(PG8_SA(0, 0), a2, voffA);
            PG8_WAIT_V(8); PG8_WAIT_L(0); PG8_BAR; PG8_MMA(1, 0, At, B0); PG8_MMA(1, 1, At, B1); PG8_BAR; PG8_SCHED;
            PG8_LDB(B0, 1, 0); PG8_LDB(B1, 1, 1); PG8_SCHED; PG8_LDA(At, 1, 0); PG8_STAGE(PG8_SA(0, 1), a2 + hstepA, voffA);
            PG8_WAIT_V(8); PG8_WAIT_L(0); PG8_BAR; PG8_MMA(0, 0, At, B0); PG8_MMA(0, 1, At, B1); PG8_BAR; PG8_SCHED;
            PG8_LDA(At, 1, 1); PG8_STAGE(PG8_SB(1, 0), b3, voffB); PG8_STAGE(PG8_SB(1, 1), b3 + hstepB, voffB); PG8_STAGE(PG8_SA(1, 0), a3, voffA);
            PG8_WAIT_V(8); PG8_WAIT_L(0); PG8_BAR; PG8_MMA(1, 0, At, B0); PG8_MMA(1, 1, At, B1); PG8_BAR; PG8_SCHED;
            } else {
            PG8_LDB(B0, 0, 0); PG8_SCHED; PG8_LDA(At, 0, 0); PG8_STAGE(PG8_SA(1, 1), a1 + hstepA, voffA);
            PG8_WAIT_L(8); PG8_BAR; PG8_WAIT_L(0); PG8_MMA(0, 0, At, B0); PG8_BAR; PG8_SCHED;
            PG8_LDB(B1, 0, 1); PG8_STAGE(PG8_SB(0, 0), b2, voffB);
            PG8_BAR; PG8_WAIT_L(0); PG8_MMA(0, 1, At, B1); PG8_BAR;
            PG8_LDA(At, 0, 1); PG8_STAGE(PG8_SA(0, 0), a2, voffA);
            PG8_BAR; PG8_WAIT_L(0); PG8_MMA(1, 0, At, B0); PG8_BAR; PG8_SCHED;
            PG8_STAGE(PG8_SB(0, 1), b2 + hstepB, voffB);
            PG8_WAIT_V(6); PG8_BAR; PG8_MMA(1, 1, At, B1); PG8_BAR;
            PG8_LDB(B0, 1, 0); PG8_SCHED; PG8_LDA(At, 1, 0); PG8_STAGE(PG8_SA(0, 1), a2 + hstepA, voffA);
            PG8_WAIT_L(8); PG8_BAR; PG8_WAIT_L(0); PG8_MMA(0, 0, At, B0); PG8_BAR; PG8_SCHED;
            PG8_LDB(B1, 1, 1); PG8_STAGE(PG8_SB(1, 0), b3, voffB);
            PG8_BAR; PG8_WAIT_L(0); PG8_MMA(0, 1, At, B1); PG8_BAR;
            PG8_LDA(At, 1, 1); PG8_STAGE(PG8_SA(1, 0), a3, voffA);
            PG8_BAR; PG8_WAIT_L(0); PG8_MMA(1, 0, At, B0); PG8_BAR; PG8_SCHED;
            PG8_STAGE(PG8_SB(1, 1), b3 + hstepB, voffB);
            PG8_WAIT_V(6); PG8_BAR; PG8_MMA(1, 1, At, B1); PG8_BAR;
            }
        }
        if constexpr (ALIGN_EPI) { if (wr == 0) PG8_BAR; }
#ifdef PROBE_G
        const unsigned long long e0_ = __builtin_amdgcn_s_memrealtime(); if (PROBE_G == 2 && Epi::PROBE_ID == PROBE_GID) pacc += e0_ - k0_;
#endif
        E(acc, cur, wr, wc, fr, fq);
#ifdef PROBE_G
        if (PROBE_G == 1 && Epi::PROBE_ID == PROBE_GID) pacc += __builtin_amdgcn_s_memrealtime() - e0_;
#endif
        if (!has_next) break;
#pragma unroll
        for (int a = 0; a < 2; ++a)
#pragma unroll
            for (int b = 0; b < 2; ++b)
#pragma unroll
                for (int m = 0; m < 4; ++m)
#pragma unroll
                    for (int n = 0; n < 2; ++n) acc[a][b][m][n] = (f32x4){0.f, 0.f, 0.f, 0.f};
        cur = nxt; cA = nA; cB = nB; ++ui;
        if constexpr (ALIGN_EPI) { if (wr == 1) PG8_BAR; }
    }
    PG8_WAIT_V(0);
    if constexpr (!ALIGN_EPI) { if (wr == 0) PG8_BAR; }
    PG8_BAR;
#undef PG8_SA
#undef PG8_SB
#undef PG8_STAGE
#undef PG8_LDA
#undef PG8_LDB
#undef PG8_MMA
#undef PG8_WAIT_V
#undef PG8_WAIT_L
#undef PG8_BAR
#undef PG8_SCHED
#undef PG8_ABASE
}
}

using pg8::bf16_t; using pg8::f32x4; using pg8::u32x4; using pg8::u32x2; using pg8::Unit; using pg8::cvt_pk_bf16;

#define GAS __attribute__((address_space(1)))
#define LAS __attribute__((address_space(3)))
typedef GAS unsigned gu32;
#define RLX_AGENT __ATOMIC_RELAXED, __HIP_MEMORY_SCOPE_AGENT

constexpr size_t MiB = 1u << 20;
constexpr size_t WS_CTL = 0, CTL_ZERO_BYTES = 1 * MiB;
constexpr size_t WS_SSQ = 1 * MiB;
constexpr size_t WS_LF = 2 * MiB;
constexpr size_t WS_CUM = 3 * MiB;
constexpr size_t WS_ROPE = 4 * MiB;
constexpr size_t WS_BIASD = WS_ROPE + 256 * 1024;
constexpr size_t WS_KMP = WS_BIASD + 64 * 1024;
constexpr size_t WS_SSQCQ = WS_KMP + 256 * 1024;
constexpr size_t WS_SSQCKV = WS_SSQCQ + 256 * 1024;
constexpr size_t WS_KR = WS_SSQCKV + 256 * 1024;
constexpr size_t WS_WFG = 6 * MiB + 256 * 1024;
constexpr size_t WS_SSQ2 = 7 * MiB;
constexpr size_t WS_W = 8 * MiB;
constexpr size_t SZ_WFI = (size_t)2 * DFF * DM * 2, SZ_WFO = (size_t)DM * DFF * 2;
constexpr size_t WS_WFI = WS_W;
constexpr size_t WS_WFO = WS_WFI + 4 * SZ_WFI;
constexpr size_t WS_WABI = WS_WFO + 4 * SZ_WFO;
constexpr size_t WS_WUP = WS_WABI + (size_t)2048 * 1024 * 2;
constexpr size_t WS_WABO = WS_WUP + (size_t)1792 * 256 * 2;
constexpr size_t WS_WFXI = WS_WABO + (size_t)1024 * 1024 * 2;
constexpr size_t WS_WFXO = WS_WFXI + (size_t)3072 * 1024 * 2;
constexpr size_t WS_WG = WS_WFXO + (size_t)1024 * 1024 * 2;
constexpr size_t WS_WP = WS_WG + (size_t)2 * 1024 * 1024 * 2;
constexpr size_t WS_WEND = WS_WP + (size_t)2 * 1024 * 256 * 2;
constexpr size_t WS_XB = 96 * MiB;
constexpr size_t WS_R = 128 * MiB;
constexpr size_t WS_PB = 248 * MiB;
constexpr size_t WS_END = 256 * MiB;
static_assert(WS_WEND <= WS_XB, "weights fit");
constexpr size_t SLAB = 15 * MiB, SLABE = SLAB / 2;
constexpr size_t R_H = 0;
constexpr size_t R_ZZ = 0;
constexpr size_t R_QMLA = 8 * MiB;
constexpr size_t R_KVMLA = 11 * MiB;
constexpr size_t R_QKV = 0;
constexpr size_t R_PP = 11 * MiB;
__host__ __device__ __forceinline__ long sadj(int pm, int ld) { return (long)(pm >> 3) * ((long)SLABE - 2048L * (long)ld); }
__host__ __device__ __forceinline__ size_t srow(int row, int ld) { return (size_t)(row >> 11) * SLABE + (size_t)(row & 2047) * (size_t)ld; }

constexpr int CW_BAR = 4096;
constexpr int CW_QUAD = 24576;
constexpr int CW_FIN = 12288;

constexpr int RING_BYTES = 131072;
constexpr int LDSCTL_OFF = 135168, MISC_OFF = LDSCTL_OFF + 320;
constexpr int RTAB_OFF = LDSCTL_OFF + 1024;
constexpr int LDS_BYTES = 147456;
static_assert(RTAB_OFF + 8192 <= LDS_BYTES, "rstd table");

#define XB_TMO      128
#define XB_XCNT(j)  (256  + 64 * (j))
#define XB_XSUB(j)  (1280 + 64 * (j))
#define XB_XGEN(j)  (2304 + 64 * (j))
#define XB_TOP      3328
#define XB_TOPGEN   3392
#define XCD_BAR_WORDS 3456
#define XB_XMASK(j) (3520 + 64 * (j))
#define XB_XSUB2(j) (4608 + 64 * (j))
#define XB_XGEN2(j) (5632 + 64 * (j))
#define XB_SPIN_CAP (1u << 22)
__device__ __forceinline__ unsigned xb_ld(unsigned* p)              { return __hip_atomic_load(p, __ATOMIC_RELAXED, __HIP_MEMORY_SCOPE_AGENT); }
__device__ __forceinline__ unsigned xb_add(unsigned* p, unsigned v) { return __hip_atomic_fetch_add(p, v, __ATOMIC_RELAXED, __HIP_MEMORY_SCOPE_AGENT); }
__device__ __forceinline__ unsigned xb_xcc_id() { return (unsigned)__builtin_amdgcn_s_getreg((3 << 11) | 20) & 0xFu; }
#define XB_SPIN(cond, bar) do { unsigned _sp = 0; while (cond) { __builtin_amdgcn_s_sleep(1); \
    if ((++_sp & 255u) == 0u) { if (xb_ld(&(bar)[XB_TMO])) break; if (_sp > XB_SPIN_CAP) { atomicAdd(&(bar)[XB_TMO], 1u); break; } } } } while (0)
struct XcdBarrier { unsigned* bar; unsigned x; volatile LAS unsigned* st; };
__device__ __forceinline__ XcdBarrier xcd_barrier_post(unsigned* bar, volatile LAS unsigned* st) {
    XcdBarrier b; b.bar = bar; b.x = xb_xcc_id(); b.st = st;
    if (threadIdx.x == 0) { (void)__hip_atomic_fetch_or(&bar[XB_XMASK(b.x)], 1u << (blockIdx.x & 7u), __ATOMIC_RELAXED, __HIP_MEMORY_SCOPE_AGENT); (void)xb_add(&bar[XB_XCNT(b.x)], 1u); }
    return b;
}
__device__ __forceinline__ void xcd_barrier_complete(unsigned* bar, unsigned x, unsigned& nloc, unsigned& nx) {
    const unsigned G = gridDim.x * gridDim.y * gridDim.z;
    unsigned sum, cnt, mine, sp = 0u;
    for (;;) {
        sum = 0u; cnt = 0u; mine = 0u;
#pragma unroll
        for (unsigned j = 0; j < 16; ++j) { const unsigned c = xb_ld(&bar[XB_XCNT(j)]); sum += c; cnt += (c > 0u) ? 1u : 0u; mine = (j == x) ? c : mine; }
        if (sum == G) break;
        __builtin_amdgcn_s_sleep(1);
        if ((++sp & 255u) == 0u) { if (xb_ld(&bar[XB_TMO])) break; if (sp > XB_SPIN_CAP) { atomicAdd(&bar[XB_TMO], 1u); break; } }
    }
    nloc = mine > 0u ? mine : 1u; nx = cnt > 0u ? cnt : 1u;
}
__device__ __forceinline__ void xcd_barrier(const XcdBarrier& b) {
    asm volatile("s_waitcnt vmcnt(0)" ::: "memory");
    __syncthreads();
    if (threadIdx.x == 0) {
        unsigned* bar = b.bar;
        __builtin_amdgcn_s_waitcnt(0);
        unsigned nloc = b.st[0], nx = b.st[1];
        if (nloc == 0u) { xcd_barrier_complete(bar, b.x, nloc, nx); b.st[0] = nloc; b.st[1] = nx; }
        const unsigned old = xb_add(&bar[XB_XSUB(b.x)], 1u);
        const unsigned gen = old / nloc;
        if (old + 1u == (gen + 1u) * nloc) {
            __builtin_amdgcn_fence(__ATOMIC_RELEASE, "agent");
            asm volatile("s_waitcnt vmcnt(0)" ::: "memory");
            const unsigned og = xb_add(&bar[XB_TOP], 1u);
            const unsigned tg = og / nx;
            if (og + 1u == (tg + 1u) * nx) xb_add(&bar[XB_TOPGEN], 1u);
            else XB_SPIN(xb_ld(&bar[XB_TOPGEN]) == tg, bar);
            __builtin_amdgcn_fence(__ATOMIC_ACQUIRE, "agent");
            xb_add(&bar[XB_XGEN(b.x)], 1u);
            asm volatile("s_waitcnt vmcnt(0)" ::: "memory");
        } else {
            XB_SPIN(xb_ld(&bar[XB_XGEN(b.x)]) == gen, bar);
            __builtin_amdgcn_fence(__ATOMIC_ACQUIRE, "agent");
            asm volatile("s_waitcnt vmcnt(0)" ::: "memory");
        }
    }
    __syncthreads();
}


__device__ __forceinline__ unsigned xcc_groups_verified(unsigned* bar) {
    unsigned ok = 1u, seen = 0u, n = 0u;
#pragma unroll
    for (unsigned j = 0; j < 16; ++j) { const unsigned c = xb_ld(&bar[XB_XCNT(j)]), m = xb_ld(&bar[XB_XMASK(j)]);
        if (c != 0u) { ++n; if (c != 32u || m == 0u || (m & (m - 1u)) != 0u || (seen & m) != 0u) ok = 0u; seen |= m; } }
    return (ok != 0u && n == 8u && seen == 0xffu) ? 1u : 0u;
}
template <class PF> __device__ __forceinline__ void xcc_barrier(const XcdBarrier& b, const int tid0, volatile LAS unsigned* kcnt, const PF& pf, unsigned* cnt, const unsigned npart) {
    asm volatile("s_waitcnt vmcnt(0)" ::: "memory");
    __syncthreads();
    if (tid0 == 0) { const unsigned k = *kcnt + 1u; *kcnt = k; __builtin_amdgcn_s_waitcnt(0); (void)xb_add(cnt, 1u); }
    pf();
    if (tid0 == 0) {
        unsigned* bar = b.bar; const unsigned k = *kcnt;
        XB_SPIN(xb_ld(cnt) < npart * k, bar);
        __builtin_amdgcn_fence(__ATOMIC_ACQUIRE, "agent");
        asm volatile("s_waitcnt vmcnt(0)" ::: "memory");
    }
    __syncthreads();
}

__device__ __forceinline__ unsigned f2bf(float f) { unsigned u = __builtin_bit_cast(unsigned, f); return (u + 0x7fffu + ((u >> 16) & 1u)) >> 16; }
__device__ __forceinline__ unsigned pk2(float lo, float hi) { return f2bf(lo) | (f2bf(hi) << 16); }
__device__ __forceinline__ float bf2f(unsigned short b) { return __builtin_bit_cast(float, (unsigned)b << 16); }
__device__ __forceinline__ float wave_sum(float v) {
#pragma unroll
    for (int o = 1; o < 64; o <<= 1) v += __shfl_xor(v, o);
    return v;
}
__device__ __forceinline__ float sum4(f32x4 a) { return (a.x + a.y) + (a.z + a.w); }
__device__ __forceinline__ float rstd_from16(const float* ssq, int row) {
    const f32x4* p = (const f32x4*)(ssq + (size_t)row * 16);
    const float s = (sum4(p[0]) + sum4(p[1])) + (sum4(p[2]) + sum4(p[3]));
    return rsqrtf(s * (1.f / 1024.f) + EPS);
}
__device__ __forceinline__ float rstd_from4(const float* ssq, int row, float invn) {
    const f32x4 a = *(const f32x4*)(ssq + (size_t)row * 4);
    return rsqrtf(sum4(a) * invn + EPS);
}
__device__ __forceinline__ float sigmoidf_(float a) { return __builtin_amdgcn_rcpf(1.f + __expf(-a)); }

struct EpiSwiglu { static constexpr int PROBE_ID = 0;
    static constexpr bool PERM = true;
    bf16_t* H; const LAS float* rtab;
    __device__ __forceinline__ void operator()(const f32x4 (&acc)[2][2][4][2], const Unit& u, int wr, int wc, int fr, int fq) const {
        const int row0 = u.pm * 256 + wr * 64 + fr, col0 = u.pn * 128 + wc * 32 + 8 * fq;
#pragma unroll
        for (int ai = 0; ai < 2; ++ai)
#pragma unroll
            for (int m = 0; m < 4; ++m) {
                const int row = row0 + ai * 128 + m * 16; const float rs = rtab[row & 2047]; const float c1 = -rs * LOG2E, rs2 = rs * rs;
                f32x4 h[2];
#pragma unroll
                for (int n = 0; n < 2; ++n) { const f32x4 a = acc[ai][0][m][n]; const f32x4 t = a * c1; f32x4 e;
                    e.x = __builtin_amdgcn_exp2f(t.x); e.y = __builtin_amdgcn_exp2f(t.y); e.z = __builtin_amdgcn_exp2f(t.z); e.w = __builtin_amdgcn_exp2f(t.w);
                    const f32x4 d = e + 1.0f; f32x4 r; r.x = __builtin_amdgcn_rcpf(d.x); r.y = __builtin_amdgcn_rcpf(d.y); r.z = __builtin_amdgcn_rcpf(d.z); r.w = __builtin_amdgcn_rcpf(d.w);
                    h[n] = (a * r) * (acc[ai][1][m][n] * rs2); }
                u32x4 w; w.x = cvt_pk_bf16(h[0].x, h[0].y); w.y = cvt_pk_bf16(h[0].z, h[0].w); w.z = cvt_pk_bf16(h[1].x, h[1].y); w.w = cvt_pk_bf16(h[1].z, h[1].w);
                *(u32x4*)(H + sadj(u.pm, DFF) + (size_t)row * DFF + col0) = w;
            }
    }
};

struct EpiRes { static constexpr int PROBE_ID = 1;
    static constexpr bool PERM = true;
    const bf16_t* xin; bf16_t* xb; float* ssq_out; const LAS float* rtab; const bf16_t* pp; float alpha; int mode; int fin; float* out; const float* gfin; unsigned* fincnt; int xin_s, xb_s;
    __device__ __forceinline__ void operator()(f32x4 (&acc)[2][2][4][2], const Unit& u, int wr, int wc, int fr, int fq) const {
        const int row0 = u.pm * 256 + wr * 64 + fr, col0 = u.pn * 256 + wc * 32 + 8 * fq;
        const long sa = sadj(u.pm, DM); const bf16_t* xin_ = xin + (xin_s ? sa : 0L); const bf16_t* pp_ = pp + sa; bf16_t* xb_ = xb + (xb_s ? sa : 0L);
#pragma unroll
        for (int aim = 0; aim < 4; ++aim) { const int ai = aim >> 1, mb = (aim & 1) * 2;
            u32x4 xo[4][2], pw[4][2]; float rs[4];
#pragma unroll
            for (int m = mb; m < mb + 2; ++m) { const int row = row0 + ai * 128 + m * 16;
#pragma unroll
                for (int bj = 0; bj < 2; ++bj) { const size_t off = (size_t)row * DM + col0 + bj * 128; xo[m][bj] = *(const u32x4*)(xin_ + off); if (mode == 1) pw[m][bj] = *(const u32x4*)(pp_ + off); }
                rs[m] = 1.f; if (mode == 1) rs[m] = rtab[row & 2047]; }
#pragma unroll
            for (int m = mb; m < mb + 2; ++m) { const int row = row0 + ai * 128 + m * 16; float q = 0.f;
#pragma unroll
                for (int bj = 0; bj < 2; ++bj) {
                    const size_t off = (size_t)row * DM + col0 + bj * 128; u32x4 wout;
#pragma unroll
                    for (int n = 0; n < 2; ++n) {
                        const unsigned x0 = n ? xo[m][bj].z : xo[m][bj].x, x1 = n ? xo[m][bj].w : xo[m][bj].y;
                        const f32x4 o_ = (f32x4){__builtin_bit_cast(float, x0 << 16), __builtin_bit_cast(float, x0 & 0xffff0000u), __builtin_bit_cast(float, x1 << 16), __builtin_bit_cast(float, x1 & 0xffff0000u)};
                        f32x4 xn;
                        if (mode == 1) { const unsigned w0 = n ? pw[m][bj].z : pw[m][bj].x, w1 = n ? pw[m][bj].w : pw[m][bj].y;
                            const float p0 = __builtin_bit_cast(float, w0 << 16), p1 = __builtin_bit_cast(float, w0 & 0xffff0000u), p2 = __builtin_bit_cast(float, w1 << 16), p3 = __builtin_bit_cast(float, w1 & 0xffff0000u);
                            const f32x4 a = acc[ai][bj][m][n] * rs[m];
                            xn.x = o_.x + sigmoidf_(a.x) * p0; xn.y = o_.y + sigmoidf_(a.y) * p1; xn.z = o_.z + sigmoidf_(a.z) * p2; xn.w = o_.w + sigmoidf_(a.w) * p3;
                        } else xn = o_ + acc[ai][bj][m][n] * alpha;
                        if (fin) { acc[ai][bj][m][n] = xn; q += (xn.x * xn.x + xn.y * xn.y) + (xn.z * xn.z + xn.w * xn.w); }
                        else {
                            const unsigned c0 = cvt_pk_bf16(xn.x, xn.y), c1 = cvt_pk_bf16(xn.z, xn.w); if (n) { wout.z = c0; wout.w = c1; } else { wout.x = c0; wout.y = c1; }
                            const float r0 = __builtin_bit_cast(float, c0 << 16), r1 = __builtin_bit_cast(float, c0 & 0xffff0000u), r2 = __builtin_bit_cast(float, c1 << 16), r3 = __builtin_bit_cast(float, c1 & 0xffff0000u);
                            q += (r0 * r0 + r1 * r1) + (r2 * r2 + r3 * r3); }
                    }
                    if (!fin) *(u32x4*)(xb_ + off) = wout;
                }
                q += __shfl_xor(q, 16); q += __shfl_xor(q, 32);
                if (fq == 0) ssq_out[(size_t)row * 16 + u.pn * 4 + wc] = q; }
        }
        if (fin) {
            asm volatile("s_waitcnt vmcnt(0)" ::: "memory"); __syncthreads();
            if (wr == 0 && wc == 0 && fr == 0 && fq == 0) {
                __builtin_amdgcn_fence(__ATOMIC_RELEASE, "agent"); asm volatile("s_waitcnt vmcnt(0)" ::: "memory");
                unsigned* c_ = fincnt + 64 * u.pm; __hip_atomic_fetch_add(c_, 1u, __ATOMIC_RELAXED, __HIP_MEMORY_SCOPE_AGENT);
                unsigned sp_ = 0; while (__hip_atomic_load(c_, __ATOMIC_RELAXED, __HIP_MEMORY_SCOPE_AGENT) < 4u) { __builtin_amdgcn_s_sleep(1); if (++sp_ > (1u << 22)) break; }
                __builtin_amdgcn_fence(__ATOMIC_ACQUIRE, "agent"); asm volatile("s_waitcnt vmcnt(0)" ::: "memory");
            }
            __syncthreads();
            f32x4 gv[2][2];
#pragma unroll
            for (int bj = 0; bj < 2; ++bj)
#pragma unroll
                for (int n = 0; n < 2; ++n) gv[bj][n] = *(const f32x4*)(gfin + col0 + bj * 128 + n * 4);
#pragma unroll
            for (int ai = 0; ai < 2; ++ai)
#pragma unroll
                for (int m = 0; m < 4; ++m) { const int row = row0 + ai * 128 + m * 16; const float rsf = rstd_from16(ssq_out, row);
#pragma unroll
                    for (int bj = 0; bj < 2; ++bj)
#pragma unroll
                        for (int n = 0; n < 2; ++n) __builtin_nontemporal_store(acc[ai][bj][m][n] * rsf * gv[bj][n], (f32x4*)(out + (size_t)row * DM + col0 + bj * 128 + n * 4)); }
        }
    }
};

struct EpiStoreT { static constexpr int PROBE_ID = 2;
    static constexpr bool PERM = true;
    bf16_t* O; int ldo; const LAS float* rtab; int qtiles; float qscale;
    __device__ __forceinline__ void operator()(const f32x4 (&acc)[2][2][4][2], const Unit& u, int wr, int wc, int fr, int fq) const {
        const int row0 = u.pm * 256 + wr * 64 + fr, col0 = u.pn * 256 + wc * 32 + 8 * fq; const float qs = (u.pn < qtiles) ? qscale : 1.f;
#pragma unroll
        for (int ai = 0; ai < 2; ++ai)
#pragma unroll
            for (int m = 0; m < 4; ++m) {
                const int row = row0 + ai * 128 + m * 16; const float rs = rtab[row & 2047] * qs;
#pragma unroll
                for (int bj = 0; bj < 2; ++bj) { const f32x4 v0 = acc[ai][bj][m][0] * rs, v1 = acc[ai][bj][m][1] * rs;
                    u32x4 w; w.x = cvt_pk_bf16(v0.x, v0.y); w.y = cvt_pk_bf16(v0.z, v0.w); w.z = cvt_pk_bf16(v1.x, v1.y); w.w = cvt_pk_bf16(v1.z, v1.w);
                    *(u32x4*)(O + sadj(u.pm, ldo) + (size_t)row * ldo + col0 + bj * 128) = w; }
            }
    }
};

__device__ __forceinline__ f32x4 rope_pair(const f32x4 x, const f32x4 cs, const f32x4 sn, const bool lower) {
    f32x4 xp;
#pragma unroll
    for (int j = 0; j < 4; ++j) { auto rr = __builtin_amdgcn_permlane32_swap(__float_as_uint(x[j]), __float_as_uint(x[j]), false, false); xp[j] = __uint_as_float(lower ? rr[1] : rr[0]); }
    return lower ? (x * cs - xp * sn) : (xp * sn + x * cs);
}
struct EpiStoreF { static constexpr int PROBE_ID = 3;
    static constexpr bool PERM = true;
    int mode; bf16_t* O; bf16_t* O2; const LAS float* rtab; float* ssq_cq; float* ssq_ckv; bf16_t* kr; float* kmp; const float* rope; float qscale;
    __device__ __forceinline__ void operator()(const f32x4 (&acc)[2][2][4][2], const Unit& u, int wr, int wc, int fr, int fq) const {
        const int row0 = u.pm * 256 + wr * 64 + fr;
        float colsum[2][2][4];
#pragma unroll
        for (int bj = 0; bj < 2; ++bj)
#pragma unroll
            for (int n = 0; n < 2; ++n)
#pragma unroll
                for (int j = 0; j < 4; ++j) colsum[bj][n][j] = 0.f;
#pragma unroll
        for (int ai = 0; ai < 2; ++ai)
#pragma unroll
            for (int m = 0; m < 4; ++m) {
                const int row = row0 + ai * 128 + m * 16;
                float rs = 1.f;
                if (mode == 0) { rs = rtab[row & 2047]; if (u.pn < 2) rs *= qscale; }
                else if (mode == 1) rs = (u.pn < 3) ? rstd_from4(ssq_cq, row, 1.f / 256.f) * qscale : rstd_from4(ssq_ckv, row, 1.f / 128.f);
                f32x4 v[2][2];
#pragma unroll
                for (int bj = 0; bj < 2; ++bj)
#pragma unroll
                    for (int n = 0; n < 2; ++n) v[bj][n] = acc[ai][bj][m][n] * rs;
                bf16_t* orow; int ocol;
                if (mode == 0) { orow = O + sadj(u.pm, 2048) + (size_t)row * 2048; ocol = u.pn * 256 + wc * 32 + 8 * fq; }
                else if (mode == 1) { if (u.pn < 3) { orow = O + sadj(u.pm, 768) + (size_t)row * 768; ocol = u.pn * 256 + wc * 32 + 8 * fq; } else { orow = O2 + sadj(u.pm, 1024) + (size_t)row * 1024; ocol = (u.pn - 3) * 256 + wc * 32 + 8 * fq; } }
                else { orow = O + sadj(u.pm, 1024) + (size_t)row * 1024; ocol = u.pn * 256 + wc * 32 + 8 * fq; }
                if (mode == 0) {
                    if (u.pn == 2) { float q = 0.f;
#pragma unroll
                        for (int bj = 0; bj < 2; ++bj)
#pragma unroll
                            for (int n = 0; n < 2; ++n) q += (v[bj][n].x * v[bj][n].x + v[bj][n].y * v[bj][n].y) + (v[bj][n].z * v[bj][n].z + v[bj][n].w * v[bj][n].w);
                        q += __shfl_xor(q, 16); q += __shfl_xor(q, 32); if (fq == 0) ssq_cq[(size_t)row * 4 + wc] = q; }
                    if (u.pn == 3) { float q = 0.f;
#pragma unroll
                        for (int n = 0; n < 2; ++n) q += (v[0][n].x * v[0][n].x + v[0][n].y * v[0][n].y) + (v[0][n].z * v[0][n].z + v[0][n].w * v[0][n].w);
                        q += __shfl_xor(q, 16); q += __shfl_xor(q, 32); if (fq == 0) ssq_ckv[(size_t)row * 4 + wc] = q;
                        if (wc == 0) {
                            const int pos = row & (SEQ - 1); f32x4 y[2];
#pragma unroll
                            for (int n = 0; n < 2; ++n) { const f32x4 cs = *(const f32x4*)(rope + (size_t)pos * 16 + 8 * (fq & 1) + 4 * n), sn = *(const f32x4*)(rope + (size_t)SEQ * 16 + (size_t)pos * 16 + 8 * (fq & 1) + 4 * n);
                                y[n] = rope_pair(v[1][n], cs, sn, fq < 2); }
                            u32x4 w; w.x = cvt_pk_bf16(y[0].x, y[0].y); w.y = cvt_pk_bf16(y[0].z, y[0].w); w.z = cvt_pk_bf16(y[1].x, y[1].y); w.w = cvt_pk_bf16(y[1].z, y[1].w);
                            *(u32x4*)(kr + (size_t)row * 32 + 8 * fq) = w;
                        } }
                    if (u.pn == 4 || u.pn == 5) {
#pragma unroll
                        for (int bj = 0; bj < 2; ++bj)
#pragma unroll
                            for (int n = 0; n < 2; ++n) { colsum[bj][n][0] += v[bj][n].x; colsum[bj][n][1] += v[bj][n].y; colsum[bj][n][2] += v[bj][n].z; colsum[bj][n][3] += v[bj][n].w; }
                    }
                }
                if (mode == 1 && u.pn < 3) {
#pragma unroll
                    for (int bj = 0; bj < 2; ++bj) {
                        const int g32 = u.pn * 8 + bj * 4 + wc;
                        if (g32 % 3 == 2) {
                            const int pos = row & (SEQ - 1);
#pragma unroll
                            for (int n = 0; n < 2; ++n) { const f32x4 cs = *(const f32x4*)(rope + (size_t)pos * 16 + 8 * (fq & 1) + 4 * n), sn = *(const f32x4*)(rope + (size_t)SEQ * 16 + (size_t)pos * 16 + 8 * (fq & 1) + 4 * n);
                                v[bj][n] = rope_pair(v[bj][n], cs, sn, fq < 2); }
                        }
                    }
                }
#pragma unroll
                for (int bj = 0; bj < 2; ++bj) { u32x4 w; w.x = cvt_pk_bf16(v[bj][0].x, v[bj][0].y); w.y = cvt_pk_bf16(v[bj][0].z, v[bj][0].w); w.z = cvt_pk_bf16(v[bj][1].x, v[bj][1].y); w.w = cvt_pk_bf16(v[bj][1].z, v[bj][1].w);
                    *(u32x4*)(orow + ocol + bj * 128) = w; }
            }
        if (mode == 0 && (u.pn == 4 || u.pn == 5)) {
#pragma unroll
            for (int bj = 0; bj < 2; ++bj)
#pragma unroll
                for (int n = 0; n < 2; ++n)
#pragma unroll
                    for (int j = 0; j < 4; ++j) { float s = colsum[bj][n][j];
                        s += __shfl_xor(s, 1); s += __shfl_xor(s, 2); s += __shfl_xor(s, 4); s += __shfl_xor(s, 8);
                        if (fr == 0) kmp[((size_t)u.pm * 2 + wr) * 512 + (u.pn - 4) * 256 + bj * 128 + wc * 32 + 8 * fq + 4 * n + j] = s; }
        }
    }
};

struct Args {
    const float* in[23]; float* out; unsigned char* ws; int ph_lo, ph_hi;
};
struct Frame {
    LAS unsigned char* lds; unsigned char* ldsg; volatile LAS unsigned* MISC; gu32* ctl;
    int tid, lane, wave, vcu, G;
    unsigned char* ws; float* x;
    unsigned long long wacc;
};

__device__ __forceinline__ int fresh_tid_(const Frame& F) { int t_ = F.tid; asm volatile("" : "+v"(t_)); return t_; }
__device__ __forceinline__ void conv_item(const float* W, int ldw, int sc0, const float* gain, bf16_t* WT, int ldt, int n0, int k0, LAS float* scr, int lane, int nvalid, bool ntst) {
    const int lr = lane >> 4, lc = (lane & 15) * 4;
    f32x4 v[16];
#pragma unroll
    for (int i = 0; i < 16; ++i) { const int kk = 4 * i + lr; v[i] = (f32x4){0.f, 0.f, 0.f, 0.f};
        if (sc0 >= 0 && lc < nvalid) v[i] = __builtin_nontemporal_load((const f32x4*)(W + (size_t)(k0 + kk) * ldw + sc0 + lc)); }
#pragma unroll
    for (int i = 0; i < 16; ++i) { const int kk = 4 * i + lr; f32x4 x = v[i]; if (gain) x = x * gain[k0 + kk];
        LAS float* d = scr + kk * 65 + lc; d[0] = x.x; d[1] = x.y; d[2] = x.z; d[3] = x.w; }
    asm volatile("s_waitcnt lgkmcnt(0)" ::: "memory");
    const int c = lane & 7;
#pragma unroll
    for (int j = 0; j < 8; ++j) { const int n = (lane >> 3) + 8 * j; const LAS float* s_ = scr + (8 * c) * 65 + n;
        u32x4 o; o.x = cvt_pk_bf16(s_[0 * 65], s_[1 * 65]); o.y = cvt_pk_bf16(s_[2 * 65], s_[3 * 65]); o.z = cvt_pk_bf16(s_[4 * 65], s_[5 * 65]); o.w = cvt_pk_bf16(s_[6 * 65], s_[7 * 65]);
        if (ntst) __builtin_nontemporal_store(o, (u32x4*)(WT + (size_t)(n0 + n) * ldt + k0 + 8 * c)); else *(u32x4*)(WT + (size_t)(n0 + n) * ldt + k0 + 8 * c) = o; }
    asm volatile("s_waitcnt lgkmcnt(0)" ::: "memory");
}

struct ConvJob { const float* W; int ldw; const float* gain; bf16_t* WT; int K, N, kind; };
__device__ __forceinline__ ConvJob get_job(int j, const Args& a, unsigned char* ws) {
    ConvJob r;
    if (j < 12) { const int l = j / 6, t = j % 6;
        switch (t) {
        case 0: r = ConvJob{a.in[4] + (size_t)l * DM * 2 * DFF, 2 * DFF, a.in[3] + l * DM, (bf16_t*)(ws + WS_WFI + (size_t)(l * 2 + 0) * SZ_WFI), DM, 2 * DFF, 1}; break;
        case 1: r = ConvJob{a.in[8] + (size_t)l * DM * 2 * DFF, 2 * DFF, a.in[7] + l * DM, (bf16_t*)(ws + WS_WFI + (size_t)(l * 2 + 1) * SZ_WFI), DM, 2 * DFF, 1}; break;
        case 2: r = ConvJob{a.in[5] + (size_t)l * DFF * DM, DM, nullptr, (bf16_t*)(ws + WS_WFO + (size_t)(l * 2 + 0) * SZ_WFO), DFF, DM, 0}; break;
        case 3: r = ConvJob{a.in[9] + (size_t)l * DFF * DM, DM, nullptr, (bf16_t*)(ws + WS_WFO + (size_t)(l * 2 + 1) * SZ_WFO), DFF, DM, 0}; break;
        case 4: r = ConvJob{a.in[11] + (size_t)l * DM * DM, DM, a.in[10] + l * DM, (bf16_t*)(ws + WS_WG + (size_t)l * DM * DM * 2), DM, DM, 0}; break;
        default: r = ConvJob{a.in[12] + (size_t)l * PLED * DM, DM, nullptr, (bf16_t*)(ws + WS_WP + (size_t)l * DM * PLED * 2), PLED, DM, 0}; break;
        }
    } else {
        switch (j) {
        case 12: r = ConvJob{a.in[13], 1952, a.in[6], (bf16_t*)(ws + WS_WABI), DM, 2048, 2}; break;
        case 13: r = ConvJob{a.in[15], 768, a.in[14], (bf16_t*)(ws + WS_WUP), 256, 768, 0}; break;
        case 14: r = ConvJob{a.in[17], 1024, a.in[16], (bf16_t*)(ws + WS_WUP + (size_t)768 * 256 * 2), 256, 1024, 5}; break;
        case 15: r = ConvJob{a.in[18], DM, nullptr, (bf16_t*)(ws + WS_WABO), DM, DM, 0}; break;
        case 16: r = ConvJob{a.in[19], 3088, a.in[6] + DM, (bf16_t*)(ws + WS_WFXI), DM, 3072, 0}; break;
        case 17: r = ConvJob{a.in[21], DM, nullptr, (bf16_t*)(ws + WS_WFXO), DM, DM, 0}; break;
        default: r = ConvJob{a.in[19], 3088, a.in[6] + DM, (bf16_t*)(ws + WS_WFG), DM, 64, 6}; break;
        }
    }
    return r;
}
__device__ __forceinline__ int conv_srccol(int kind, int n0) {
    if (kind == 1) { const int pn = n0 >> 8, j = n0 & 255; return j < 128 ? pn * 128 + j : DFF + pn * 128 + (j - 128); }
    if (kind == 2) { if (n0 < 512) return n0; if (n0 < 1024) { const int o = n0 - 512; return o < 416 ? 1536 + o : -1; } if (n0 < 1536) return 512 + (n0 - 1024); return 1024 + (n0 - 1536); }
    return n0;
}

__device__ __forceinline__ void conv_p_rows(Frame& F, const float* p, bf16_t* pb, bool local) {
    const int gw = local ? (((int)blockIdx.x >> 3) - (F.G >> 4)) * 8 + F.wave : F.vcu * 8 + F.wave, NGW = local ? (F.G >> 4) * 8 : F.G * 8;
    const int mbeg = local ? ((int)blockIdx.x & 7) * SEQ : 0, mend = local ? mbeg + SEQ : M;
    for (int m0 = mbeg + gw; m0 < mend; m0 += 8 * NGW) { f32x4 v[8];
#pragma unroll
        for (int k = 0; k < 8; ++k) { const int m = m0 + k * NGW; v[k] = (f32x4){0.f, 0.f, 0.f, 0.f}; if (m < mend) v[k] = __builtin_nontemporal_load((const f32x4*)(p + (size_t)m * PLED) + F.lane); }
#pragma unroll
        for (int k = 0; k < 8; ++k) { const int m = m0 + k * NGW; if (m < mend) { u32x2 w; w.x = cvt_pk_bf16(v[k].x, v[k].y); w.y = cvt_pk_bf16(v[k].z, v[k].w); *((u32x2*)(pb + (size_t)m * PLED) + F.lane) = w; } } }
}

struct ConvItem { const float* W; int ldw, sc0; const float* gain; bf16_t* WT; int ldt, n0, k0, nvalid; bool ntst; };
__device__ __forceinline__ ConvItem conv_describe(int j, int it, const Args& a, unsigned char* ws) {
    const ConvJob jb = get_job(j, a, ws); const int nblk = jb.N / 64; const int kb = it / nblk, nb = it % nblk, k0 = 64 * kb, n0 = 64 * nb;
    int sc0 = conv_srccol(jb.kind, n0);
    if (jb.kind == 5 && k0 >= 128) sc0 = -1;
    if (jb.kind == 6) sc0 = 3072;
    int nvalid = 64; if (jb.kind == 6) nvalid = 16; if (jb.kind == 2 && n0 == 896) nvalid = 32; if (jb.kind == 2 && n0 > 896 && n0 < 1024) sc0 = -1;
    return ConvItem{jb.W, jb.ldw, sc0, jb.gain, jb.WT, jb.K, n0, k0, nvalid, j != 0};
}
__device__ __forceinline__ void conv_load(const ConvItem& c, int lane, f32x4 (&v)[16]) {
    const int lr = lane >> 4, lc = (lane & 15) * 4;
#pragma unroll
    for (int i = 0; i < 16; ++i) { const int kk = 4 * i + lr; v[i] = (f32x4){0.f, 0.f, 0.f, 0.f};
        if (c.sc0 >= 0 && lc < c.nvalid) v[i] = __builtin_nontemporal_load((const f32x4*)(c.W + (size_t)(c.k0 + kk) * c.ldw + c.sc0 + lc)); }
}
__device__ __forceinline__ void conv_finish(const ConvItem& c, LAS float* scr, int lane, const f32x4 (&v)[16]) {
    const int lr = lane >> 4, lc = (lane & 15) * 4;
#pragma unroll
    for (int i = 0; i < 16; ++i) { const int kk = 4 * i + lr; f32x4 x = v[i]; if (c.gain) x = x * c.gain[c.k0 + kk];
        LAS float* d = scr + kk * 65 + lc; d[0] = x.x; d[1] = x.y; d[2] = x.z; d[3] = x.w; }
    asm volatile("s_waitcnt lgkmcnt(0)" ::: "memory");
    const int cc = lane & 7;
#pragma unroll
    for (int j = 0; j < 8; ++j) { const int n = (lane >> 3) + 8 * j; const LAS float* s_ = scr + (8 * cc) * 65 + n;
        u32x4 o; o.x = cvt_pk_bf16(s_[0 * 65], s_[1 * 65]); o.y = cvt_pk_bf16(s_[2 * 65], s_[3 * 65]); o.z = cvt_pk_bf16(s_[4 * 65], s_[5 * 65]); o.w = cvt_pk_bf16(s_[6 * 65], s_[7 * 65]);
        if (c.ntst) __builtin_nontemporal_store(o, (u32x4*)(c.WT + (size_t)(c.n0 + n) * c.ldt + c.k0 + 8 * cc)); else *(u32x4*)(c.WT + (size_t)(c.n0 + n) * c.ldt + c.k0 + 8 * cc) = o; }
    asm volatile("s_waitcnt lgkmcnt(0)" ::: "memory");
}
struct ConvCursor { int j, it, base; };
__device__ __forceinline__ bool conv_settle(ConvCursor& c, const Args& a, unsigned char* ws, int gw, int NGW) {
    for (;;) {
        if (c.j >= 19) return false;
        const ConvJob jb = get_job(c.j, a, ws); const int nit = (jb.K / 64) * (jb.N / 64);
        if (c.it < nit) return true;
        c.base = (c.base + nit) % NGW; ++c.j;
        int first = (gw - c.base) % NGW; if (first < 0) first += NGW; c.it = first;
    }
}
__device__ __forceinline__ void prologue(Frame& F, const Args& a) {
    LAS float* scr = (LAS float*)(F.lds + F.wave * 16640);
    const int gw = F.vcu * 8 + F.wave, NGW = F.G * 8;
    unsigned char* ws = F.ws;
    constexpr int nj = 19;
#ifdef PROBE_PRO
    unsigned long long pp0_ = __builtin_amdgcn_s_memrealtime();
#endif
    {
        ConvCursor c{0, gw % NGW, 0}; bool cv = conv_settle(c, a, ws, gw, NGW);
        f32x4 vA[16], vB[16];
        if (cv) conv_load(conv_describe(c.j, c.it, a, ws), F.lane, vA);
        while (cv) {
            ConvCursor n = c; n.it += NGW; const bool nv = conv_settle(n, a, ws, gw, NGW);
            if (nv) conv_load(conv_describe(n.j, n.it, a, ws), F.lane, vB);
            conv_finish(conv_describe(c.j, c.it, a, ws), scr, F.lane, vA);
            if (!nv) break;
            c = n; c.it += NGW; cv = conv_settle(c, a, ws, gw, NGW);
            if (cv) conv_load(conv_describe(c.j, c.it, a, ws), F.lane, vA);
            conv_finish(conv_describe(n.j, n.it, a, ws), scr, F.lane, vB);
        }
    }
#ifdef PROBE_PRO
    { asm volatile("s_waitcnt vmcnt(0)" ::: "memory"); const unsigned long long t_ = __builtin_amdgcn_s_memrealtime(); if (PROBE_PRO == 1) F.wacc += t_ - pp0_; pp0_ = t_; }
#endif
    {
        const float* xin = a.in[0]; bf16_t* xb = (bf16_t*)(ws + WS_R + R_PP); float* ssq = (float*)(ws + WS_SSQ2);
        for (int m0 = gw; m0 < M; m0 += 4 * NGW) {
            f32x4 v[4][4];
#pragma unroll
            for (int k = 0; k < 4; ++k)
#pragma unroll
                for (int j = 0; j < 4; ++j) v[k][j] = __builtin_nontemporal_load((const f32x4*)(xin + (size_t)(m0 + k * NGW) * DM) + F.lane + 64 * j);
#pragma unroll
            for (int k = 0; k < 4; ++k) { const int m = m0 + k * NGW; float s = 0.f;
#pragma unroll
                for (int j = 0; j < 4; ++j) { u32x2 w; w.x = cvt_pk_bf16(v[k][j].x, v[k][j].y); w.y = cvt_pk_bf16(v[k][j].z, v[k][j].w); *((u32x2*)(xb + srow(m, DM)) + F.lane + 64 * j) = w;
                    const float r0 = __builtin_bit_cast(float, w.x << 16), r1 = __builtin_bit_cast(float, w.x & 0xffff0000u), r2 = __builtin_bit_cast(float, w.y << 16), r3 = __builtin_bit_cast(float, w.y & 0xffff0000u);
                    s += (r0 * r0 + r1 * r1) + (r2 * r2 + r3 * r3); }
                s = wave_sum(s);
                if (F.lane < 16) ssq[(size_t)m * 16 + F.lane] = (F.lane == 0) ? s : 0.f; }
        }
    }
#ifdef PROBE_PRO
    { asm volatile("s_waitcnt vmcnt(0)" ::: "memory"); const unsigned long long t_ = __builtin_amdgcn_s_memrealtime(); if (PROBE_PRO == 2) F.wacc += t_ - pp0_; pp0_ = t_; }
#endif
    conv_p_rows(F, a.in[1], (bf16_t*)(ws + WS_PB), false);
    {
        float* rope = (float*)(ws + WS_ROPE); const int gt = F.vcu * 512 + F.tid, NGT = F.G * 512;
        for (int e = gt; e < SEQ * 16; e += NGT) { const int pos = e >> 4, i = e & 15;
            const float inv = powf(10000.f, -(float)i / 16.f); const float ang = (float)pos * inv;
            rope[e] = (float)cos((double)ang); rope[SEQ * 16 + e] = (float)sin((double)ang); }
        float* biasd = (float*)(ws + WS_BIASD); const float* t5 = a.in[2];
        for (int e = gt; e < 8 * 128; e += NGT) { const int h = e >> 7, d = e & 127; int bk;
            if (d < 16) bk = d; else { bk = 16 + (int)(logf((float)d / 16.f) / 2.0794415416798357f * 16.f); if (bk > 31) bk = 31; }
            biasd[e] = t5[bk * 8 + h]; }
    }
#ifdef PROBE_PRO
    { asm volatile("s_waitcnt vmcnt(0)" ::: "memory"); const unsigned long long t_ = __builtin_amdgcn_s_memrealtime(); if (PROBE_PRO == 3) F.wacc += t_ - pp0_; }
#endif
}

typedef short bf16x8_t __attribute__((ext_vector_type(8)));
typedef short s16x4 __attribute__((ext_vector_type(4)));
typedef float f32x16 __attribute__((ext_vector_type(16)));
typedef short v4i16_t __attribute__((ext_vector_type(4)));
typedef float f32x2_t __attribute__((ext_vector_type(2))); typedef __bf16 bf16x2_t __attribute__((ext_vector_type(2)));
constexpr int MA_NSLOT = 4, MA_K = 0, MA_KSLOT = 12288, MA_V = 49152, MA_VSLOT = 8192, MA_WS = 81920, MA_OST = 83968, MA_C2 = 116736, MA_BT = 124928, MA_KM = 125952, MA_END = 130048;
static_assert(MA_END <= RING_BYTES, "attention LDS map");
constexpr float MA_THR = 6.0f;
__device__ __forceinline__ int crow(int r, int hi) { return (r & 3) + 8 * (r >> 2) + 4 * hi; }
__device__ __forceinline__ s16x4 vtr(const LAS unsigned char* p) { return __builtin_bit_cast(s16x4, __builtin_amdgcn_ds_read_tr16_b64_v4i16((LAS v4i16_t*)p)); }
__device__ __forceinline__ unsigned cvtpk_s(float lo, float hi) { f32x2_t v = {lo, hi}; bf16x2_t b = __builtin_convertvector(v, bf16x2_t); return __builtin_bit_cast(unsigned, b); }
__device__ __forceinline__ float swapmax(float m) { auto rr = __builtin_amdgcn_permlane32_swap(__float_as_uint(m), __float_as_uint(m), false, false); return fmaxf(__uint_as_float(rr[0]), __uint_as_float(rr[1])); }

template <int MODE> __device__ __forceinline__ void mattn_unit(Frame& F, int b, int h, int qb) {
    constexpr int DQ = (MODE == 1) ? 96 : 64, NKS = DQ / 16;
    int tid = F.tid; asm volatile("" : "+v"(tid));
    const int lane = tid & 63, wid = __builtin_amdgcn_readfirstlane(tid >> 6), r32 = lane & 31, hi = lane >> 5;
    LAS unsigned char* L = F.lds; unsigned char* ws = F.ws;
    const bf16_t *Qp, *K1, *K2 = nullptr, *Vp; bf16_t* Op; int ldq, ldk, ldv, ldo;
    if (MODE == 0) { const bf16_t* ZZ = (const bf16_t*)(ws + WS_R + R_ZZ); Qp = ZZ + h * 64; ldq = 2048; K1 = ZZ + 1024 + h * 64; ldk = 2048; Vp = ZZ + 1536 + h * 64; ldv = 2048; Op = (bf16_t*)ZZ + h * 64; ldo = 2048; }
    else if (MODE == 1) { const bf16_t* QM = (const bf16_t*)(ws + WS_R + R_QMLA); const bf16_t* KV = (const bf16_t*)(ws + WS_R + R_KVMLA);
        Qp = QM + h * 96; ldq = 768; K1 = KV + h * 128; ldk = 1024; K2 = (const bf16_t*)(ws + WS_KR); Vp = KV + h * 128 + 64; ldv = 1024; Op = (bf16_t*)(ws + WS_R + R_ZZ) + 512 + h * 64; ldo = 2048; }
    else { const bf16_t* QKV = (const bf16_t*)(ws + WS_R + R_QKV); Qp = QKV + h * 64; ldq = 3072; K1 = QKV + 1024 + h * 64; ldk = 3072; Vp = QKV + 2048 + h * 64; ldv = 3072; Op = (bf16_t*)QKV + h * 64; ldo = 3072; }
    const size_t rowb = (size_t)b * SEQ, bs = (size_t)b * SLABE; const int q0 = qb * 256 + wid * 32;
    bf16x8_t qr[NKS];
#pragma unroll
    for (int d0 = 0; d0 < NKS; ++d0) qr[d0] = *(const bf16x8_t*)(Qp + bs + (size_t)(q0 + r32) * ldq + d0 * 16 + hi * 8);
    const int NT = 4 * qb + 4, tlast = 4 * qb + (wid >> 1);
    LAS float* wsf = (LAS float*)(L + MA_WS) + wid * 64;
    LAS float* C2 = (LAS float*)(L + MA_C2); LAS float* BT = (LAS float*)(L + MA_BT);
#define MA_DMA(t, slot) do { \
    { const bf16_t* s_ = K1 + bs + ((size_t)(t) * 64 + lane) * ldk + wid * 8; \
      __builtin_amdgcn_global_load_lds((const unsigned*)s_, (LAS unsigned*)(L + MA_K + (slot) * MA_KSLOT + wid * 1024), 16, 0, 0); } \
    if (MODE == 1) { const bf16_t* s_ = K2 + (rowb + (size_t)(t) * 64 + lane) * 32 + (wid & 3) * 8; \
      __builtin_amdgcn_global_load_lds((const unsigned*)s_, (LAS unsigned*)(L + MA_K + (slot) * MA_KSLOT + (8 + (wid & 3)) * 1024), 16, 0, 0); } \
    { const bf16_t* s_ = Vp + bs + ((size_t)(t) * 64 + 16 * (wid & 3) + (lane >> 2)) * ldv + (wid >> 2) * 32 + (lane & 3) * 8; \
      __builtin_amdgcn_global_load_lds((const unsigned*)s_, (LAS unsigned*)(L + MA_V + (slot) * MA_VSLOT + wid * 1024), 16, 0, 0); } } while (0)
    if (MODE == 2) {
        const float* lft = (const float*)(ws + WS_CUM) + (size_t)(b * 16 + h) * SEQ; LAS float* wtot = (LAS float*)(L + MA_WS);
        f32x4 v = (f32x4){0.f, 0.f, 0.f, 0.f}; if (4 * tid < NT * 64) v = *(const f32x4*)(lft + 4 * tid);
        v.y += v.x; v.z += v.y; v.w += v.z; float incl = v.w;
#pragma unroll
        for (int o_ = 1; o_ < 64; o_ <<= 1) { const float tt = __shfl_up(incl, o_); if (lane >= o_) incl += tt; }
        if (lane == 63) wtot[wid] = incl;
        __syncthreads();
        float woff = 0.f;
#pragma unroll
        for (int w_ = 0; w_ < 8; ++w_) { const float tw = wtot[w_]; if (w_ < wid) woff += tw; }
        const float ex = incl - v.w + woff;
        if (4 * tid < NT * 64) *(LAS f32x4*)(C2 + 4 * tid) = (f32x4){v.x + ex, v.y + ex, v.z + ex, v.w + ex};
        __syncthreads();
    }
    if (MODE == 0) {
        const float* biasd = (const float*)(ws + WS_BIASD) + h * 128;
        if (tid < 256) BT[tid] = tid < 128 ? (biasd[tid] - biasd[127]) * LOG2E : 0.f;
        if (tid < 256) {
            const int c = tid >> 5, row = tid & 31, n = row & 7, part = row >> 3; u32x4 w = (u32x4){0u, 0u, 0u, 0u};
            if (part < 2) { const float* k0 = (const float*)(ws + WS_KMP) + ((size_t)(b * 8 + n) * 2) * 512 + h * 64 + c * 8; const float* k1 = k0 + 512; unsigned e[8];
#pragma unroll
                for (int j = 0; j < 8; ++j) { const float v = (k0[j] + k1[j]) * (1.f / 256.f); const unsigned hb = f2bf(v); const unsigned lb = f2bf(v - __builtin_bit_cast(float, hb << 16)); e[j] = part == 0 ? hb : lb; }
                w.x = e[0] | (e[1] << 16); w.y = e[2] | (e[3] << 16); w.z = e[4] | (e[5] << 16); w.w = e[6] | (e[7] << 16); }
            *(LAS u32x4*)(L + MA_KM + c * 512 + row * 16) = w; }
    }
    MA_DMA(0, 0); MA_DMA(1, 1); MA_DMA(2, 2);
    if (MODE == 1) asm volatile("s_waitcnt vmcnt(6)" ::: "memory"); else asm volatile("s_waitcnt vmcnt(4)" ::: "memory");
    asm volatile("s_waitcnt lgkmcnt(0)" ::: "memory"); __builtin_amdgcn_s_barrier(); asm volatile("" ::: "memory");
    unsigned sel = 0u;
    if (MODE == 0) {
        f32x16 g;
#pragma unroll
        for (int r = 0; r < 16; ++r) g[r] = 0.f;
#pragma unroll
        for (int d0 = 0; d0 < 4; ++d0) { const bf16x8_t kf = *(const LAS bf16x8_t*)(L + MA_KM + (2 * d0 + hi) * 512 + r32 * 16); g = __builtin_amdgcn_mfma_f32_32x32x16_bf16(kf, qr[d0], g, 0, 0, 0); }
        float gate[8];
#pragma unroll
        for (int j = 0; j < 4; ++j) { const float gv = g[j] + g[4 + j]; auto rr = __builtin_amdgcn_permlane32_swap(__float_as_uint(gv), __float_as_uint(gv), false, false); gate[j] = __uint_as_float(rr[0]); gate[4 + j] = __uint_as_float(rr[1]); }
        const int nsel = qb < 3 ? qb : 3;
        for (int r = 0; r < nsel; ++r) { int best = -1; float bv = -INFINITY;
#pragma unroll
            for (int n = 0; n < 8; ++n) { if (n < qb && !((sel >> n) & 1u) && (best < 0 || gate[n] > bv)) { best = n; bv = gate[n]; } }
            sel |= 1u << (best & 7); }
    }
    float mhat = -1000.f, l_reg = 0.f; f32x16 o[2];
#pragma unroll
    for (int r = 0; r < 16; ++r) { o[0][r] = 0.f; o[1][r] = 0.f; }
    f32x16 cvec; int cvblk = -1;
#pragma unroll
    for (int r = 0; r < 16; ++r) cvec[r] = -mhat;
    if (wid >= 4) __builtin_amdgcn_s_setprio(1);
    for (int t = 0; t < NT; ++t) {
        const int slot = t & 3;
        if (t <= tlast) {
            if (MODE == 0) { const int n = t >> 2; if (n != cvblk) { cvblk = n; const bool valid = (n == qb) || ((sel >> n) & 1u); const float ci = valid ? -mhat : -1e30f;
#pragma unroll
                for (int r = 0; r < 16; ++r) cvec[r] = ci; } }
            f32x16 p0, p1;
            const LAS unsigned char* kb = L + MA_K + slot * MA_KSLOT + hi * 1024 + r32 * 16;
            bf16x8_t kf[2 * NKS];
#pragma unroll
            for (int d0 = 0; d0 < NKS; ++d0) { kf[2 * d0] = *(const LAS bf16x8_t*)(kb + d0 * 2048); kf[2 * d0 + 1] = *(const LAS bf16x8_t*)(kb + d0 * 2048 + 512); }
            f32x4 cb0[4], cb1[4];
            if (MODE == 2) {
#pragma unroll
                for (int g = 0; g < 4; ++g) { cb0[g] = *(const LAS f32x4*)(C2 + t * 64 + 4 * hi + 8 * g); cb1[g] = *(const LAS f32x4*)(C2 + t * 64 + 32 + 4 * hi + 8 * g); }
            }
            __builtin_amdgcn_sched_barrier(0);
#pragma unroll
            for (int d0 = 0; d0 < NKS; ++d0) {
                if (d0 == 0) { p0 = __builtin_amdgcn_mfma_f32_32x32x16_bf16(kf[0], qr[0], cvec, 0, 0, 0); p1 = __builtin_amdgcn_mfma_f32_32x32x16_bf16(kf[1], qr[0], cvec, 0, 0, 0); }
                else { p0 = __builtin_amdgcn_mfma_f32_32x32x16_bf16(kf[2 * d0], qr[d0], p0, 0, 0, 0); p1 = __builtin_amdgcn_mfma_f32_32x32x16_bf16(kf[2 * d0 + 1], qr[d0], p1, 0, 0, 0); } }
            const LAS unsigned char* vp = L + MA_V + slot * MA_VSLOT + ((lane >> 4) & 1) * 32 + (lane & 3) * 8 + (4 * hi + ((lane & 15) >> 2)) * 64;
            s16x4 vlo[8], vhh[8];
#pragma unroll
            for (int i = 0; i < 8; ++i) { vlo[i] = vtr(vp + (i >> 2) * 4096 + (i & 3) * 1024); vhh[i] = vtr(vp + (i >> 2) * 4096 + (i & 3) * 1024 + 512); }
            __builtin_amdgcn_sched_barrier(0);
            if (MODE == 2) {
#pragma unroll
                for (int g = 0; g < 4; ++g) {
#pragma unroll
                    for (int j = 0; j < 4; ++j) { p0[4 * g + j] -= cb0[g][j]; p1[4 * g + j] -= cb1[g][j]; } }
            }
            const int dl = q0 - 64 * t + r32 - 4 * hi;
            if (MODE == 0) {
                if (t + 3 >= tlast) {
#pragma unroll
                    for (int r = 0; r < 16; ++r) { const int i0 = dl - ((r & 3) + 8 * (r >> 2)), i1 = i0 - 32;
                        const float b0 = BT[min(max(i0, 0), 128)], b1 = BT[min(max(i1, 0), 128)];
                        p0[r] = i0 < 0 ? -1e30f : p0[r] + b0; p1[r] = i1 < 0 ? -1e30f : p1[r] + b1; }
                }
            } else if (t == tlast) {
#pragma unroll
                for (int r = 0; r < 16; ++r) { const int i0 = dl - ((r & 3) + 8 * (r >> 2)), i1 = i0 - 32; if (i0 < 0) p0[r] = -1e30f; if (i1 < 0) p1[r] = -1e30f; }
            }
#define MX3(a_, b_, c_) __builtin_fmaxf(__builtin_fmaxf((a_), (b_)), (c_))
            float rm; { float a_ = MX3(p0[0], p0[1], p1[0]), b_ = MX3(p0[2], p0[3], p1[1]); a_ = MX3(a_, p1[2], p1[3]);
#pragma unroll
                for (int r = 4; r < 16; r += 4) { a_ = MX3(a_, p0[r], p0[r + 1]); b_ = MX3(b_, p0[r + 2], p0[r + 3]); a_ = MX3(a_, p1[r], p1[r + 1]); b_ = MX3(b_, p1[r + 2], p1[r + 3]); }
                rm = __builtin_fmaxf(a_, b_); }
#undef MX3
            rm = swapmax(rm);
            if (__any(rm > MA_THR)) {
                const float dlt = fmaxf(rm, 0.f); mhat += dlt;
#pragma unroll
                for (int r = 0; r < 16; ++r) { p0[r] -= dlt; p1[r] -= dlt; }
                { bool valid_ = true; if (MODE == 0) { const int n = t >> 2; valid_ = (n == qb) || ((sel >> n) & 1u); } const float ci = valid_ ? -mhat : -1e30f;
#pragma unroll
                  for (int r = 0; r < 16; ++r) cvec[r] = ci; }
                const float f = __builtin_amdgcn_exp2f(-dlt); l_reg *= f; if (hi == 0) wsf[r32] = f;
#pragma unroll
                for (int r = 0; r < 16; ++r) { const float fr_ = wsf[crow(r, hi)]; o[0][r] *= fr_; o[1][r] *= fr_; }
            }
            float sacc = 0.f;
#pragma unroll
            for (int r = 0; r < 16; ++r) { p0[r] = __builtin_amdgcn_exp2f(p0[r]); p1[r] = __builtin_amdgcn_exp2f(p1[r]); sacc += p0[r] + p1[r]; }
            l_reg += sacc;
            u32x4 pw[4];
            pw[0] = (u32x4){cvtpk_s(p0[0], p0[1]), cvtpk_s(p0[2], p0[3]), cvtpk_s(p0[4], p0[5]), cvtpk_s(p0[6], p0[7])};
            pw[1] = (u32x4){cvtpk_s(p0[8], p0[9]), cvtpk_s(p0[10], p0[11]), cvtpk_s(p0[12], p0[13]), cvtpk_s(p0[14], p0[15])};
            pw[2] = (u32x4){cvtpk_s(p1[0], p1[1]), cvtpk_s(p1[2], p1[3]), cvtpk_s(p1[4], p1[5]), cvtpk_s(p1[6], p1[7])};
            pw[3] = (u32x4){cvtpk_s(p1[8], p1[9]), cvtpk_s(p1[10], p1[11]), cvtpk_s(p1[12], p1[13]), cvtpk_s(p1[14], p1[15])};
#pragma unroll
            for (int dh = 0; dh < 2; ++dh)
#pragma unroll
                for (int ks = 0; ks < 4; ++ks) { const s16x4 lo = vlo[dh * 4 + ks], hh = vhh[dh * 4 + ks];
                    const bf16x8_t vf = (bf16x8_t){lo[0], lo[1], lo[2], lo[3], hh[0], hh[1], hh[2], hh[3]};
                    o[dh] = __builtin_amdgcn_mfma_f32_32x32x16_bf16(__builtin_bit_cast(bf16x8_t, pw[ks]), vf, o[dh], 0, 0, 0); }
        }
        if (t + 3 < NT) MA_DMA(t + 3, (t + 3) & 3);
        if (MODE == 1) { if (t + 3 < NT) asm volatile("s_waitcnt vmcnt(6)" ::: "memory"); else if (t + 2 < NT) asm volatile("s_waitcnt vmcnt(3)" ::: "memory"); else asm volatile("s_waitcnt vmcnt(0)" ::: "memory"); }
        else { if (t + 3 < NT) asm volatile("s_waitcnt vmcnt(4)" ::: "memory"); else if (t + 2 < NT) asm volatile("s_waitcnt vmcnt(2)" ::: "memory"); else asm volatile("s_waitcnt vmcnt(0)" ::: "memory"); }
        asm volatile("s_waitcnt lgkmcnt(0)" ::: "memory"); __builtin_amdgcn_s_barrier(); asm volatile("" ::: "memory");
    }
    __builtin_amdgcn_s_setprio(0);
#undef MA_DMA
    { auto rr = __builtin_amdgcn_permlane32_swap(__float_as_uint(l_reg), __float_as_uint(l_reg), false, false); l_reg = __uint_as_float(rr[0]) + __uint_as_float(rr[1]); }
    if (hi == 0) wsf[32 + r32] = l_reg;
    LAS bf16_t* stg = (LAS bf16_t*)(L + MA_OST) + wid * 2048;
#pragma unroll
    for (int r = 0; r < 16; ++r) { const int orow = crow(r, hi); const float rli = __builtin_amdgcn_rcpf(wsf[32 + orow]);
        stg[orow * 64 + r32] = (bf16_t)f2bf(o[0][r] * rli); stg[orow * 64 + 32 + r32] = (bf16_t)f2bf(o[1][r] * rli); }
    bf16_t* Ow = Op + bs + (size_t)q0 * ldo;
#pragma unroll
    for (int i = 0; i < 4; ++i) { const int row = i * 8 + (lane >> 3), ch = lane & 7; const u32x4 v = *(const LAS u32x4*)(stg + row * 64 + ch * 8); *(u32x4*)(Ow + (size_t)row * ldo + ch * 8) = v; }
    __syncthreads();
}
template <int MODE> __device__ __forceinline__ void mattn_phase(Frame& F) {
    constexpr int NH = (MODE == 2) ? 16 : 8;
    if (F.G == 256) {
        const int x = (int)blockIdx.x & 7, j = (int)blockIdx.x >> 3, jj = j & 7;
        for (int r = 0; r < NH / 4; ++r) { const int h = (j >> 3) + 4 * r; const int qb = (r & 1) ? 7 - jj : jj; mattn_unit<MODE>(F, x, h, qb); }
    } else {
        const int nunits = BATCH * NH * 8;
        for (int u = F.vcu, r = 0; u < nunits; u += F.G, ++r) {
            const int jj = u & 7, bh = u >> 3; const int qb = (r & 1) ? 7 - jj : jj;
            mattn_unit<MODE>(F, bh / NH, bh % NH, qb);
        }
    }
}

__device__ __forceinline__ void fox_gate_rows(Frame& F, const Args& a) {
    { int t_ = F.tid; asm volatile("" : "+v"(t_)); F.tid = t_; F.lane = t_ & 63; F.wave = __builtin_amdgcn_readfirstlane(t_ >> 6); }
    const float* bfp = a.in[20];
    const float* ssq = (const float*)(F.ws + WS_SSQ); float* LF = (float*)(F.ws + WS_CUM);
    const bf16_t* XBp = (const bf16_t*)(F.ws + WS_XB); const bf16_t* Wg = (const bf16_t*)(F.ws + WS_WFG);
    const int fr = F.lane & 15, fq = F.lane >> 4;
    LAS f32x4* red = (LAS f32x4*)F.lds;
    if (F.G == 256) {
        const int j_ = (int)blockIdx.x >> 3;
        const int g = ((int)blockIdx.x & 7) * (M / 16 / 8) + (j_ & 7) * 16 + (j_ >> 3) * 4 + (F.wave & 3), kh = F.wave >> 2;
        const bf16_t* ap = XBp + (size_t)(g * 16 + fr) * DM + fq * 8 + kh * (DM / 2); const bf16_t* bp = Wg + (size_t)fr * DM + fq * 8 + kh * (DM / 2);
        f32x4 acc = (f32x4){0.f, 0.f, 0.f, 0.f};
#pragma unroll
        for (int k = 0; k < DM / 64; ++k) { const pg8::bf16x8 av = *(const pg8::bf16x8*)(ap + k * 32), bv = *(const pg8::bf16x8*)(bp + k * 32);
            acc = __builtin_amdgcn_mfma_f32_16x16x32_bf16(av, bv, acc, 0, 0, 0); }
        if (kh == 1) red[(F.wave & 3) * 64 + F.lane] = acc;
        __syncthreads();
        if (kh == 0) { const f32x4 o_ = red[(F.wave & 3) * 64 + F.lane]; acc = acc + o_;
            const float bb = bfp[fr];
#pragma unroll
            for (int r = 0; r < 4; ++r) { const int row = g * 16 + fq * 4 + r; const float z = acc[r] * rstd_from16(ssq, row) + bb;
                LF[((size_t)(row >> 11) * 16 + fr) * SEQ + (row & (SEQ - 1))] = (fminf(z, 0.f) - log1pf(__expf(-fabsf(z)))) * LOG2E; } }
        __syncthreads();
    } else {
        const int gw = F.vcu * 8 + F.wave, NGW = F.G * 8;
        for (int g = gw; g < M / 16; g += NGW) {
            const bf16_t* ap = XBp + (size_t)(g * 16 + fr) * DM + fq * 8; const bf16_t* bp = Wg + (size_t)fr * DM + fq * 8;
            f32x4 acc = (f32x4){0.f, 0.f, 0.f, 0.f};
#pragma unroll 8
            for (int k = 0; k < DM / 32; ++k) { const pg8::bf16x8 av = *(const pg8::bf16x8*)(ap + k * 32), bv = *(const pg8::bf16x8*)(bp + k * 32);
                acc = __builtin_amdgcn_mfma_f32_16x16x32_bf16(av, bv, acc, 0, 0, 0); }
            const float bb = bfp[fr];
#pragma unroll
            for (int r = 0; r < 4; ++r) { const int row = g * 16 + fq * 4 + r; const float z = acc[r] * rstd_from16(ssq, row) + bb;
                LF[((size_t)(row >> 11) * 16 + fr) * SEQ + (row & (SEQ - 1))] = (fminf(z, 0.f) - log1pf(__expf(-fabsf(z)))) * LOG2E; }
        }
    }
}
__device__ __forceinline__ void fox_scan(Frame& F) {
    { int t_ = F.tid; asm volatile("" : "+v"(t_)); F.tid = t_; F.lane = t_ & 63; F.wave = __builtin_amdgcn_readfirstlane(t_ >> 6); }
    const int gw = F.vcu * 8 + F.wave, NGW = F.G * 8; const float* LF = (const float*)(F.ws + WS_LF); float* cum = (float*)(F.ws + WS_CUM);
    for (int sc = gw; sc < BATCH * 16; sc += NGW) { const int b = sc >> 4, hh = sc & 15;
        float v[32]; float run = 0.f;
#pragma unroll
        for (int i = 0; i < 32; ++i) { run += LF[((size_t)b * SEQ + F.lane * 32 + i) * 16 + hh]; v[i] = run; }
        float incl = run;
#pragma unroll
        for (int o = 1; o < 64; o <<= 1) { const float tt = __shfl_up(incl, o); if (F.lane >= o) incl += tt; }
        const float excl = incl - run;
#pragma unroll
        for (int i = 0; i < 32; ++i) cum[(size_t)sc * SEQ + F.lane * 32 + i] = v[i] + excl;
    }
}
__device__ __forceinline__ void final_norm(Frame& F, const Args& a) {
    { int t_ = F.tid; asm volatile("" : "+v"(t_)); F.tid = t_; F.lane = t_ & 63; F.wave = __builtin_amdgcn_readfirstlane(t_ >> 6); }
    const int gw = F.vcu * 8 + F.wave, NGW = F.G * 8; const float* ssq = (const float*)(F.ws + WS_SSQ2); const float* g = a.in[22]; const bf16_t* xs = (const bf16_t*)(F.ws + WS_R + R_PP);
    for (int m = gw; m < M; m += NGW) { const float rs = rstd_from16(ssq, m);
#pragma unroll
        for (int j = 0; j < 4; ++j) { const u32x2 xw = *((const u32x2*)(xs + srow(m, DM)) + F.lane + 64 * j); const f32x4 gg = *((const f32x4*)g + F.lane + 64 * j);
            f32x4 v = (f32x4){__builtin_bit_cast(float, xw.x << 16), __builtin_bit_cast(float, xw.x & 0xffff0000u), __builtin_bit_cast(float, xw.y << 16), __builtin_bit_cast(float, xw.y & 0xffff0000u)};
            v = v * rs * gg; *((f32x4*)(F.x + (size_t)m * DM) + F.lane + 64 * j) = v; } }
}

constexpr int NPHASE = 20;
__global__ void __launch_bounds__(512, 2) mk_fwd(Args args) {
    extern __shared__ __attribute__((aligned(16))) unsigned char lds[];
    Frame F;
    F.lds = (LAS unsigned char*)lds; F.ldsg = lds;
    F.MISC = (volatile LAS unsigned*)(F.lds + MISC_OFF);
    F.tid = threadIdx.x; F.lane = F.tid & 63; F.wave = __builtin_amdgcn_readfirstlane(F.tid >> 6);
    F.G = gridDim.x; { const int bx = blockIdx.x; F.vcu = (F.G % 8 == 0) ? (bx % 8) * (F.G / 8) + bx / 8 : bx; }
    F.ws = args.ws; F.x = args.out; F.ctl = (gu32*)(args.ws + WS_CTL); F.wacc = 0ull;
    for (int u = F.tid; u < (LDS_BYTES - LDSCTL_OFF) / 4; u += 512) ((LAS unsigned*)(F.lds + LDSCTL_OFF))[u] = 0u;
    __syncthreads();
    XcdBarrier bar; bar.bar = (unsigned*)(F.ctl + CW_BAR); bar.x = 0; bar.st = nullptr;
    const bool multi = (args.ph_hi - args.ph_lo) > 1;
    if (multi) bar = xcd_barrier_post((unsigned*)(F.ctl + CW_BAR), F.MISC + 8);
    unsigned char* ws = args.ws;
    bf16_t* XB = (bf16_t*)(ws + WS_XB); float* SSQ = (float*)(ws + WS_SSQ);
#ifdef PROBE_MASK
    unsigned long long pr_acc = 0ull, pr_t0 = __builtin_amdgcn_s_memrealtime();
#define PROBE_MARK(ph_) do { const unsigned long long t_ = __builtin_amdgcn_s_memrealtime(); if ((PROBE_MASK >> (ph_)) & 1u) pr_acc += t_ - pr_t0; pr_t0 = t_; } while (0)
#else
#define PROBE_MARK(ph_) do {} while (0)
#endif
    if (args.ph_lo == 0) { prologue(F, args); if (1 < args.ph_hi) xcd_barrier(bar); PROBE_MARK(0); }
    if (multi) { if (threadIdx.x == 0) F.MISC[10] = (F.G == 256) ? xcc_groups_verified(bar.bar) : 0u; __syncthreads(); }
    bool b0s = false;
    for (int ph = (args.ph_lo == 0 ? 1 : args.ph_lo); ph < args.ph_hi; ++ph) {
        { unsigned char* w_ = args.ws; asm volatile("" : "+s"(w_)); ws = w_; F.ws = w_; float* x_ = args.out; asm volatile("" : "+s"(x_)); F.x = x_;
          int t_ = threadIdx.x; asm volatile("" : "+v"(t_)); F.tid = t_; F.lane = t_ & 63; F.wave = __builtin_amdgcn_readfirstlane(t_ >> 6);
          XB = (bf16_t*)(ws + WS_XB); SSQ = (float*)(ws + WS_SSQ); }
        const int layer = (ph >= 10) ? 1 : 0; const int lp = (ph == 0 || ph == 19) ? -1 : (ph - 1) - layer * 9;
        if (lp == 3 && layer == 1) continue;
        const bool fuse_fin = (F.G == 256);
        if (ph == 19) { if (fuse_fin) continue; final_norm(F, args); PROBE_MARK(ph); continue; }
        if (lp == 4) {
            if (layer == 0) { mattn_phase<0>(F); mattn_phase<1>(F); }
            else mattn_phase<2>(F);
        } else {
            const int njobs = (lp == 6) ? 2 : 1;
            for (int jb = 0; jb < njobs; ++jb) {
                int et; pg8::Gemm g; int N_;
                bf16_t* XB2 = (bf16_t*)(ws + WS_R + R_PP); float* SSQ2 = (float*)(ws + WS_SSQ2);
                const LAS float* RT = (const LAS float*)(F.lds + RTAB_OFF);
                EpiSwiglu E0{(bf16_t*)(ws + WS_R + R_H), RT};
                EpiRes E1{XB, XB, SSQ, RT, (const bf16_t*)(ws + WS_R + R_PP), 1.0f, 0, 0, F.x, args.in[22], (unsigned*)(F.ctl + CW_FIN), 0, 0};
                EpiStoreT E2{(bf16_t*)(ws + WS_R + R_QKV), 3072, RT, 4, C2A};
                EpiStoreF E3{0, (bf16_t*)(ws + WS_R + R_ZZ), nullptr, RT, (float*)(ws + WS_SSQCQ), (float*)(ws + WS_SSQCKV), (bf16_t*)(ws + WS_KR), (float*)(ws + WS_KMP), (const float*)(ws + WS_ROPE), C2A};
                int Gs = F.G, cs = (int)blockIdx.x;
                int lcnt = 0, lpm = 0, lpn0 = 0;
                if (jb == 1) { et = 3; N_ = DM; E3.mode = 2; E3.O = (bf16_t*)(ws + WS_R + R_PP);
                    g = pg8::Gemm{(const bf16_t*)(ws + WS_PB), nullptr, (const bf16_t*)(ws + WS_WP + (size_t)layer * DM * PLED * 2), M, DM, PLED, PLED, PLED, 1 << 30, (size_t)2048 * PLED * 2};
                    Gs = F.G / 2; cs = (int)blockIdx.x - F.G / 2; if (cs < 0) cs = 1 << 28;
                    if (F.G == 256 && cs < (1 << 28)) { const int j_ = (int)blockIdx.x >> 3; lcnt = 2; lpm = ((int)blockIdx.x & 7) * 8 + (j_ & 7); lpn0 = ((j_ >> 3) - 2) * 2; } }
                else if (lp == 0 || lp == 6) { const int wi = layer * 2 + (lp == 6 ? 1 : 0); et = 0; N_ = 2 * DFF;
                    const bf16_t* A_ = (lp == 0) ? XB2 : XB;
                    g = pg8::Gemm{A_, A_, (const bf16_t*)(ws + WS_WFI + (size_t)wi * SZ_WFI), M, 2 * DFF, DM, DM, DM, 1 << 30, (lp == 0) ? SLAB : (size_t)2048 * DM * 2}; }
                else if (lp == 1 || lp == 7) { const int wi = layer * 2 + (lp == 7 ? 1 : 0); et = 1; N_ = DM; E1.alpha = 0.5f; if (lp == 1) { E1.xin = XB2; E1.xin_s = 1; }
                    g = pg8::Gemm{(const bf16_t*)(ws + WS_R + R_H), nullptr, (const bf16_t*)(ws + WS_WFO + (size_t)wi * SZ_WFO), M, DM, DFF, DFF, DFF, 1 << 30, SLAB}; }
                else if (lp == 5) { et = 1; N_ = DM; E1.alpha = 1.0f;
                    if (layer == 0) g = pg8::Gemm{(const bf16_t*)(ws + WS_R + R_ZZ), nullptr, (const bf16_t*)(ws + WS_WABO), M, DM, DM, 2048, DM, 1 << 30, SLAB};
                    else g = pg8::Gemm{(const bf16_t*)(ws + WS_R + R_QKV), nullptr, (const bf16_t*)(ws + WS_WFXO), M, DM, DM, 3072, DM, 1 << 30, SLAB}; }
                else if (lp == 2 && layer == 0) { et = 3; N_ = 2048; g = pg8::Gemm{XB, XB, (const bf16_t*)(ws + WS_WABI), M, 2048, DM, DM, DM, 1 << 30, (size_t)2048 * DM * 2}; }
                else if (lp == 2) { et = 2; N_ = 3072; g = pg8::Gemm{XB, XB, (const bf16_t*)(ws + WS_WFXI), M, 3072, DM, DM, DM, 1 << 30, (size_t)2048 * DM * 2}; }
                else if (lp == 3) { et = 3; N_ = 1792; const bf16_t* ZZ = (const bf16_t*)(ws + WS_R + R_ZZ);
                    g = pg8::Gemm{ZZ + 512, ZZ + 768, (const bf16_t*)(ws + WS_WUP), M, 1792, 256, 2048, 256, 3, SLAB};
                    E3.mode = 1; E3.qscale = C2M; E3.O = (bf16_t*)(ws + WS_R + R_QMLA); E3.O2 = (bf16_t*)(ws + WS_R + R_KVMLA); }
                else { et = 1; N_ = DM; E1.mode = 1; E1.xb = XB2; E1.xb_s = 1; E1.ssq_out = SSQ2; E1.fin = (layer == 1 && fuse_fin) ? 1 : 0;
                    g = pg8::Gemm{XB, nullptr, (const bf16_t*)(ws + WS_WG + (size_t)layer * DM * DM * 2), M, DM, DM, DM, DM, 1 << 30, (size_t)2048 * DM * 2}; }
                pg8::StaticOrder S; S.init(M, N_, Gs, cs); S.lcnt = lcnt; S.lpm = lpm; S.lpn0 = lpn0;
                const bool need_rt = (jb == 0) && (lp == 0 || lp == 6 || lp == 2 || lp == 8);
                auto pre = [&]() __attribute__((always_inline)) {
                    if (need_rt) { const float* sq = (lp == 0) ? (const float*)(ws + WS_SSQ2) : (const float*)SSQ; LAS float* rt = (LAS float*)(F.lds + RTAB_OFF); const int rb = ((int)blockIdx.x & 7) * 2048; const int t0 = fresh_tid_(F);
                        for (int r = t0; r < 2048; r += 512) rt[r] = rstd_from16(sq, rb + r); } };
#ifndef NO_GEMM
                if (et == 0) pg8::gemm_phase<EpiSwiglu, pg8::StaticOrder, true, true>(F.lds, g, S, E0, F.tid, F.wacc, pre, b0s && jb == 0);
                else if (et == 1) pg8::gemm_phase<EpiRes, pg8::StaticOrder, true, true>(F.lds, g, S, E1, F.tid, F.wacc, pre, b0s && jb == 0);
                else if (et == 2) pg8::gemm_phase<EpiStoreT, pg8::StaticOrder, true, true>(F.lds, g, S, E2, F.tid, F.wacc, pre, b0s && jb == 0);
                else pg8::gemm_phase<EpiStoreF, pg8::StaticOrder, true, true>(F.lds, g, S, E3, F.tid, F.wacc, pre, b0s && jb == 0);
#endif
            }
            b0s = false;
            if (lp == 2 && layer == 1) fox_gate_rows(F, args);
            if (lp == 0 && layer == 1) {
                if (F.G == 256) { if ((int)blockIdx.x >= 128) conv_p_rows(F, args.in[1] + (size_t)M * PLED, (bf16_t*)(ws + WS_PB), true); }
                else conv_p_rows(F, args.in[1] + (size_t)M * PLED, (bf16_t*)(ws + WS_PB), false); }
        }
        if (ph + 1 < args.ph_hi && !(ph == 18 && fuse_fin)) {
            if (F.MISC[10] != 0u) {
                const int nph = (ph == 12) ? 14 : ph + 1; const int nl = (nph >= 10) ? 1 : 0, nlp = (nph - 1) - nl * 9;
                const bf16_t* nB = nullptr; int nldb = DM, nN = DM;
                if (nlp == 0 || nlp == 6) { nB = (const bf16_t*)(ws + WS_WFI + (size_t)(nl * 2 + (nlp == 6 ? 1 : 0)) * SZ_WFI); nN = 2 * DFF; }
                else if (nlp == 1 || nlp == 7) { nB = (const bf16_t*)(ws + WS_WFO + (size_t)(nl * 2 + (nlp == 7 ? 1 : 0)) * SZ_WFO); nldb = DFF; }
                else if (nlp == 5) nB = (const bf16_t*)(ws + (nl == 0 ? WS_WABO : WS_WFXO));
                else if (nlp == 2) { nB = (const bf16_t*)(ws + (nl == 0 ? WS_WABI : WS_WFXI)); nN = (nl == 0) ? 2048 : 3072; }
                else if (nlp == 3) { nB = (const bf16_t*)(ws + WS_WUP); nldb = 256; nN = 1792; }
                else if (nlp == 8) nB = (const bf16_t*)(ws + WS_WG + (size_t)nl * DM * DM * 2);
                pg8::StaticOrder NS; NS.init(M, nN, F.G, (int)blockIdx.x); pg8::Unit nu; const bool nhas = (nB != nullptr) && nph < args.ph_hi && NS.next(0, nu);
                const bool quad = (F.G == 256) && (ph == 1 || ph == 2 || ph == 3 || ph == 6 || ph == 7 || ph == 8 || ph == 9 || ph == 10 || ph == 11 || ph == 15 || ph == 16 || ph == 17);
                unsigned* cnt_ = quad ? (unsigned*)(F.ctl + CW_QUAD) + 64 * (((int)blockIdx.x & 7) * 8 + (((int)blockIdx.x >> 3) & 7)) : &bar.bar[XB_XSUB2(bar.x)];
                xcc_barrier(bar, (int)threadIdx.x, F.MISC + (quad ? 12 : 11), [&]() __attribute__((always_inline)) { if (nhas) pg8::prefetch_b0(F.lds, nB, nldb, nu.pn, (int)threadIdx.x); }, cnt_, quad ? 4u : 32u);
                b0s = nhas;
            } else xcd_barrier(bar);
        }
#ifdef PROBE_XBAR
        if (ph == 4) { for (int i_ = 0; i_ < 16; ++i_) xcd_barrier(bar); }
#endif
        PROBE_MARK(ph);
    }
#if defined(PROBE_PRO) || defined(PROBE_G)
    if (blockIdx.x == 0 && threadIdx.x == 0) { const unsigned long long t_ = __builtin_amdgcn_s_memrealtime(); while (__builtin_amdgcn_s_memrealtime() - t_ < 4ull * F.wacc) __builtin_amdgcn_s_sleep(8); }
#endif
#ifdef PROBE_MASK
    if (blockIdx.x == 0 && threadIdx.x == 0) { const unsigned long long t_ = __builtin_amdgcn_s_memrealtime(); while (__builtin_amdgcn_s_memrealtime() - t_ < 4ull * pr_acc) __builtin_amdgcn_s_sleep(8); }
#endif
}

extern "C" void kernel_launch(void* const* d_in, const int* in_sizes, int n_in, void* d_out, int out_size, void* d_ws, size_t ws_size, hipStream_t stream) {
    static int grid = 0;
    if (grid == 0) {
        if (n_in != 23 || out_size != M * DM || ws_size < WS_END) { fprintf(stderr, "kernel_launch: unexpected shapes (n_in %d out %d ws %zu)\n", n_in, out_size, ws_size); grid = -1; return; }
        int dev = 0, cus = 0, per_cu = 0;
        if (hipGetDevice(&dev) != hipSuccess || hipDeviceGetAttribute(&cus, hipDeviceAttributeMultiprocessorCount, dev) != hipSuccess) { grid = -1; return; }
        if (hipFuncSetAttribute((const void*)mk_fwd, hipFuncAttributeMaxDynamicSharedMemorySize, LDS_BYTES) != hipSuccess) { fprintf(stderr, "kernel_launch: hipFuncSetAttribute failed\n"); grid = -1; return; }
        if (hipOccupancyMaxActiveBlocksPerMultiprocessor(&per_cu, (const void*)mk_fwd, 512, LDS_BYTES) != hipSuccess || per_cu < 1) { fprintf(stderr, "kernel_launch: occupancy query says %d\n", per_cu); per_cu = 1; }
        (void)hipGetLastError();
        grid = cus;
        if (grid > 256) grid = 256;
        grid -= grid % 8;
    }
    if (grid < 0) return;
    (void)hipMemsetAsync((char*)d_ws + WS_CTL, 0, CTL_ZERO_BYTES, stream);
    Args a{};
    for (int i = 0; i < 23; ++i) a.in[i] = (const float*)d_in[i];
    a.out = (float*)d_out; a.ws = (unsigned char*)d_ws;
#if MK_ONE_LAUNCH
    a.ph_lo = 0; a.ph_hi = NPHASE;
    hipLaunchKernelGGL(mk_fwd, dim3(grid), dim3(512), LDS_BYTES, stream, a);
#else
    for (int ph = 0; ph < NPHASE; ++ph) { a.ph_lo = ph; a.ph_hi = ph + 1; hipLaunchKernelGGL(mk_fwd, dim3(grid), dim3(512), LDS_BYTES, stream, a); }
#endif
}
```
